# Optimizing an MI355X kernel written in HIP

```python
import jax, jax.numpy as jnp
from jax import lax
import numpy as np

D_MODEL = 1024
BATCH = 8
SEQ = 8192
DEPTH = 2
DEC_BATCH = 16
DEC_SEQ = 64
PAST_LEN = 2048

CHUNK = 64
Q_BLOCK = 128
D_MIX = D_MODEL
FOX_WIDTH = D_MIX // 2
FOX_HEAD_DIM = 64
FOX_HEADS = FOX_WIDTH // FOX_HEAD_DIM
HG_WIDTH = D_MIX - FOX_WIDTH
HG_HEAD_DIM = 128
HG_HEADS = HG_WIDTH // HG_HEAD_DIM
NORM_EPS = 1e-6
_SIZES = (FOX_WIDTH, FOX_WIDTH, FOX_WIDTH, FOX_HEADS, FOX_WIDTH, HG_WIDTH, HG_WIDTH, HG_WIDTH, HG_WIDTH)
D_IN = 4 * FOX_WIDTH + FOX_HEADS + 4 * HG_WIDTH
SPLIT_POINTS = tuple(int(v) for v in np.cumsum(_SIZES)[:-1])

kernel_name = "fox_hgrn2_parallel_stream_step"

F32 = jnp.float32


def rmsnorm(x, g):
    xf = x.astype(F32)
    y = xf * lax.rsqrt(jnp.mean(xf * xf, axis=-1, keepdims=True) + NORM_EPS)
    return (y * g.astype(F32)).astype(x.dtype)


def project(h, w_in, b_f, lb):
    B, S = h.shape[0], h.shape[1]
    z = jnp.einsum('bsd,de->bse', h, w_in)
    fq, fk, fv, ff, fg, hq, hf, hi, hg = jnp.split(z, SPLIT_POINTS, axis=-1)
    fq = fq.reshape(B, S, FOX_HEADS, FOX_HEAD_DIM)
    fk = fk.reshape(B, S, FOX_HEADS, FOX_HEAD_DIM)
    fv = fv.reshape(B, S, FOX_HEADS, FOX_HEAD_DIM)
    fox_logf = jax.nn.log_sigmoid(ff.astype(F32) + b_f.astype(F32))
    zf = hf.astype(F32).reshape(B, S, HG_HEADS, HG_HEAD_DIM)
    lbr = lb.reshape(HG_HEADS, HG_HEAD_DIM)
    hg_logf = jnp.logaddexp(jnp.log(lbr), jnp.log1p(-lbr) + jax.nn.log_sigmoid(zf))
    hg_k = (1.0 - lbr) * jax.nn.sigmoid(-zf)
    hq = jax.nn.silu(hq).reshape(B, S, HG_HEADS, HG_HEAD_DIM)
    hi = hi.reshape(B, S, HG_HEADS, HG_HEAD_DIM)
    return fq, fk, fv, fox_logf, fg, hq, hg_logf, hg_k, hi, hg


def fox_attend(q, k, v, c_q, c_k, q_pos, k_pos):
    s = jnp.einsum('bqhd,bkhd->bhqk', q.astype(F32), k.astype(F32)) * (FOX_HEAD_DIM ** -0.5)
    s = s + (jnp.swapaxes(c_q, 1, 2)[..., :, None] - jnp.swapaxes(c_k, 1, 2)[..., None, :])
    mask = k_pos[None, :] <= q_pos[:, None]
    s = jnp.where(mask, s, -jnp.inf)
    p = jax.nn.softmax(s, axis=-1)
    return jnp.einsum('bhqk,bkhd->bqhd', p.astype(v.dtype), v)


def fox_prompt(q, k, v, logf):
    B, S = q.shape[0], q.shape[1]
    c = jnp.cumsum(logf, axis=1)
    pos = jnp.arange(S)

    def block(i):
        st = i * Q_BLOCK
        qb = lax.dynamic_slice_in_dim(q, st, Q_BLOCK, axis=1)
        cb = lax.dynamic_slice_in_dim(c, st, Q_BLOCK, axis=1)
        return fox_attend(qb, k, v, cb, c, st + jnp.arange(Q_BLOCK), pos)

    out = lax.map(block, jnp.arange(S // Q_BLOCK))
    return jnp.swapaxes(out, 0, 1).reshape(B, S, FOX_WIDTH)


def fox_sample(q, k, v, logf, ck, cv, clogf):
    B, T = q.shape[0], q.shape[1]
    P = ck.shape[1]
    kk = jnp.concatenate([ck.astype(k.dtype), k], axis=1)
    vv = jnp.concatenate([cv.astype(v.dtype), v], axis=1)
    c = jnp.cumsum(jnp.concatenate([clogf.astype(F32), logf], axis=1), axis=1)
    out = fox_attend(q, kk, vv, c[:, P:], c, P + jnp.arange(T), jnp.arange(P + T))
    return out.reshape(B, T, FOX_WIDTH)


def hgrn_chunk(S0, q, logf, k, v):
    q, k, v = q.astype(F32), k.astype(F32), v.astype(F32)
    L = q.shape[1]
    b = jnp.cumsum(logf, axis=1)
    o_inter = jnp.einsum('blhk,bhkv->blhv', q * jnp.exp(b), S0)
    causal = jnp.tril(jnp.ones((L, L), dtype=bool))
    diff = b[:, :, None] - b[:, None, :]
    decay = jnp.exp(jnp.where(causal[None, :, :, None, None], diff, -jnp.inf))
    A = jnp.einsum('bthk,btshk,bshk->bhts', q, decay, k)
    o = o_inter + jnp.einsum('bhts,bshv->bthv', A, v)
    b_last = b[:, -1]
    S_new = jnp.exp(b_last)[..., None] * S0 + jnp.einsum(
        'bshk,bshv->bhkv', jnp.exp(b_last[:, None] - b) * k, v)
    return o, S_new


def hgrn_prompt(q, logf, k, v):
    B, S = q.shape[0], q.shape[1]
    n_chunks = S // CHUNK

    def to_chunks(a):
        return jnp.swapaxes(a.reshape(B, n_chunks, CHUNK, *a.shape[2:]), 0, 1)

    def step(state, inp):
        o, s_new = hgrn_chunk(state, *inp)
        return s_new, o

    S0 = jnp.zeros((B, HG_HEADS, HG_HEAD_DIM, HG_HEAD_DIM), F32)
    S_fin, o = lax.scan(step, S0, (to_chunks(q), to_chunks(logf), to_chunks(k), to_chunks(v)))
    return jnp.swapaxes(o, 0, 1).reshape(B, S, HG_HEADS, HG_HEAD_DIM), S_fin


def merge(fox_o, fox_gate, hg_o, hg_gate, g_norm, w_out):
    B, S = fox_gate.shape[0], fox_gate.shape[1]
    dt = fox_gate.dtype
    fox_y = fox_o.reshape(B, S, FOX_WIDTH) * jax.nn.silu(fox_gate)
    hn = hg_o * lax.rsqrt(jnp.mean(hg_o * hg_o, axis=-1, keepdims=True) + NORM_EPS)
    hn = hn * g_norm.astype(F32).reshape(HG_HEADS, HG_HEAD_DIM)
    hg_y = hn.reshape(B, S, HG_WIDTH).astype(dt) * jax.nn.silu(hg_gate)
    return jnp.einsum('bse,ed->bsd', jnp.concatenate([fox_y, hg_y], axis=-1), w_out)


def setup_inputs(seed: int = 0) -> dict:
    key = jax.random.key(seed)
    ks = jax.random.split(key, 14)
    nrm = jax.random.normal
    return {
        "x_prompt": nrm(ks[0], (BATCH, SEQ, D_MODEL), F32),
        "x_sample": nrm(ks[1], (DEC_BATCH, DEC_SEQ, D_MODEL), F32),
        "cache_k": nrm(ks[2], (DEPTH, DEC_BATCH, PAST_LEN, FOX_HEADS, FOX_HEAD_DIM), F32),
        "cache_v": nrm(ks[3], (DEPTH, DEC_BATCH, PAST_LEN, FOX_HEADS, FOX_HEAD_DIM), F32),
        "cache_logf": jax.nn.log_sigmoid(2.0 + nrm(ks[4], (DEPTH, DEC_BATCH, PAST_LEN, FOX_HEADS), F32)),
        "state_hgrn": 0.5 * nrm(ks[5], (DEPTH, DEC_BATCH, HG_HEADS, HG_HEAD_DIM, HG_HEAD_DIM), F32),
        "norm_g": 1.0 + 0.01 * nrm(ks[6], (DEPTH, D_MODEL), F32),
        "w_in": nrm(ks[7], (DEPTH, D_MODEL, D_IN), F32) * (D_MODEL ** -0.5),
        "fox_b_f": 0.1 * nrm(ks[8], (DEPTH, FOX_HEADS), F32),
        "hg_lower": nrm(ks[9], (DEPTH, HG_WIDTH), F32),
        "hg_norm_g": 1.0 + 0.01 * nrm(ks[10], (DEPTH, HG_WIDTH), F32),
        "w_out": nrm(ks[11], (DEPTH, D_MIX, D_MODEL), F32) * (D_MIX ** -0.5),
        "final_g": 1.0 + 0.01 * nrm(ks[12], (D_MODEL,), F32),
    }


def reference(x_prompt, x_sample, cache_k, cache_v, cache_logf, state_hgrn,
              norm_g, w_in, fox_b_f, hg_lower, hg_norm_g, w_out, final_g):
    lb_all = jnp.cumsum(jax.nn.softmax(hg_lower.astype(F32), axis=0), axis=0)

    xp = x_prompt
    kp, vp, lfp, sp = [], [], [], []
    for l in range(DEPTH):
        lb = lb_all[l] - lb_all[0]
        h = rmsnorm(xp, norm_g[l])
        fq, fk, fv, flogf, fg, hq, hlogf, hk, hi, hg = project(h, w_in[l], fox_b_f[l], lb)
        fox_o = fox_prompt(fq, fk, fv, flogf)
        hg_o, s_fin = hgrn_prompt(hq, hlogf, hk, hi)
        xp = xp + merge(fox_o, fg, hg_o, hg, hg_norm_g[l], w_out[l])
        kp.append(fk); vp.append(fv); lfp.append(flogf); sp.append(s_fin)
    y_prompt = rmsnorm(xp, final_g)

    xs = x_sample
    ksm, vsm, lfs, ss = [], [], [], []
    for l in range(DEPTH):
        lb = lb_all[l] - lb_all[0]
        h = rmsnorm(xs, norm_g[l])
        fq, fk, fv, flogf, fg, hq, hlogf, hk, hi, hg = project(h, w_in[l], fox_b_f[l], lb)
        fox_o = fox_sample(fq, fk, fv, flogf, cache_k[l], cache_v[l], cache_logf[l])
        hg_o, s_new = hgrn_chunk(state_hgrn[l].astype(F32), hq, hlogf, hk, hi)
        xs = xs + merge(fox_o, fg, hg_o, hg, hg_norm_g[l], w_out[l])
        ksm.append(fk); vsm.append(fv); lfs.append(flogf); ss.append(s_new)
    y_sample = rmsnorm(xs, final_g)

    return (y_prompt, y_sample,
            jnp.stack(kp), jnp.stack(vp), jnp.stack(lfp), jnp.stack(sp),
            jnp.stack(ksm), jnp.stack(vsm), jnp.stack(lfs), jnp.stack(ss))
```

```cpp
#include <hip/hip_runtime.h>
#include <hip/hip_cooperative_groups.h>
#include <cstdio>
#include <cstdint>
namespace cg = cooperative_groups;
namespace pg8 {
#define PG8_LAS __attribute__((address_space(3)))
typedef unsigned short bf16_t;
typedef short bf16x8 __attribute__((ext_vector_type(8)));
typedef float f32x4 __attribute__((ext_vector_type(4)));
typedef unsigned u32x4 __attribute__((ext_vector_type(4)));
constexpr int BM = 256, BK = 64, HALF = 128, HTB = HALF * BK * 2  , STAGE_BYTES = 8 * HTB, NXCD = 8, WGM = 8;

__host__ __device__ __forceinline__ int lds_byte(int r, int c) { const int st = (r >> 4) * 2 + (c >> 5), rr = r & 15, cc = c & 31, ob = rr * 64 + cc * 2; return st * 1024 + (ob ^ (((ob >> 9) & 1) << 5)); }
__host__ __device__ __forceinline__ void stage_rc(int b, int& R, int& C) { const int st = b / 1024, sb = b % 1024, swz = sb ^ (((sb >> 9) & 1) << 5); R = (st >> 1) * 16 + swz / 64; C = (st & 1) * 32 + (swz % 64) / 2; }
__host__ __device__ __forceinline__ int perm32(int rho) { const int n = rho >> 4, i = rho & 15; return 8 * (i >> 2) + 4 * n + (i & 3); }

struct Unit { int pm, pn; };
struct Gemm { const bf16_t* A; const bf16_t* Bt; int M, N, K; };

struct StaticOrder {
    int nM, nN, nwg, G, c;
    __host__ __device__ void init(int M, int N, int G_, int c_) { nM = M / BM; nN = N / BM; nwg = nM * nN; G = G_; c = c_; }
    __host__ __device__ bool next(int i, Unit& u) const {
        const long L = (long)i * G + c; if (L >= nwg) return false;
        int wgid = (int)L; { const int q = nwg / NXCD, r = nwg % NXCD, xcd = wgid % NXCD, off = wgid / NXCD; wgid = (xcd < r ? xcd * (q + 1) : r * (q + 1) + (xcd - r) * q) + off; }
        const int nig = WGM * nN, gid = wgid / nig, fm = gid * WGM, gsz = (nM - fm) < WGM ? (nM - fm) : WGM;
        u.pm = fm + ((wgid % nig) % gsz); u.pn = (wgid % nig) / gsz; return true;
    }
    __device__ __forceinline__ void a_ready(const Unit&) const {}
    __device__ __forceinline__ void done(const Unit&) const {}
};

template <class Epi, class Sched, bool ALIGN_EPI = false, bool SP2 = false>
__device__ __forceinline__ void gemm_phase(PG8_LAS unsigned char* lds, const Gemm g, const Sched& S, const Epi& E) {
    int tid_ = threadIdx.x; asm volatile("" : "+v"(tid_));
    const int tid = tid_, wid = __builtin_amdgcn_readfirstlane(tid >> 6), lane = tid & 63, wr = wid >> 2, wc = wid & 3, fr = lane & 15, fq = lane >> 4;
    const int K = g.K, nt = K / BK;
    unsigned voffA[2], voffB[2];
#pragma unroll
    for (int i = 0; i < 2; ++i) { int R, C; stage_rc(tid * 16 + i * 8192, R, C); const int Rb = Epi::PERM ? ((R & ~31) + perm32(R & 31)) : R;
        voffA[i] = (unsigned)(R * K + C) * 2u; voffB[i] = (unsigned)(Rb * K + C) * 2u; }
    const size_t kstep = (size_t)(BK * 2);
    const size_t hstep = (size_t)HALF * K * 2;
    const size_t tstep = 2 * hstep;
    const unsigned ldsw = (unsigned)wid * 1024u;
    const int aoff = lds_byte(wr * 64 + fr, fq * 8), boff = lds_byte(wc * 32 + fr, fq * 8);
#define PG8_SA(b, h) (((b) * 2 + (h)) * HTB)
#define PG8_SB(b, h) ((4 + (b) * 2 + (h)) * HTB)
#define PG8_STAGE(bufoff, gbase, voff) do { _Pragma("unroll") for (int _i = 0; _i < 2; ++_i) \
        __builtin_amdgcn_global_load_lds((const unsigned*)((const char*)(gbase) + (voff)[_i]), (PG8_LAS unsigned*)(lds + (bufoff) + ldsw + _i * 8192), 16, 0, 0); } while (0)
#define PG8_LDA(dst, b, h) do { _Pragma("unroll") for (int m = 0; m < 4; ++m) _Pragma("unroll") for (int k = 0; k < 2; ++k) dst[m][k] = *(const PG8_LAS bf16x8*)(lds + PG8_SA(b, h) + aoff + m * 2048 + k * 1024); } while (0)
#define PG8_LDB(dst, b, h) do { _Pragma("unroll") for (int n = 0; n < 2; ++n) _Pragma("unroll") for (int k = 0; k < 2; ++k) dst[n][k] = *(const PG8_LAS bf16x8*)(lds + PG8_SB(b, h) + boff + n * 2048 + k * 1024); } while (0)
#define PG8_MMA(ai, bj, At, Bt) do { __builtin_amdgcn_s_setprio(1); _Pragma("unroll") for (int m = 0; m < 4; ++m) _Pragma("unroll") for (int n = 0; n < 2; ++n) _Pragma("unroll") for (int k = 0; k < 2; ++k) \
        acc[ai][bj][m][n] = __builtin_amdgcn_mfma_f32_16x16x32_bf16(Bt[n][k], At[m][k], acc[ai][bj][m][n], 0, 0, 0); __builtin_amdgcn_s_setprio(0); } while (0)
#define PG8_WAIT_V(n) asm volatile("s_waitcnt vmcnt(" #n ")" ::: "memory")
#define PG8_WAIT_L(n) asm volatile("s_waitcnt lgkmcnt(" #n ")" ::: "memory")
#define PG8_BAR __builtin_amdgcn_s_barrier()
#define PG8_SCHED __builtin_amdgcn_sched_barrier(0)
    Unit cur, nxt; int ui = 0;
    if (!S.next(0, cur)) return;
    f32x4 acc[2][2][4][2];
#pragma unroll
    for (int a = 0; a < 2; ++a)
#pragma unroll
        for (int b = 0; b < 2; ++b)
#pragma unroll
            for (int m = 0; m < 4; ++m)
#pragma unroll
                for (int n = 0; n < 2; ++n) acc[a][b][m][n] = (f32x4){0.f, 0.f, 0.f, 0.f};
    bf16x8 At[4][2], B0[2][2], B1[2][2];
    const char* cA = (const char*)g.A + (size_t)cur.pm * tstep; const char* cB = (const char*)g.Bt + (size_t)cur.pn * tstep;
    S.a_ready(cur);
    if constexpr (SP2) {
        PG8_STAGE(PG8_SB(0, 0), cB, voffB); PG8_STAGE(PG8_SB(0, 1), cB + hstep, voffB); PG8_STAGE(PG8_SA(0, 0), cA, voffA); PG8_STAGE(PG8_SA(0, 1), cA + hstep, voffA);
        if (wr == 1) PG8_BAR;
        PG8_WAIT_V(2); PG8_BAR;
        PG8_STAGE(PG8_SB(1, 0), cB + kstep, voffB); PG8_STAGE(PG8_SA(1, 0), cA + kstep, voffA); PG8_STAGE(PG8_SB(1, 1), cB + hstep + kstep, voffB);
        PG8_WAIT_V(6); PG8_BAR;
    } else {
        PG8_STAGE(PG8_SB(0, 0), cB, voffB); PG8_STAGE(PG8_SA(0, 0), cA, voffA); PG8_STAGE(PG8_SB(0, 1), cB + hstep, voffB); PG8_STAGE(PG8_SA(0, 1), cA + hstep, voffA);
        if (wr == 1) PG8_BAR;
        PG8_WAIT_V(4); PG8_BAR;
        PG8_STAGE(PG8_SB(1, 0), cB + kstep, voffB); PG8_STAGE(PG8_SA(1, 0), cA + kstep, voffA); PG8_STAGE(PG8_SB(1, 1), cB + hstep + kstep, voffB);
        PG8_WAIT_V(6); PG8_BAR;
    }
    for (;;) {
        const bool has_next = S.next(ui + 1, nxt);
        const char* nA = has_next ? (const char*)g.A + (size_t)nxt.pm * tstep : cA; const char* nB = has_next ? (const char*)g.Bt + (size_t)nxt.pn * tstep : cB;
        for (int t = 0; t < nt; t += 2) {
            const bool last = (t == nt - 2);
            const char* a1 = cA + (size_t)(t + 1) * kstep;
            const char* a2 = last ? nA : cA + (size_t)(t + 2) * kstep; const char* b2 = last ? nB : cB + (size_t)(t + 2) * kstep;
            const char* a3 = a2 + kstep; const char* b3 = b2 + kstep;
            if (last && has_next) S.a_ready(nxt);
            if constexpr (SP2) {
            PG8_LDB(B0, 0, 0); PG8_LDB(B1, 0, 1); PG8_SCHED; PG8_LDA(At, 0, 0); PG8_STAGE(PG8_SA(1, 1), a1 + hstep, voffA);
            PG8_WAIT_V(8); PG8_WAIT_L(0); PG8_BAR; PG8_MMA(0, 0, At, B0); PG8_MMA(0, 1, At, B1); PG8_BAR; PG8_SCHED;
            PG8_LDA(At, 0, 1); PG8_STAGE(PG8_SB(0, 0), b2, voffB); PG8_STAGE(PG8_SB(0, 1), b2 + hstep, voffB); PG8_STAGE(PG8_SA(0, 0), a2, voffA);
            PG8_WAIT_V(8); PG8_WAIT_L(0); PG8_BAR; PG8_MMA(1, 0, At, B0); PG8_MMA(1, 1, At, B1); PG8_BAR; PG8_SCHED;
            PG8_LDB(B0, 1, 0); PG8_LDB(B1, 1, 1); PG8_SCHED; PG8_LDA(At, 1, 0); PG8_STAGE(PG8_SA(0, 1), a2 + hstep, voffA);
            PG8_WAIT_V(8); PG8_WAIT_L(0); PG8_BAR; PG8_MMA(0, 0, At, B0); PG8_MMA(0, 1, At, B1); PG8_BAR; PG8_SCHED;
            PG8_LDA(At, 1, 1); PG8_STAGE(PG8_SB(1, 0), b3, voffB); PG8_STAGE(PG8_SB(1, 1), b3 + hstep, voffB); PG8_STAGE(PG8_SA(1, 0), a3, voffA);
            PG8_WAIT_V(8); PG8_WAIT_L(0); PG8_BAR; PG8_MMA(1, 0, At, B0); PG8_MMA(1, 1, At, B1); PG8_BAR; PG8_SCHED;
            } else {
            PG8_LDB(B0, 0, 0); PG8_SCHED; PG8_LDA(At, 0, 0); PG8_STAGE(PG8_SA(1, 1), a1 + hstep, voffA);
            PG8_WAIT_L(8); PG8_BAR; PG8_WAIT_L(0); PG8_MMA(0, 0, At, B0); PG8_BAR; PG8_SCHED;
            PG8_LDB(B1, 0, 1); PG8_STAGE(PG8_SB(0, 0), b2, voffB);
            PG8_BAR; PG8_WAIT_L(0); PG8_MMA(0, 1, At, B1); PG8_BAR;
            PG8_LDA(At, 0, 1); PG8_STAGE(PG8_SA(0, 0), a2, voffA);
            PG8_BAR; PG8_WAIT_L(0); PG8_MMA(1, 0, At, B0); PG8_BAR; PG8_SCHED;
            PG8_STAGE(PG8_SB(0, 1), b2 + hstep, voffB);
            PG8_WAIT_V(6); PG8_BAR; PG8_MMA(1, 1, At, B1); PG8_BAR;
            PG8_LDB(B0, 1, 0); PG8_SCHED; PG8_LDA(At, 1, 0); PG8_STAGE(PG8_SA(0, 1), a2 + hstep, voffA);
            PG8_WAIT_L(8); PG8_BAR; PG8_WAIT_L(0); PG8_MMA(0, 0, At, B0); PG8_BAR; PG8_SCHED;
            PG8_LDB(B1, 1, 1); PG8_STAGE(PG8_SB(1, 0), b3, voffB);
            PG8_BAR; PG8_WAIT_L(0); PG8_MMA(0, 1, At, B1); PG8_BAR;
            PG8_LDA(At, 1, 1); PG8_STAGE(PG8_SA(1, 0), a3, voffA);
            PG8_BAR; PG8_WAIT_L(0); PG8_MMA(1, 0, At, B0); PG8_BAR; PG8_SCHED;
            PG8_STAGE(PG8_SB(1, 1), b3 + hstep, voffB);
            PG8_WAIT_V(6); PG8_BAR; PG8_MMA(1, 1, At, B1); PG8_BAR;
            }
        }
        if constexpr (ALIGN_EPI) { if (wr == 0) PG8_BAR; }
        if constexpr (!Epi::AFTER_DRAIN) { E(acc, cur, wr, wc, fr, fq); S.done(cur); }
        if (!has_next) break;
#pragma unroll
        for (int a = 0; a < 2; ++a)
#pragma unroll
            for (int b = 0; b < 2; ++b)
#pragma unroll
                for (int m = 0; m < 4; ++m)
#pragma unroll
                    for (int n = 0; n < 2; ++n) acc[a][b][m][n] = (f32x4){0.f, 0.f, 0.f, 0.f};
        cur = nxt; cA = nA; cB = nB; ++ui;
        if constexpr (ALIGN_EPI) { if (wr == 1) PG8_BAR; }
    }
    PG8_WAIT_V(0);
    if constexpr (!ALIGN_EPI) { if (wr == 0) PG8_BAR; }
    PG8_BAR;
    if constexpr (Epi::AFTER_DRAIN) { E.fused(acc, cur, wr, wc, fr, fq, lds, wid, lane); S.done(cur); }
#undef PG8_SA
#undef PG8_SB
#undef PG8_STAGE
#undef PG8_LDA
#undef PG8_LDB
#undef PG8_MMA
#undef PG8_WAIT_V
#undef PG8_WAIT_L
#undef PG8_BAR
#undef PG8_SCHED
}
}

#define LAS __attribute__((address_space(3)))
typedef unsigned short bf16_t;
typedef short bf16x8 __attribute__((ext_vector_type(8)));
typedef float f32x4 __attribute__((ext_vector_type(4)));
typedef float f32x16 __attribute__((ext_vector_type(16)));
typedef unsigned u32x4 __attribute__((ext_vector_type(4)));
typedef unsigned u32x2 __attribute__((ext_vector_type(2)));

constexpr int DMODEL = 1024, SEQ = 8192, NBAT = 8, DEPTH = 2, DBAT = 16, DSEQ = 64, PAST = 2048;
constexpr int MP = NBAT * SEQ;
constexpr int MS = DBAT * DSEQ;
constexpr int MT = MP + MS;
constexpr int DIN = 4104, NPAD = 4352;
constexpr int SKV = PAST + DSEQ;
constexpr int KSROWS = DBAT * SKV;
constexpr int KROWS = MP + KSROWS;
constexpr int NG = MT / 64;
constexpr int NKT = KROWS / 64;
constexpr float EPS = 1e-6f;
constexpr float LOG2E = 1.4426950408889634f;
constexpr float QSCALE = 0.125f * LOG2E;

constexpr size_t OFF_Y = 0;
constexpr size_t OFF_KP = (size_t)MT * 1024;
constexpr size_t OFF_VP = OFF_KP + (size_t)DEPTH * MP * 512;
constexpr size_t OFF_LP = OFF_VP + (size_t)DEPTH * MP * 512;
constexpr size_t OFF_HP = OFF_LP + (size_t)DEPTH * MP * 8;
constexpr size_t OFF_KS = OFF_HP + (size_t)DEPTH * NBAT * 4 * 16384;
constexpr size_t OFF_VS = OFF_KS + (size_t)DEPTH * MS * 512;
constexpr size_t OFF_LS = OFF_VS + (size_t)DEPTH * MS * 512;
constexpr size_t OFF_HS = OFF_LS + (size_t)DEPTH * MS * 8;
constexpr size_t OUT_TOTAL = OFF_HS + (size_t)DEPTH * DBAT * 4 * 16384;

constexpr size_t al256(size_t x) { return (x + 255) & ~(size_t)255; }
constexpr size_t WS_CTL = 0;
constexpr size_t WS_BAR = 8192;
constexpr size_t WS_WTIN = 32768;
constexpr size_t WS_WTOUT = WS_WTIN + al256((size_t)DEPTH * NPAD * 1024 * 2);
constexpr size_t WS_XB = WS_WTOUT + al256((size_t)DEPTH * 1024 * 1024 * 2);
constexpr size_t WS_YC = WS_XB + al256((size_t)MT * 1024 * 2);
constexpr size_t WS_QB = WS_YC + al256((size_t)MT * 1024 * 2);
constexpr size_t WS_KBP = WS_QB + al256((size_t)MT * 512 * 2);
constexpr size_t WS_KBS = WS_KBP + al256((size_t)MP * 512 * 2);
constexpr size_t WS_VTP = WS_KBS + al256((size_t)DEPTH * KSROWS * 512 * 2);
constexpr size_t WS_VTS = WS_VTP + al256((size_t)MP * 512 * 2);
constexpr size_t WS_QE = WS_VTS + al256((size_t)DEPTH * KSROWS * 512 * 2);
constexpr size_t WS_HF = WS_QE + al256((size_t)MT * 512 * 2);
constexpr size_t WS_KDT = WS_HF + al256((size_t)MT * 512 * 4);
constexpr size_t WS_VTH = WS_KDT + al256((size_t)NG * 4 * 8192 * 2);
constexpr size_t WS_DG = WS_VTH + al256((size_t)NG * 4 * 8192 * 2);
constexpr size_t WS_CL = WS_DG + al256((size_t)NG * 4 * 128 * 4);
constexpr size_t WS_BT = WS_CL + al256((size_t)DEPTH * KROWS * 8 * 4);
constexpr size_t WS_SS = WS_BT + al256((size_t)DEPTH * NKT * 8 * 4);
constexpr size_t WS_CM = WS_SS + al256((size_t)16 * MT * 4);
constexpr size_t WS_KN = WS_CM + al256((size_t)DEPTH * NKT * 8 * 4);
constexpr size_t WS_LG = WS_KN + al256((size_t)DEPTH * NKT * 8 * 4);
constexpr size_t WS_LB = WS_LG + al256((size_t)NG * 4 * 128 * 4);
constexpr size_t WS_END = WS_LB + al256((size_t)256 * 16384 * 4);

static_assert(WS_END <= (size_t)1073741824, "d_ws map must fit 1 GiB");
constexpr int LDS_BYTES = 147456;
constexpr int LDS_MISC = 131072;

struct Params {
    const float* in[13];
    float* out;
    unsigned char* ws;
};

__device__ __forceinline__ unsigned pk2(float lo, float hi) {
    typedef float f2_t __attribute__((ext_vector_type(2))); typedef __bf16 b2_t __attribute__((ext_vector_type(2)));
    f2_t v = {lo, hi}; b2_t b = __builtin_convertvector(v, b2_t); return __builtin_bit_cast(unsigned, b);
}
__device__ __forceinline__ float bf2f(unsigned short b) { return __uint_as_float((unsigned)b << 16); }
__device__ __forceinline__ float bflo(unsigned w) { return __uint_as_float(w << 16); }
__device__ __forceinline__ float bfhi(unsigned w) { return __uint_as_float(w & 0xffff0000u); }
__device__ __forceinline__ unsigned short f2bf(float f) { return (unsigned short)(pk2(f, 0.f) & 0xffffu); }
__device__ __forceinline__ float fsilu(float x) { return x * __builtin_amdgcn_rcpf(1.f + __expf(-x)); }
__device__ __forceinline__ float logsig(float z) { return fminf(z, 0.f) - __logf(1.f + __expf(-fabsf(z))); }
__device__ __forceinline__ float wave_sum(float v) {
#pragma unroll
    for (int o = 1; o < 64; o <<= 1) v += __shfl_xor(v, o);
    return v;
}
__device__ __forceinline__ float wave_scan_incl(float v, int lane) {
#pragma unroll
    for (int o = 1; o < 64; o <<= 1) { float t = __shfl_up(v, o); if (lane >= o) v += t; }
    return v;
}
__device__ __forceinline__ float wave_scan_max(float v, int lane) {
#pragma unroll
    for (int o = 1; o < 64; o <<= 1) { float t = __shfl_up(v, o); if (lane >= o) v = fmaxf(v, t); }
    return v;
}
__device__ __forceinline__ float wave_min(float v) {
#pragma unroll
    for (int o = 1; o < 64; o <<= 1) v = fminf(v, __shfl_xor(v, o));
    return v;
}
__device__ __forceinline__ float sq8(u32x4 w) {
    float s = 0.f;
#pragma unroll
    for (int i = 0; i < 4; ++i) { const float a = bflo(w[i]), b = bfhi(w[i]); s += a * a + b * b; }
    return s;
}
#define XB_TMO      128
#define XB_XCNT(j)  (256  + 64 * (j))
#define XB_XSUB(j)  (1280 + 64 * (j))
#define XB_XGEN(j)  (2304 + 64 * (j))
#define XB_TOP      3328
#define XB_TOPGEN   3392
#define XCD_BAR_WORDS 3456
#define XB_SPIN_CAP (1u << 18)

__device__ __forceinline__ unsigned xb_ld(unsigned* p)              { return __hip_atomic_load(p, __ATOMIC_RELAXED, __HIP_MEMORY_SCOPE_AGENT); }
__device__ __forceinline__ unsigned xb_add(unsigned* p, unsigned v) { return __hip_atomic_fetch_add(p, v, __ATOMIC_RELAXED, __HIP_MEMORY_SCOPE_AGENT); }
__device__ __forceinline__ unsigned xb_xcc_id() { return (unsigned)__builtin_amdgcn_s_getreg((3 << 11) | 20) & 0xFu; }
#define XB_SPIN(cond, bar) do { unsigned _sp = 0; while (cond) { __builtin_amdgcn_s_sleep(1); \
    if ((++_sp & 255u) == 0u) { if (xb_ld(&(bar)[XB_TMO])) break; if (_sp > XB_SPIN_CAP) { atomicAdd(&(bar)[XB_TMO], 1u); break; } } } } while (0)

struct XcdBarrier {
    unsigned* bar; unsigned x;
    volatile LAS unsigned* st;
};

__device__ __forceinline__ XcdBarrier xcd_barrier_post(unsigned* bar, volatile LAS unsigned* st) {
    XcdBarrier b; b.bar = bar; b.x = xb_xcc_id(); b.st = st;
    if (threadIdx.x == 0) (void)xb_add(&bar[XB_XCNT(b.x)], 1u);
    return b;
}
__device__ __forceinline__ void xcd_barrier_complete(unsigned* bar, unsigned x, unsigned& nloc, unsigned& nx) {
    const unsigned G = gridDim.x * gridDim.y * gridDim.z;
    unsigned sum, cnt, mine, sp = 0u;
    for (;;) {
        sum = 0u; cnt = 0u; mine = 0u;
#pragma unroll
        for (unsigned j = 0; j < 16; ++j) { const unsigned c = xb_ld(&bar[XB_XCNT(j)]); sum += c; cnt += (c > 0u) ? 1u : 0u; mine = (j == x) ? c : mine; }
        if (sum == G) break;
        __builtin_amdgcn_s_sleep(1);
        if ((++sp & 255u) == 0u) { if (xb_ld(&bar[XB_TMO])) break; if (sp > XB_SPIN_CAP) { atomicAdd(&bar[XB_TMO], 1u); break; } }
    }
    nloc = mine > 0u ? mine : 1u; nx = cnt > 0u ? cnt : 1u;
}

__device__ __forceinline__ void xcd_barrier(const XcdBarrier& b) {
    asm volatile("s_waitcnt vmcnt(0)" ::: "memory");
    __syncthreads();
    if (threadIdx.x == 0) {
        unsigned* bar = b.bar;
        __builtin_amdgcn_s_waitcnt(0);
        unsigned nloc = b.st[0], nx = b.st[1];
        if (nloc == 0u) { xcd_barrier_complete(bar, b.x, nloc, nx); b.st[0] = nloc; b.st[1] = nx; }
        const unsigned old = xb_add(&bar[XB_XSUB(b.x)], 1u);
        const unsigned gen = old / nloc;
        if (old + 1u == (gen + 1u) * nloc) {
            __builtin_amdgcn_fence(__ATOMIC_RELEASE, "agent");
            asm volatile("s_waitcnt vmcnt(0)" ::: "memory");
            const unsigned og = xb_add(&bar[XB_TOP], 1u);
            const unsigned tg = og / nx;
            if (og + 1u == (tg + 1u) * nx) xb_add(&bar[XB_TOPGEN], 1u);
            else XB_SPIN(xb_ld(&bar[XB_TOPGEN]) == tg, bar);
            __builtin_amdgcn_fence(__ATOMIC_ACQUIRE, "agent");
            xb_add(&bar[XB_XGEN(b.x)], 1u);
            asm volatile("s_waitcnt vmcnt(0)" ::: "memory");
        } else {
            XB_SPIN(xb_ld(&bar[XB_XGEN(b.x)]) == gen, bar);
            __builtin_amdgcn_fence(__ATOMIC_ACQUIRE, "agent");
            asm volatile("s_waitcnt vmcnt(0)" ::: "memory");
        }
    }
    __syncthreads();
}

typedef short v4i16_t __attribute__((ext_vector_type(4)));
__device__ __forceinline__ u32x2 ldtr(LAS unsigned char* p) { const v4i16_t v = __builtin_amdgcn_ds_read_tr16_b64_v4i16((LAS v4i16_t*)p); return __builtin_bit_cast(u32x2, v); }
#define LDSW() asm volatile("s_waitcnt lgkmcnt(0)" ::: "memory")

__device__ __forceinline__ float row_rs(const float* SS, int r, int fq) {
    const f32x4 p4 = *(const f32x4*)(SS + (size_t)r * 16 + 4 * fq);
    float s = (p4[0] + p4[1]) + (p4[2] + p4[3]);
    s += __shfl_xor(s, 16); s += __shfl_xor(s, 32);
    return rsqrtf(s * (1.0f / 1024.0f) + EPS);
}
struct EpiIn {
    static constexpr bool PERM = true, AFTER_DRAIN = false;
    unsigned char* ws; float* out; const float* bfv; int layer;
    pg8::StaticOrder S; LAS unsigned char* rsl; mutable int ui;
    __device__ __forceinline__ void operator()(const f32x4 (&acc)[2][2][4][2], const pg8::Unit& u, int wr, int wc, int fr, int fq) const {
        unsigned char* ws = this->ws; float* out = this->out; const float* bfv = this->bfv;
        size_t zo = 0;
        asm volatile("" : "+v"(fr), "+v"(fq), "+s"(wr), "+s"(wc), "+s"(zo));
        ws += zo; out += zo; bfv += zo;
        const int cat = u.pn >> 1;
        const int rowb = u.pm * 256 + wr * 64 + fr;
        const bool samp = (u.pm >= MP / 256);
        const float* SS = (const float*)(ws + WS_SS);
        const int cb = (u.pn & 1) * 256 + wc * 32 + 8 * fq;
        LAS float* slot = (LAS float*)(rsl + (wr * 4 + wc) * 512);
        float rs[2][4];
        if (ui == 0) {
#pragma unroll
            for (int ai = 0; ai < 2; ++ai)
#pragma unroll
                for (int m = 0; m < 4; ++m) rs[ai][m] = row_rs(SS, rowb + ai * 128 + m * 16, fq);
        } else {
#pragma unroll
            for (int ai = 0; ai < 2; ++ai)
#pragma unroll
                for (int m = 0; m < 4; ++m) rs[ai][m] = slot[(ai * 4 + m) * 16 + fr];
        }
        pg8::Unit nx; const bool hasn = S.next(ui + 1, nx);
        f32x4 np[8];
        if (hasn) { const int nrowb = nx.pm * 256 + wr * 64 + fr;
#pragma unroll
            for (int q = 0; q < 8; ++q) np[q] = *(const f32x4*)(SS + (size_t)(nrowb + (q >> 2) * 128 + (q & 3) * 16) * 16 + 4 * fq); }
        if (cat == 0 || cat == 3 || cat == 4 || cat == 6 || cat == 7) {
            bf16_t* base; int pitch;
            if (cat == 0) { base = (bf16_t*)(ws + WS_QB); pitch = 512; } else if (cat == 3) { base = (bf16_t*)(ws + WS_YC); pitch = 1024; }
            else if (cat == 4) { base = (bf16_t*)(ws + WS_QE); pitch = 512; } else if (cat == 6) { base = (bf16_t*)(ws + WS_VTH); pitch = 512; } else { base = (bf16_t*)(ws + WS_YC) + 512; pitch = 1024; }
#pragma unroll
            for (int ai = 0; ai < 2; ++ai)
#pragma unroll
                for (int m = 0; m < 4; ++m) { const int r = rowb + ai * 128 + m * 16; const float sc = rs[ai][m];
#pragma unroll
                    for (int bj = 0; bj < 2; ++bj) { u32x4 w;
#pragma unroll
                        for (int n = 0; n < 2; ++n) { f32x4 v = acc[ai][bj][m][n] * sc;
                            if (cat == 0) v = v * QSCALE; else if (cat != 6) { v[0] = fsilu(v[0]); v[1] = fsilu(v[1]); v[2] = fsilu(v[2]); v[3] = fsilu(v[3]); }
                            w[2 * n] = pk2(v[0], v[1]); w[2 * n + 1] = pk2(v[2], v[3]); }
                        *(u32x4*)(base + (size_t)r * pitch + cb + bj * 128) = w; } }
        } else if (cat == 1 || cat == 2) {
#pragma unroll
            for (int ai = 0; ai < 2; ++ai)
#pragma unroll
                for (int m = 0; m < 4; ++m) { const int r = rowb + ai * 128 + m * 16; const float sc = rs[ai][m];
                    float* fo; bf16_t* bo;
                    if (!samp) { fo = out + (cat == 1 ? OFF_KP : OFF_VP) + ((size_t)layer * MP + r) * 512; bo = (bf16_t*)(ws + (cat == 1 ? WS_KBP : WS_VTP)) + (size_t)r * 512; }
                    else { const int q = r - MP; fo = out + (cat == 1 ? OFF_KS : OFF_VS) + ((size_t)layer * MS + q) * 512; bo = (bf16_t*)(ws + (cat == 1 ? WS_KBS : WS_VTS)) + ((size_t)layer * KSROWS + (size_t)((q >> 6) * SKV + PAST + (q & 63))) * 512; }
#pragma unroll
                    for (int bj = 0; bj < 2; ++bj) { u32x4 w;
#pragma unroll
                        for (int n = 0; n < 2; ++n) { const f32x4 v = acc[ai][bj][m][n] * sc; *(f32x4*)(fo + cb + bj * 128 + 4 * n) = v; w[2 * n] = pk2(v[0], v[1]); w[2 * n + 1] = pk2(v[2], v[3]); }
                        *(u32x4*)(bo + cb + bj * 128) = w; } }
        } else if (cat == 5) {
            float* HF = (float*)(ws + WS_HF);
#pragma unroll
            for (int ai = 0; ai < 2; ++ai)
#pragma unroll
                for (int m = 0; m < 4; ++m) { const int r = rowb + ai * 128 + m * 16; const float sc = rs[ai][m];
#pragma unroll
                    for (int bj = 0; bj < 2; ++bj)
#pragma unroll
                        for (int n = 0; n < 2; ++n) *(f32x4*)(HF + (size_t)r * 512 + cb + bj * 128 + n * 4) = acc[ai][bj][m][n] * sc; }
        } else {
            const f32x4 b0 = *(const f32x4*)(bfv), b1 = *(const f32x4*)(bfv + 4);
#pragma unroll
            for (int ai = 0; ai < 2; ++ai)
#pragma unroll
                for (int m = 0; m < 4; ++m) { const int r = rowb + ai * 128 + m * 16; const float sc = rs[ai][m];
                    if (wc == 0 && fq == 0) {
                        const f32x4 v0 = acc[ai][0][m][0] * sc + b0, v1 = acc[ai][0][m][1] * sc + b1; f32x4 o0, o1;
#pragma unroll
                        for (int i = 0; i < 4; ++i) { o0[i] = logsig(v0[i]); o1[i] = logsig(v1[i]); }
                        float* dst = samp ? (out + OFF_LS + ((size_t)layer * MS + (r - MP)) * 8) : (out + OFF_LP + ((size_t)layer * MP + r) * 8);
                        *(f32x4*)(dst) = o0; *(f32x4*)(dst + 4) = o1; } }
        }
        if (hasn) {
#pragma unroll
            for (int q = 0; q < 8; ++q) { float s_ = (np[q][0] + np[q][1]) + (np[q][2] + np[q][3]); s_ += __shfl_xor(s_, 16); s_ += __shfl_xor(s_, 32);
                if (fq == 0) slot[q * 16 + fr] = rsqrtf(s_ * (1.0f / 1024.0f) + EPS); }
        }
        ++ui;
    }
};

struct OneUnit {
    int pm, pn;
    __device__ __forceinline__ bool next(int i, pg8::Unit& u) const { if (i != 0) return false; u.pm = pm; u.pn = pn; return true; }
    __device__ __forceinline__ void a_ready(const pg8::Unit&) const {}
    __device__ __forceinline__ void done(const pg8::Unit&) const {}
};
struct EpiOut {
    static constexpr bool PERM = true, AFTER_DRAIN = false;
    bf16_t* XB;
    float* SS;
    __device__ __forceinline__ void operator()(const f32x4 (&acc)[2][2][4][2], const pg8::Unit& u, int wr, int wc, int fr, int fq) const {
        bf16_t* XB = this->XB; float* SS = this->SS;
        size_t zo = 0;
        asm volatile("" : "+v"(fr), "+v"(fq), "+s"(wr), "+s"(wc), "+s"(zo));
        XB += zo; SS += zo;
        const int rowb = u.pm * 256 + wr * 64 + fr;
        const int cb = u.pn * 256 + wc * 32 + 8 * fq;
#pragma unroll
        for (int ai = 0; ai < 2; ++ai)
#pragma unroll
            for (int m = 0; m < 4; ++m) { const int r = rowb + ai * 128 + m * 16;
                u32x4 rw[2];
#pragma unroll
                for (int bj = 0; bj < 2; ++bj) rw[bj] = *(const u32x4*)(XB + (size_t)r * 1024 + cb + bj * 128);
                float ss = 0.f;
#pragma unroll
                for (int bj = 0; bj < 2; ++bj) { u32x4 w;
#pragma unroll
                    for (int n = 0; n < 2; ++n) { f32x4 v = acc[ai][bj][m][n];
                        v[0] += bflo(rw[bj][2 * n]); v[1] += bfhi(rw[bj][2 * n]); v[2] += bflo(rw[bj][2 * n + 1]); v[3] += bfhi(rw[bj][2 * n + 1]);
                        ss += (v[0] * v[0] + v[1] * v[1]) + (v[2] * v[2] + v[3] * v[3]);
                        w[2 * n] = pk2(v[0], v[1]); w[2 * n + 1] = pk2(v[2], v[3]); }
                    *(u32x4*)(XB + (size_t)r * 1024 + cb + bj * 128) = w; }
                ss += __shfl_xor(ss, 16); ss += __shfl_xor(ss, 32);
                if (fq == 0) SS[(size_t)r * 16 + (u.pn * 4 + wc)] = ss; }
    }
};

__device__ __forceinline__ void tr_item(const float* src, size_t spitch, int nvalid, const float* scale, bf16_t* dst, size_t dpitch, LAS float* scr, int lane) {
    const int n = lane & 31;
#pragma unroll 16
    for (int i = 0; i < 32; ++i) { const int kk = 2 * i + (lane >> 5); float v = (n < nvalid) ? src[(size_t)kk * spitch + n] : 0.f; if (scale) v *= scale[kk]; scr[kk * 33 + n] = v; }
    LDSW();
    const int c = lane & 7;
#pragma unroll
    for (int j = 0; j < 4; ++j) { const int nn = (lane >> 3) + 8 * j; const LAS float* s = scr + (8 * c) * 33 + nn;
        u32x4 o; o.x = pk2(s[0 * 33], s[1 * 33]); o.y = pk2(s[2 * 33], s[3 * 33]); o.z = pk2(s[4 * 33], s[5 * 33]); o.w = pk2(s[6 * 33], s[7 * 33]);
        *(u32x4*)(dst + (size_t)nn * dpitch + 8 * c) = o; }
    LDSW();
}

__device__ __forceinline__ void p0_prologue(const Params& P, LAS unsigned char* lds, int tid, int lane, int wave) {
    unsigned char* ws = P.ws;
    LAS float* scr = (LAS float*)(lds + wave * 16384);
    const int gw = blockIdx.x * 8 + wave, NGW = gridDim.x * 8;
    const float* w_in = P.in[7]; const float* w_out = P.in[11]; const float* norm_g = P.in[6];
    bf16_t* WTIN = (bf16_t*)(ws + WS_WTIN); bf16_t* WTOUT = (bf16_t*)(ws + WS_WTOUT);
    constexpr int I_IN = 16 * (NPAD / 32), I_OUT = 16 * 32;
    constexpr int NIT = DEPTH * I_IN + DEPTH * I_OUT;
    for (int it = gw; it < NIT; it += NGW) {
        int r = it;
        if (r < DEPTH * I_IN) { const int l = r / I_IN; r -= l * I_IN; const int kb = r / (NPAD / 32), nb = r % (NPAD / 32), n0 = nb * 32;
            int sc = n0, nv = 32; if (n0 >= 4104) { sc = 0; nv = 0; } else if (n0 >= 4096) { sc = 1536; nv = 8; } else if (n0 >= 1536) sc = n0 + 8;
            tr_item(w_in + (size_t)l * 1024 * DIN + (size_t)(64 * kb) * DIN + sc, DIN, nv, norm_g + l * 1024 + 64 * kb, WTIN + ((size_t)l * NPAD + n0) * 1024 + 64 * kb, 1024, scr, lane);
            continue; }
        r -= DEPTH * I_IN;
        if (r < DEPTH * I_OUT) { const int l = r / I_OUT; r -= l * I_OUT; const int kb = r / 32, nb = r % 32;
            tr_item(w_out + (size_t)l * 1024 * 1024 + (size_t)(64 * kb) * 1024 + nb * 32, 1024, 32, nullptr, WTOUT + ((size_t)l * 1024 + nb * 32) * 1024 + 64 * kb, 1024, scr, lane);
            continue; }
    }
    bf16_t* XB = (bf16_t*)(ws + WS_XB); float* SS = (float*)(ws + WS_SS);
    for (int r0 = gw; r0 < MT; r0 += 4 * NGW) {
        f32x4 v[4][4];
#pragma unroll
        for (int q = 0; q < 4; ++q) { const int r = min(r0 + q * NGW, MT - 1);
            const float* src = (r < MP) ? (P.in[0] + (size_t)r * 1024) : (P.in[1] + (size_t)(r - MP) * 1024);
#pragma unroll
            for (int j = 0; j < 4; ++j) v[q][j] = ((const f32x4*)src)[lane + 64 * j]; }
#pragma unroll
        for (int q = 0; q < 4; ++q) { const int r = r0 + q * NGW;
            float s = 0.f;
#pragma unroll
            for (int j = 0; j < 4; ++j) s += (v[q][j][0] * v[q][j][0] + v[q][j][1] * v[q][j][1]) + (v[q][j][2] * v[q][j][2] + v[q][j][3] * v[q][j][3]);
            s = wave_sum(s);
            if (r < MT) {
#pragma unroll
                for (int j = 0; j < 4; ++j) { u32x2 w; w.x = pk2(v[q][j][0], v[q][j][1]); w.y = pk2(v[q][j][2], v[q][j][3]); ((u32x2*)(XB + (size_t)r * 1024))[lane + 64 * j] = w; }
                if (lane < 16) SS[(size_t)r * 16 + lane] = (lane == 0) ? s : 0.f;
            } }
    }
    for (int tl = gw; tl < DEPTH * DBAT * 32; tl += NGW) {
        const int l = tl / (DBAT * 32), q = tl % (DBAT * 32), b = q / 32, t = q % 32;
        const float* src = P.in[2] + ((size_t)(l * DBAT + b) * PAST + t * 64) * 512;
        float nmax = 0.f;
#pragma unroll 16
        for (int r = 0; r < 64; ++r) {
            const f32x4 a = ((const f32x4*)(src + (size_t)r * 512))[2 * lane], c = ((const f32x4*)(src + (size_t)r * 512))[2 * lane + 1];
            u32x4 w; w.x = pk2(a[0], a[1]); w.y = pk2(a[2], a[3]); w.z = pk2(c[0], c[1]); w.w = pk2(c[2], c[3]);
            float n2 = sq8(w); n2 += __shfl_xor(n2, 1); n2 += __shfl_xor(n2, 2); n2 += __shfl_xor(n2, 4); nmax = fmaxf(nmax, n2);
        }
        if ((lane & 7) == 0) ((float*)(ws + WS_KN))[((size_t)l * NKT + 1024 + b * 33 + t) * 8 + (lane >> 3)] = sqrtf(nmax);
    }
    float* CL = (float*)(ws + WS_CL); float* BT = (float*)(ws + WS_BT);
    for (int r = gw; r < DEPTH * DBAT * 32; r += NGW) {
        const int l = r / (DBAT * 32), q = r % (DBAT * 32), b = q / 32, t = q % 32;
        const float* src = P.in[4] + ((size_t)(l * DBAT + b) * PAST + t * 64 + lane) * 8;
        const size_t krow = (size_t)MP + (size_t)b * SKV + t * 64 + lane;
#pragma unroll
        for (int h = 0; h < 8; ++h) { const float c = wave_scan_incl(src[h], lane); CL[((size_t)l * KROWS + krow) * 8 + h] = c; const float cm = wave_min(c);
            if (lane == 63) { BT[((size_t)l * NKT + (krow >> 6)) * 8 + h] = c; ((float*)(ws + WS_CM))[((size_t)l * NKT + (krow >> 6)) * 8 + h] = cm; } }
    }
}

__device__ __forceinline__ void fox_cumsum(const Params& P, LAS unsigned char* lds, int layer, int tid, int lane, int wave) {
    asm volatile("" : "+v"(lane));
    float* CL = (float*)(P.ws + WS_CL) + (size_t)layer * KROWS * 8; float* BT = (float*)(P.ws + WS_BT) + (size_t)layer * NKT * 8;
    float* CM = (float*)(P.ws + WS_CM) + (size_t)layer * NKT * 8; float* KN = (float*)(P.ws + WS_KN) + (size_t)layer * NKT * 8;
    const float* lfP = P.out + OFF_LP + (size_t)layer * MP * 8; const float* lfS = P.out + OFF_LS + (size_t)layer * MS * 8;
    LAS float* part = (LAS float*)lds;
    for (int g = blockIdx.x; g < NG; g += gridDim.x) {
        const float* src; size_t krow0;
        if (g < MP / 64) { src = lfP + (size_t)g * 64 * 8; krow0 = (size_t)g * 64; }
        else { const int b = g - MP / 64; src = lfS + (size_t)b * 64 * 8; krow0 = (size_t)MP + (size_t)b * SKV + PAST; }
        const bf16_t* kb = (g < MP / 64) ? ((const bf16_t*)(P.ws + WS_KBP) + krow0 * 512) : ((const bf16_t*)(P.ws + WS_KBS) + ((size_t)layer * KSROWS + (krow0 - MP)) * 512);
        u32x4 kw[8];
#pragma unroll
        for (int r = 0; r < 8; ++r) kw[r] = ((const u32x4*)(kb + (size_t)(8 * wave + r) * 512))[lane];
        float hv[8];
        if (wave == 0) {
#pragma unroll
            for (int h = 0; h < 8; ++h) hv[h] = src[(size_t)lane * 8 + h];
        }
        float nmax = 0.f;
#pragma unroll
        for (int r = 0; r < 8; ++r) { float n2 = sq8(kw[r]); n2 += __shfl_xor(n2, 1); n2 += __shfl_xor(n2, 2); n2 += __shfl_xor(n2, 4); nmax = fmaxf(nmax, n2); }
        if ((lane & 7) == 0) part[wave * 8 + (lane >> 3)] = nmax;
        if (wave == 0) {
#pragma unroll
            for (int h = 0; h < 8; ++h) { const float c = wave_scan_incl(hv[h], lane); CL[(krow0 + lane) * 8 + h] = c; const float cm = wave_min(c);
                if (lane == 63) { BT[(krow0 >> 6) * 8 + h] = c; CM[(krow0 >> 6) * 8 + h] = cm; } }
        }
        __syncthreads();
        if (tid < 8) { float m = part[tid];
#pragma unroll
            for (int w = 1; w < 8; ++w) m = fmaxf(m, part[w * 8 + tid]);
            KN[(krow0 >> 6) * 8 + tid] = sqrtf(m); }
        __syncthreads();
    }
}

#define MFMA16(a, b, c) __builtin_amdgcn_mfma_f32_16x16x32_bf16((a), (b), (c), 0, 0, 0)
#define MFMA32(a, b, c) __builtin_amdgcn_mfma_f32_32x32x16_bf16((a), (b), (c), 0, 0, 0)

constexpr int PP_QT = 0, PP_KT = 17408, PP_VT = 34816, PP_AM = 53248, PP_TOT = 62464;
__device__ __forceinline__ void hg_prepass_unit(const Params& P, LAS unsigned char* lds, int layer, int g, int h, int tid, int lane, int wave) {
    unsigned char* ws = P.ws; const float* hl = P.in[9];
    size_t zo = 0;
    asm volatile("" : "+v"(tid), "+v"(lane), "+s"(zo), "+s"(g), "+s"(h));
    ws += zo; hl += zo;
    const int k = tid & 127, tq = tid >> 7, fr = lane & 15, fq = lane >> 4;
    float* HF = (float*)(ws + WS_HF); bf16_t* QE = (bf16_t*)(ws + WS_QE); bf16_t* KDT = (bf16_t*)(ws + WS_KDT) + (size_t)(g * 4 + h) * 8192;
    const bf16_t* HI = (const bf16_t*)(ws + WS_VTH) + (size_t)g * 64 * 512 + h * 128; float* DG = (float*)(ws + WS_DG) + (size_t)(g * 4 + h) * 128;
    float lbv = 0.f;
    if (layer > 0) { lbv = __builtin_amdgcn_rcpf(1.f + __expf(hl[h * 128 + k] - hl[512 + h * 128 + k])); }
    const float oml = 1.f - lbv;
    const size_t e0 = ((size_t)g * 64 + tq * 16) * 512 + h * 128 + k;
    float bc[16], kk[16]; unsigned short qv[16];
    float run = 0.f;
#pragma unroll
    for (int i = 0; i < 16; ++i) qv[i] = QE[e0 + (size_t)i * 512];
#pragma unroll
    for (int i = 0; i < 16; ++i) { const float z = HF[e0 + (size_t)i * 512]; const float ls = logsig(z);
        const float lf = (layer == 0) ? ls : __logf(lbv + oml * __expf(ls)); run += lf; bc[i] = run; kk[i] = oml * __builtin_amdgcn_rcpf(1.f + __expf(z)); }
    LAS float* tot = (LAS float*)(lds + PP_TOT);
    tot[tq * 128 + k] = run;
#pragma unroll
    for (int j = 0; j < 2; ++j) { const int idx = tid + 512 * j, rc = idx >> 4, ch = idx & 15; const u32x4 v = *(const u32x4*)(HI + (size_t)rc * 512 + ch * 8); *(LAS u32x4*)(lds + PP_VT + rc * 272 + ch * 16) = v; }
    __syncthreads();
    const float t0 = tot[k], t1 = tot[128 + k], t2 = tot[256 + k], t3 = tot[384 + k];
    const float off = (tq > 0 ? t0 : 0.f) + (tq > 1 ? t1 : 0.f) + (tq > 2 ? t2 : 0.f);
    const float bmid = t0 + t1, blast = (t0 + t1) + (t2 + t3);
    unsigned kdp[8];
#pragma unroll
    for (int i = 0; i < 16; i += 2) {
        float kd2[2];
#pragma unroll
        for (int j = 0; j < 2; ++j) { const int ii = i + j; const float b = bc[ii] + off; const float q = bf2f(qv[ii]);
            const float qe = q * __expf(b), kd = kk[ii] * __expf(blast - b), qt = q * __expf(b - bmid), kt = kk[ii] * __expf(bmid - b);
            QE[e0 + (size_t)ii * 512] = f2bf(qe); kd2[j] = kd;
            const int t = tq * 16 + ii;
            *(LAS bf16_t*)(lds + PP_QT + t * 272 + k * 2) = f2bf(qt); *(LAS bf16_t*)(lds + PP_KT + t * 272 + k * 2) = f2bf(kt); }
        kdp[i >> 1] = pk2(kd2[0], kd2[1]);
    }
    { u32x4 w0 = {kdp[0], kdp[1], kdp[2], kdp[3]}, w1 = {kdp[4], kdp[5], kdp[6], kdp[7]};
      *(u32x4*)(KDT + k * 64 + tq * 16) = w0; *(u32x4*)(KDT + k * 64 + tq * 16 + 8) = w1; }
    if (tq == 0) { DG[k] = __expf(blast); ((float*)(ws + WS_LG))[(size_t)(g * 4 + h) * 128 + k] = blast; }
    __syncthreads();
    { const int mt = wave >> 1;
#pragma unroll
      for (int nn = 0; nn < 2; ++nn) { const int nt = 2 * (wave & 1) + nn; f32x4 a4 = {0.f, 0.f, 0.f, 0.f};
#pragma unroll
          for (int ks = 0; ks < 4; ++ks) { const bf16x8 a = *(const LAS bf16x8*)(lds + PP_QT + (16 * mt + fr) * 272 + (32 * ks + 8 * fq) * 2);
              const bf16x8 b = *(const LAS bf16x8*)(lds + PP_KT + (16 * nt + fr) * 272 + (32 * ks + 8 * fq) * 2); a4 = MFMA16(a, b, a4); }
#pragma unroll
          for (int rg = 0; rg < 4; ++rg) { const int t = 16 * mt + 4 * fq + rg, s = 16 * nt + fr; const float v = (s <= t) ? a4[rg] : 0.f;
              *(LAS bf16_t*)(lds + PP_AM + t * 144 + s * 2) = f2bf(v); } } }
    __syncthreads();
    { float* OI = HF + (size_t)g * 64 * 512 + h * 128 + 16 * wave + fr;
#pragma unroll
      for (int mt = 0; mt < 4; ++mt) { f32x4 a4 = {0.f, 0.f, 0.f, 0.f};
#pragma unroll
          for (int ks = 0; ks < 2; ++ks) { const bf16x8 a = *(const LAS bf16x8*)(lds + PP_AM + (16 * mt + fr) * 144 + (32 * ks + 8 * fq) * 2);
              const int trq = (lane & 15) >> 2, trp = lane & 3;
              const u32x2 bl = ldtr(lds + PP_VT + (32 * ks + 8 * fq + trq) * 272 + (16 * wave + 4 * trp) * 2), bh = ldtr(lds + PP_VT + (32 * ks + 8 * fq + 4 + trq) * 272 + (16 * wave + 4 * trp) * 2);
              const u32x4 bw = {bl.x, bl.y, bh.x, bh.y}; a4 = MFMA16(a, __builtin_bit_cast(bf16x8, bw), a4); }
#pragma unroll
          for (int rg = 0; rg < 4; ++rg) OI[(size_t)(16 * mt + 4 * fq + rg) * 512] = a4[rg]; } }
    __syncthreads();
}

constexpr int HS_QE = 0, HS_KD = 17408, HS_VT = 35840, HS_D = 54272, HS_O = 54784, HS_G = 54784 + 33792, HS_DS = HS_G + 512, HS_DC = HS_DS + 4096;
constexpr int NSEG = 8, SEGC = 16;
__device__ __forceinline__ void hg_seq_unit(const Params& P, LAS unsigned char* lds, int layer, int g0, int nch, int h, const float* S0, float* Sout, int mode, int seg, const float* Lb, int tid, int lane, int wave) {
    unsigned char* ws = P.ws; const float* gnp = P.in[10] + layer * 512 + h * 128;
    size_t zo = 0;
    asm volatile("" : "+v"(tid), "+v"(lane), "+s"(zo), "+s"(g0), "+s"(nch), "+s"(h), "+s"(mode), "+s"(seg));
    ws += zo; gnp += zo; S0 += zo; Sout += zo; Lb += zo;
    const int fr = lane & 15, fq = lane >> 4;
    const bf16_t* QE = (const bf16_t*)(ws + WS_QE); const bf16_t* KDT = (const bf16_t*)(ws + WS_KDT); const bf16_t* HI = (const bf16_t*)(ws + WS_VTH);
    const float* DG = (const float*)(ws + WS_DG); float* OI = (float*)(ws + WS_HF); bf16_t* YC = (bf16_t*)(ws + WS_YC);
    f32x4 S[8];
#pragma unroll
    for (int kb = 0; kb < 8; ++kb) S[kb] = (f32x4){0.f, 0.f, 0.f, 0.f};
    if (mode == 0) {
#pragma unroll
        for (int kb = 0; kb < 8; ++kb)
#pragma unroll
            for (int rg = 0; rg < 4; ++rg) S[kb][rg] = S0[(size_t)(16 * kb + 4 * fq + rg) * 128 + 16 * wave + fr];
    }
    if (mode == 2) {
        const float* LG = (const float*)(ws + WS_LG);
        if (tid < 128) {
            const int gb = g0 - seg * SEGC;
            for (int j = 0; j < seg; ++j) { float a = 0.f;
#pragma unroll
                for (int c = 0; c < SEGC; ++c) a += LG[((size_t)(gb + SEGC * j + c) * 4 + h) * 128 + tid];
                *(LAS float*)(lds + HS_DS + (j * 128 + tid) * 4) = __expf(a); }
            float run = 0.f;
#pragma unroll
            for (int c = 0; c < SEGC; ++c) { *(LAS float*)(lds + HS_DC + (c * 128 + tid) * 4) = __expf(run); run += LG[((size_t)(g0 + c) * 4 + h) * 128 + tid]; }
            *(LAS float*)(lds + HS_DS + (seg * 128 + tid) * 4) = __expf(run);
        }
        __syncthreads();
        for (int j = 0; j < seg; ++j) { const float* Lj = Lb + (size_t)j * 16384;
#pragma unroll
            for (int kb = 0; kb < 8; ++kb) { const f32x4 d4 = *(const LAS f32x4*)(lds + HS_DS + (j * 128 + 16 * kb + 4 * fq) * 4);
#pragma unroll
                for (int rg = 0; rg < 4; ++rg) S[kb][rg] = S[kb][rg] * d4[rg] + Lj[(size_t)(16 * kb + 4 * fq + rg) * 128 + 16 * wave + fr]; } }
    }
    const int nt = tid >> 3, nseg = tid & 7;
    if (tid < 128) *(LAS float*)(lds + HS_G + tid * 4) = gnp[tid];
    u32x4 pq[2], pkd[2], pv[2]; f32x4 pd;
#define HS_ISSUE(g) do { _Pragma("unroll") for (int j = 0; j < 2; ++j) { const int idx = tid + 512 * j; \
        pq[j] = *(const u32x4*)(QE + ((size_t)(g) * 64 + (idx >> 4)) * 512 + h * 128 + (idx & 15) * 8); \
        if (mode != 2) { pkd[j] = *(const u32x4*)(KDT + (size_t)((g) * 4 + h) * 8192 + idx * 8); pv[j] = *(const u32x4*)(HI + ((size_t)(g) * 64 + (idx >> 4)) * 512 + h * 128 + (idx & 15) * 8); } } \
        if (mode != 2 && tid < 32) pd = *(const f32x4*)(DG + (size_t)((g) * 4 + h) * 128 + tid * 4); } while (0)
#define HS_COMMIT() do { _Pragma("unroll") for (int j = 0; j < 2; ++j) { const int idx = tid + 512 * j; \
        *(LAS u32x4*)(lds + HS_QE + (idx >> 4) * 272 + (idx & 15) * 16) = pq[j]; \
        if (mode != 2) { *(LAS u32x4*)(lds + HS_KD + (idx >> 3) * 144 + (idx & 7) * 16) = pkd[j]; *(LAS u32x4*)(lds + HS_VT + (idx >> 4) * 272 + (idx & 15) * 16) = pv[j]; } } \
        if (mode != 2 && tid < 32) *(LAS f32x4*)(lds + HS_D + tid * 16) = pd; } while (0)
    HS_ISSUE(g0); HS_COMMIT();
    u32x4 gt0 = {0u, 0u, 0u, 0u}, gt1 = {0u, 0u, 0u, 0u}; f32x4 oi[4];
#define HS_LOAD_OI(g) do { _Pragma("unroll") for (int mt = 0; mt < 4; ++mt) _Pragma("unroll") for (int rg = 0; rg < 4; ++rg) \
        oi[mt][rg] = OI[((size_t)(g) * 64 + 16 * mt + 4 * fq + rg) * 512 + h * 128 + 16 * wave + fr]; } while (0)
#define HS_LOAD_GT(g) do { const size_t yo_ = ((size_t)(g) * 64 + nt) * 1024 + 512 + h * 128 + 16 * nseg; gt0 = *(const u32x4*)(YC + yo_); gt1 = *(const u32x4*)(YC + yo_ + 8); } while (0)
    HS_LOAD_OI(g0); if (mode != 1) HS_LOAD_GT(g0);
    __syncthreads();
    for (int c = 0; c < nch; ++c) {
        const int g = g0 + c;
        if (c + 1 < nch) HS_ISSUE(g + 1);
        const size_t yoff = ((size_t)g * 64 + nt) * 1024 + 512 + h * 128 + 16 * nseg;
        bf16x8 sb[4];
        if (mode == 2) {
#pragma unroll
            for (int ks = 0; ks < 4; ++ks) { const f32x4 da = *(const LAS f32x4*)(lds + HS_DC + (c * 128 + 32 * ks + 4 * fq) * 4), db = *(const LAS f32x4*)(lds + HS_DC + (c * 128 + 32 * ks + 16 + 4 * fq) * 4);
                const f32x4 x = S[2 * ks] * da, y = S[2 * ks + 1] * db; u32x4 w; w.x = pk2(x[0], x[1]); w.y = pk2(x[2], x[3]); w.z = pk2(y[0], y[1]); w.w = pk2(y[2], y[3]); sb[ks] = __builtin_bit_cast(bf16x8, w); }
        } else {
#pragma unroll
            for (int ks = 0; ks < 4; ++ks) { u32x4 w; w.x = pk2(S[2 * ks][0], S[2 * ks][1]); w.y = pk2(S[2 * ks][2], S[2 * ks][3]); w.z = pk2(S[2 * ks + 1][0], S[2 * ks + 1][1]); w.w = pk2(S[2 * ks + 1][2], S[2 * ks + 1][3]);
                sb[ks] = __builtin_bit_cast(bf16x8, w); }
        }
#pragma unroll
        for (int mp = 0; mp < 2; ++mp) { u32x2 alo[2][4], ahi[2][4];
#pragma unroll
          for (int m2 = 0; m2 < 2; ++m2)
#pragma unroll
              for (int ks = 0; ks < 4; ++ks) { const int mt = 2 * mp + m2; alo[m2][ks] = *(const LAS u32x2*)(lds + HS_QE + (16 * mt + fr) * 272 + (32 * ks + 4 * fq) * 2);
                  ahi[m2][ks] = *(const LAS u32x2*)(lds + HS_QE + (16 * mt + fr) * 272 + (32 * ks + 16 + 4 * fq) * 2); }
          __builtin_amdgcn_sched_barrier(0);
#pragma unroll
          for (int m2 = 0; m2 < 2; ++m2) { const int mt = 2 * mp + m2; f32x4 o4 = oi[mt];
#pragma unroll
              for (int ks = 0; ks < 4; ++ks) { const u32x4 aw = {alo[m2][ks].x, alo[m2][ks].y, ahi[m2][ks].x, ahi[m2][ks].y}; o4 = MFMA16(__builtin_bit_cast(bf16x8, aw), sb[ks], o4); }
              if (mode == 1) {
#pragma unroll
                  for (int rg = 0; rg < 4; ++rg) OI[((size_t)g * 64 + 16 * mt + 4 * fq + rg) * 512 + h * 128 + 16 * wave + fr] = o4[rg];
              } else {
#pragma unroll
                  for (int rg = 0; rg < 4; ++rg) *(LAS float*)(lds + HS_O + ((16 * mt + 4 * fq + rg) * 132 + 16 * wave + fr) * 4) = o4[rg];
              } } }
        if (c + 1 < nch) HS_LOAD_OI(g + 1);
        if (mode != 2) {
          const int trq = (lane & 15) >> 2, trp = lane & 3;
          const u32x2 v0 = ldtr(lds + HS_VT + (8 * fq + trq) * 272 + (16 * wave + 4 * trp) * 2), v1 = ldtr(lds + HS_VT + (8 * fq + 4 + trq) * 272 + (16 * wave + 4 * trp) * 2);
          const u32x2 v2 = ldtr(lds + HS_VT + (32 + 8 * fq + trq) * 272 + (16 * wave + 4 * trp) * 2), v3 = ldtr(lds + HS_VT + (32 + 8 * fq + 4 + trq) * 272 + (16 * wave + 4 * trp) * 2);
          const u32x4 bw0 = {v0.x, v0.y, v1.x, v1.y}, bw1 = {v2.x, v2.y, v3.x, v3.y};
          const bf16x8 b0 = __builtin_bit_cast(bf16x8, bw0), b1 = __builtin_bit_cast(bf16x8, bw1);
#pragma unroll
          for (int hf = 0; hf < 2; ++hf) { f32x4 d4[4]; bf16x8 a0[4], a1[4];
#pragma unroll
              for (int q = 0; q < 4; ++q) { const int kb = 4 * hf + q; d4[q] = *(const LAS f32x4*)(lds + HS_D + (16 * kb + 4 * fq) * 4);
                  a0[q] = *(const LAS bf16x8*)(lds + HS_KD + (16 * kb + fr) * 144 + (8 * fq) * 2); a1[q] = *(const LAS bf16x8*)(lds + HS_KD + (16 * kb + fr) * 144 + (32 + 8 * fq) * 2); }
              __builtin_amdgcn_sched_barrier(0);
#pragma unroll
              for (int q = 0; q < 4; ++q) { const int kb = 4 * hf + q; S[kb] = S[kb] * d4[q]; S[kb] = MFMA16(a0[q], b0, S[kb]); S[kb] = MFMA16(a1[q], b1, S[kb]); } } }
        __syncthreads();
        if (mode != 1) { f32x4 v[4]; float ss = 0.f;
#pragma unroll
          for (int j = 0; j < 4; ++j) { v[j] = *(const LAS f32x4*)(lds + HS_O + (nt * 132 + 16 * nseg + 4 * j) * 4); ss += (v[j][0] * v[j][0] + v[j][1] * v[j][1]) + (v[j][2] * v[j][2] + v[j][3] * v[j][3]); }
          ss += __shfl_xor(ss, 1); ss += __shfl_xor(ss, 2); ss += __shfl_xor(ss, 4);
          const float rinv = rsqrtf(ss * (1.0f / 128.0f) + EPS);
          const unsigned gw_[8] = {gt0.x, gt0.y, gt0.z, gt0.w, gt1.x, gt1.y, gt1.z, gt1.w};
          unsigned ow[8];
#pragma unroll
          for (int j = 0; j < 8; ++j) { const f32x4 gq = *(const LAS f32x4*)(lds + HS_G + (16 * nseg + 4 * (j >> 1)) * 4); const float g0_ = gq[(j & 1) * 2], g1_ = gq[(j & 1) * 2 + 1];
              const float a = v[j >> 1][(j & 1) * 2] * rinv * g0_ * bflo(gw_[j]); const float b = v[j >> 1][(j & 1) * 2 + 1] * rinv * g1_ * bfhi(gw_[j]); ow[j] = pk2(a, b); }
          const u32x4 o0 = {ow[0], ow[1], ow[2], ow[3]}, o1 = {ow[4], ow[5], ow[6], ow[7]};
          *(u32x4*)(YC + yoff) = o0; *(u32x4*)(YC + yoff + 8) = o1;
          if (c + 1 < nch) HS_LOAD_GT(g + 1); }
        if (c + 1 < nch) HS_COMMIT();
        __syncthreads();
    }
    if (mode == 2) {
        if (seg == NSEG - 1) {
            const float* Lj = Lb + (size_t)seg * 16384;
#pragma unroll
            for (int kb = 0; kb < 8; ++kb) { const f32x4 d4 = *(const LAS f32x4*)(lds + HS_DS + (seg * 128 + 16 * kb + 4 * fq) * 4);
#pragma unroll
                for (int rg = 0; rg < 4; ++rg) Sout[(size_t)(16 * kb + 4 * fq + rg) * 128 + 16 * wave + fr] = S[kb][rg] * d4[rg] + Lj[(size_t)(16 * kb + 4 * fq + rg) * 128 + 16 * wave + fr]; }
        }
    } else {
#pragma unroll
        for (int kb = 0; kb < 8; ++kb)
#pragma unroll
            for (int rg = 0; rg < 4; ++rg) Sout[(size_t)(16 * kb + 4 * fq + rg) * 128 + 16 * wave + fr] = S[kb][rg];
    }
    __syncthreads();
#undef HS_ISSUE
#undef HS_COMMIT
#undef HS_LOAD_OI
#undef HS_LOAD_GT
}

constexpr int HL_QE = 0, HL_KD = 17408, HL_VT = 35840, HL_D = 53248, HL_QT = 53760, HL_KT = 71168, HL_AM = 88576, HL_TOT = 97792;
__device__ __forceinline__ void hg_local_unit(const Params& P, LAS unsigned char* lds, int layer, int g0, int h, float* Sout, int tid, int lane, int wave) {
    unsigned char* ws = P.ws; const float* hl = P.in[9];
    size_t zo = 0;
    asm volatile("" : "+v"(tid), "+v"(lane), "+s"(zo), "+s"(g0), "+s"(h));
    ws += zo; hl += zo; Sout += zo;
    const int k = tid & 127, tq = tid >> 7, fr = lane & 15, fq = lane >> 4;
    float* HF = (float*)(ws + WS_HF); bf16_t* QE = (bf16_t*)(ws + WS_QE); const bf16_t* HIb = (const bf16_t*)(ws + WS_VTH); float* LG = (float*)(ws + WS_LG);
    float lbv = 0.f;
    if (layer > 0) lbv = __builtin_amdgcn_rcpf(1.f + __expf(hl[h * 128 + k] - hl[512 + h * 128 + k]));
    const float oml = 1.f - lbv;
    f32x4 S[8];
#pragma unroll
    for (int kb = 0; kb < 8; ++kb) S[kb] = (f32x4){0.f, 0.f, 0.f, 0.f};
    float z[16]; unsigned short qv[16]; u32x4 hv[2];
#define HL_E0(gg) (((size_t)(gg) * 64 + tq * 16) * 512 + h * 128 + k)
#define HL_LOADZ(gg) do { const size_t e_ = HL_E0(gg); _Pragma("unroll") for (int i = 0; i < 16; ++i) z[i] = HF[e_ + (size_t)i * 512]; } while (0)
#define HL_LOADQ(gg) do { const size_t e_ = HL_E0(gg); _Pragma("unroll") for (int i = 0; i < 16; ++i) qv[i] = QE[e_ + (size_t)i * 512]; } while (0)
#define HL_LOADH(gg) do { const bf16_t* hi_ = HIb + (size_t)(gg) * 64 * 512 + h * 128; _Pragma("unroll") for (int j = 0; j < 2; ++j) { const int idx = tid + 512 * j; hv[j] = *(const u32x4*)(hi_ + (size_t)(idx >> 4) * 512 + (idx & 15) * 8); } } while (0)
    HL_LOADZ(g0); HL_LOADQ(g0); HL_LOADH(g0);
    for (int c = 0; c < SEGC; ++c) {
        const int g = g0 + c;
        const size_t e0 = HL_E0(g);
        float bc[16], kk[16];
#pragma unroll
        for (int j = 0; j < 2; ++j) { const int idx = tid + 512 * j; *(LAS u32x4*)(lds + HL_VT + (idx >> 4) * 272 + (idx & 15) * 16) = hv[j]; }
        float run = 0.f;
#pragma unroll
        for (int i = 0; i < 16; ++i) { const float zz = z[i]; const float e = __expf(-fabsf(zz)), r = __builtin_amdgcn_rcpf(1.f + e), er = e * r;
            const float lf = (layer == 0) ? (fminf(zz, 0.f) - __logf(1.f + e)) : __logf(lbv + oml * (zz > 0.f ? r : er));
            run += lf; bc[i] = run; kk[i] = oml * (zz > 0.f ? er : r); }
        *(LAS float*)(lds + HL_TOT + (tq * 128 + k) * 4) = run;
        if (c + 1 < SEGC) { HL_LOADZ(g + 1); HL_LOADH(g + 1); }
        __syncthreads();
        const float t0 = *(const LAS float*)(lds + HL_TOT + k * 4), t1 = *(const LAS float*)(lds + HL_TOT + (128 + k) * 4), t2 = *(const LAS float*)(lds + HL_TOT + (256 + k) * 4), t3 = *(const LAS float*)(lds + HL_TOT + (384 + k) * 4);
        const float off = (tq > 0 ? t0 : 0.f) + (tq > 1 ? t1 : 0.f) + (tq > 2 ? t2 : 0.f);
        const float bmid = t0 + t1, blast = (t0 + t1) + (t2 + t3);
        unsigned kdp[8];
        const float cA = __expf(bmid), cB = __expf(blast - bmid);
#pragma unroll
        for (int i = 0; i < 16; i += 2) {
            float kd2[2];
#pragma unroll
            for (int j = 0; j < 2; ++j) { const int ii = i + j; const float b = bc[ii] + off; const float q = bf2f(qv[ii]);
                const float qt = q * __expf(b - bmid), kt = kk[ii] * __expf(bmid - b), qe = qt * cA, kd = kt * cB;
                const unsigned short qeb = f2bf(qe);
                QE[e0 + (size_t)ii * 512] = qeb; kd2[j] = kd;
                const int t = tq * 16 + ii;
                *(LAS bf16_t*)(lds + HL_QE + t * 272 + k * 2) = qeb;
                *(LAS bf16_t*)(lds + HL_QT + t * 272 + k * 2) = f2bf(qt); *(LAS bf16_t*)(lds + HL_KT + t * 272 + k * 2) = f2bf(kt); }
            kdp[i >> 1] = pk2(kd2[0], kd2[1]);
        }
        { const u32x4 w0 = {kdp[0], kdp[1], kdp[2], kdp[3]}, w1 = {kdp[4], kdp[5], kdp[6], kdp[7]};
          *(LAS u32x4*)(lds + HL_KD + k * 144 + tq * 32) = w0; *(LAS u32x4*)(lds + HL_KD + k * 144 + tq * 32 + 16) = w1; }
        if (tq == 0) { *(LAS float*)(lds + HL_D + k * 4) = __expf(blast); LG[(size_t)(g * 4 + h) * 128 + k] = blast; }
        if (c + 1 < SEGC) HL_LOADQ(g + 1);
        __syncthreads();
        { const int mt = wave >> 1;
#pragma unroll
          for (int nn = 0; nn < 2; ++nn) { const int nt = 2 * (wave & 1) + nn; f32x4 a4 = {0.f, 0.f, 0.f, 0.f};
#pragma unroll
              for (int ks = 0; ks < 4; ++ks) { const bf16x8 a = *(const LAS bf16x8*)(lds + HL_QT + (16 * mt + fr) * 272 + (32 * ks + 8 * fq) * 2);
                  const bf16x8 b = *(const LAS bf16x8*)(lds + HL_KT + (16 * nt + fr) * 272 + (32 * ks + 8 * fq) * 2); a4 = MFMA16(a, b, a4); }
#pragma unroll
              for (int rg = 0; rg < 4; ++rg) { const int t = 16 * mt + 4 * fq + rg, s_ = 16 * nt + fr; const float v = (s_ <= t) ? a4[rg] : 0.f;
                  *(LAS bf16_t*)(lds + HL_AM + t * 144 + s_ * 2) = f2bf(v); } } }
        __syncthreads();
        const int trq = (lane & 15) >> 2, trp = lane & 3;
        bf16x8 vb0, vb1;
        { const u32x2 v0 = ldtr(lds + HL_VT + (8 * fq + trq) * 272 + (16 * wave + 4 * trp) * 2), v1 = ldtr(lds + HL_VT + (8 * fq + 4 + trq) * 272 + (16 * wave + 4 * trp) * 2);
          const u32x2 v2 = ldtr(lds + HL_VT + (32 + 8 * fq + trq) * 272 + (16 * wave + 4 * trp) * 2), v3 = ldtr(lds + HL_VT + (32 + 8 * fq + 4 + trq) * 272 + (16 * wave + 4 * trp) * 2);
          const u32x4 bw0 = {v0.x, v0.y, v1.x, v1.y}, bw1 = {v2.x, v2.y, v3.x, v3.y}; vb0 = __builtin_bit_cast(bf16x8, bw0); vb1 = __builtin_bit_cast(bf16x8, bw1); }
        bf16x8 sb[4];
#pragma unroll
        for (int ks = 0; ks < 4; ++ks) { u32x4 w; w.x = pk2(S[2 * ks][0], S[2 * ks][1]); w.y = pk2(S[2 * ks][2], S[2 * ks][3]); w.z = pk2(S[2 * ks + 1][0], S[2 * ks + 1][1]); w.w = pk2(S[2 * ks + 1][2], S[2 * ks + 1][3]);
            sb[ks] = __builtin_bit_cast(bf16x8, w); }
#pragma unroll
        for (int mt = 0; mt < 4; ++mt) {
            const bf16x8 am0 = *(const LAS bf16x8*)(lds + HL_AM + (16 * mt + fr) * 144 + (8 * fq) * 2), am1 = *(const LAS bf16x8*)(lds + HL_AM + (16 * mt + fr) * 144 + (32 + 8 * fq) * 2);
            u32x2 alo[4], ahi[4];
#pragma unroll
            for (int ks = 0; ks < 4; ++ks) { alo[ks] = *(const LAS u32x2*)(lds + HL_QE + (16 * mt + fr) * 272 + (32 * ks + 4 * fq) * 2); ahi[ks] = *(const LAS u32x2*)(lds + HL_QE + (16 * mt + fr) * 272 + (32 * ks + 16 + 4 * fq) * 2); }
            f32x4 o4 = {0.f, 0.f, 0.f, 0.f};
            o4 = MFMA16(am0, vb0, o4); o4 = MFMA16(am1, vb1, o4);
#pragma unroll
            for (int ks = 0; ks < 4; ++ks) { const u32x4 aw = {alo[ks].x, alo[ks].y, ahi[ks].x, ahi[ks].y}; o4 = MFMA16(__builtin_bit_cast(bf16x8, aw), sb[ks], o4); }
#pragma unroll
            for (int rg = 0; rg < 4; ++rg) HF[((size_t)g * 64 + 16 * mt + 4 * fq + rg) * 512 + h * 128 + 16 * wave + fr] = o4[rg];
        }
#pragma unroll
        for (int hf = 0; hf < 2; ++hf) { f32x4 d4[4]; bf16x8 a0[4], a1[4];
#pragma unroll
            for (int q = 0; q < 4; ++q) { const int kb = 4 * hf + q; d4[q] = *(const LAS f32x4*)(lds + HL_D + (16 * kb + 4 * fq) * 4);
                a0[q] = *(const LAS bf16x8*)(lds + HL_KD + (16 * kb + fr) * 144 + (8 * fq) * 2); a1[q] = *(const LAS bf16x8*)(lds + HL_KD + (16 * kb + fr) * 144 + (32 + 8 * fq) * 2); }
#pragma unroll
            for (int q = 0; q < 4; ++q) { const int kb = 4 * hf + q; S[kb] = S[kb] * d4[q]; S[kb] = MFMA16(a0[q], vb0, S[kb]); S[kb] = MFMA16(a1[q], vb1, S[kb]); } }
        __syncthreads();
    }
#pragma unroll
    for (int kb = 0; kb < 8; ++kb)
#pragma unroll
        for (int rg = 0; rg < 4; ++rg) Sout[(size_t)(16 * kb + 4 * fq + rg) * 128 + 16 * wave + fr] = S[kb][rg];
#undef HL_E0
#undef HL_LOADZ
#undef HL_LOADQ
#undef HL_LOADH
}

constexpr int AT_BUF = 9216 + 9216 + 256, AT_PFX = 2 * AT_BUF, AT_PUB = AT_PFX + 528, AT_RED = AT_PUB + 528;
constexpr float AT_THR = -160.f;
__device__ __forceinline__ int crow(int r, int hi) { return (r & 3) + 8 * (r >> 2) + 4 * hi; }
__device__ __forceinline__ void attn_tile(LAS unsigned char* lds, int bo, const bf16x8 (&qr)[4], f32x16& o0, f32x16& o1, float& mrun, float& lrun, int t, int qlo, int r32, int hi) {
    f32x16 p0, p1;
#pragma unroll
    for (int g = 0; g < 4; ++g) { const f32x4 x0 = *(const LAS f32x4*)(lds + bo + 18432 + (8 * g + 4 * hi) * 4), x1 = *(const LAS f32x4*)(lds + bo + 18432 + (32 + 8 * g + 4 * hi) * 4);
#pragma unroll
        for (int i = 0; i < 4; ++i) { p0[4 * g + i] = x0[i]; p1[4 * g + i] = x1[i]; } }
    { bf16x8 k0[4], k1[4];
#pragma unroll
      for (int d0 = 0; d0 < 4; ++d0) { k0[d0] = *(const LAS bf16x8*)(lds + bo + r32 * 144 + (16 * d0 + 8 * hi) * 2); k1[d0] = *(const LAS bf16x8*)(lds + bo + (32 + r32) * 144 + (16 * d0 + 8 * hi) * 2); }
      __builtin_amdgcn_sched_barrier(0);
      __builtin_amdgcn_s_setprio(1);
#pragma unroll
      for (int d0 = 0; d0 < 4; ++d0) { p0 = MFMA32(k0[d0], qr[d0], p0); p1 = MFMA32(k1[d0], qr[d0], p1); }
      __builtin_amdgcn_s_setprio(0); }
    if (64 * t + 63 > qlo) {
        const int qp = qlo + r32, kb = 64 * t + 4 * hi;
#pragma unroll
        for (int r = 0; r < 16; ++r) { const int kv = kb + (r & 3) + 8 * (r >> 2); if (kv > qp) p0[r] = -INFINITY; if (kv + 32 > qp) p1[r] = -INFINITY; }
    }
    float mx = fmaxf(p0[0], p1[0]);
#pragma unroll
    for (int r = 1; r < 16; ++r) mx = fmaxf(mx, fmaxf(p0[r], p1[r]));
    mx = fmaxf(mx, __shfl_xor(mx, 32));
    if (__any(mx > mrun)) {
        const float mnew = fmaxf(mrun, mx);
        const float alpha = __builtin_amdgcn_exp2f(mrun - mnew);
        mrun = mnew; lrun *= alpha;
#pragma unroll
        for (int r = 0; r < 16; ++r) { o0[r] *= alpha; o1[r] *= alpha; }
    }
    float rsum = 0.f;
#pragma unroll
    for (int r = 0; r < 16; ++r) { p0[r] = __builtin_amdgcn_exp2f(p0[r] - mrun); p1[r] = __builtin_amdgcn_exp2f(p1[r] - mrun); rsum += p0[r] + p1[r]; }
    lrun += rsum;
    const int trq = (r32 & 15) >> 2, trp = r32 & 3, blk = r32 >> 4;
    u32x2 va[4][2][2];
#pragma unroll
    for (int st = 0; st < 4; ++st) { const int kvb = 16 * st + 4 * hi;
#pragma unroll
        for (int d0 = 0; d0 < 2; ++d0) { va[st][d0][0] = ldtr(lds + bo + 9216 + (kvb + trq) * 144 + (32 * d0 + 16 * blk + 4 * trp) * 2); va[st][d0][1] = ldtr(lds + bo + 9216 + (kvb + 8 + trq) * 144 + (32 * d0 + 16 * blk + 4 * trp) * 2); } }
    __builtin_amdgcn_sched_barrier(0);
    __builtin_amdgcn_s_setprio(1);
#pragma unroll
    for (int st = 0; st < 4; ++st) {
        u32x4 w;
        if (st < 2) { w.x = pk2(p0[8 * st], p0[8 * st + 1]); w.y = pk2(p0[8 * st + 2], p0[8 * st + 3]); w.z = pk2(p0[8 * st + 4], p0[8 * st + 5]); w.w = pk2(p0[8 * st + 6], p0[8 * st + 7]); }
        else { const int s2 = st - 2; w.x = pk2(p1[8 * s2], p1[8 * s2 + 1]); w.y = pk2(p1[8 * s2 + 2], p1[8 * s2 + 3]); w.z = pk2(p1[8 * s2 + 4], p1[8 * s2 + 5]); w.w = pk2(p1[8 * s2 + 6], p1[8 * s2 + 7]); }
        const bf16x8 pf = __builtin_bit_cast(bf16x8, w);
        { const u32x4 aw = {va[st][0][0].x, va[st][0][0].y, va[st][0][1].x, va[st][0][1].y}; o0 = MFMA32(__builtin_bit_cast(bf16x8, aw), pf, o0); }
        { const u32x4 aw = {va[st][1][0].x, va[st][1][0].y, va[st][1][1].x, va[st][1][1].y}; o1 = MFMA32(__builtin_bit_cast(bf16x8, aw), pf, o1); }
    }
    __builtin_amdgcn_s_setprio(0);
}
__device__ __forceinline__ void attn_unit(LAS unsigned char* lds, const bf16_t* Qp, const bf16_t* Kp, const bf16_t* VTp, int vpitch, const float* CLp, const float* BTp, const float* CMp, const float* KNp,
                                          int NT, int nqw, int qpos0, int cref_tile, bf16_t* Yp, const float* Kc, const float* Vc, int ncache, int tid, int lane, int wave) {
    size_t zo = 0;
    asm volatile("" : "+v"(tid), "+v"(lane), "+s"(zo), "+s"(vpitch), "+s"(NT), "+s"(nqw), "+s"(qpos0), "+s"(cref_tile), "+s"(ncache));
    Qp += zo; Kp += zo; VTp += zo; CLp += zo; BTp += zo; CMp += zo; KNp += zo; Yp += zo; Kc += zo; Vc += zo;
    const int r32 = lane & 31, hi = lane >> 5;
    LAS float* Pfx = (LAS float*)(lds + AT_PFX); LAS float* PUB = (LAS float*)(lds + AT_PUB); LAS float* red = (LAS float*)(lds + AT_RED);
    const int srow = tid >> 3, sch = tid & 7;
    float bt_a = 0.f, bt_b = 0.f, kn_a = 0.f, kn_b = 0.f, cm_a = 0.f, cm_b = 0.f;
    if (wave == 0) {
        if (lane < NT) { bt_a = BTp[(size_t)lane * 8]; kn_a = KNp[(size_t)lane * 8]; cm_a = CMp[(size_t)lane * 8]; }
        if (lane + 64 < NT) { bt_b = BTp[(size_t)(lane + 64) * 8]; kn_b = KNp[(size_t)(lane + 64) * 8]; cm_b = CMp[(size_t)(lane + 64) * 8]; }
    }
    bf16x8 qr[4];
    const bool active = wave < nqw;
    if (active) {
#pragma unroll
        for (int d0 = 0; d0 < 4; ++d0) qr[d0] = *(const bf16x8*)(Qp + (size_t)(32 * wave + r32) * 512 + 16 * d0 + 8 * hi);
    } else {
#pragma unroll
        for (int d0 = 0; d0 < 4; ++d0) qr[d0] = (bf16x8){0, 0, 0, 0, 0, 0, 0, 0};
    }
    u32x4 pkA, pvA, pkB, pvB; float pbA = 0.f, pbB = 0.f;
#define AT_ISSUE(PK, PV, PB, t) { if ((t) < ncache) { const size_t co_ = ((size_t)(64 * (t) + srow)) * 512 + sch * 8;     \
            const f32x4 ka_ = *(const f32x4*)(Kc + co_), kc_ = *(const f32x4*)(Kc + co_ + 4), va_ = *(const f32x4*)(Vc + co_), vc_ = *(const f32x4*)(Vc + co_ + 4); \
            PK = (u32x4){pk2(ka_[0], ka_[1]), pk2(ka_[2], ka_[3]), pk2(kc_[0], kc_[1]), pk2(kc_[2], kc_[3])}; PV = (u32x4){pk2(va_[0], va_[1]), pk2(va_[2], va_[3]), pk2(vc_[0], vc_[1]), pk2(vc_[2], vc_[3])}; } \
        else { PK = *(const u32x4*)(Kp + ((size_t)(64 * (t) + srow)) * 512 + sch * 8); PV = *(const u32x4*)(VTp + ((size_t)(64 * (t) + srow)) * 512 + sch * 8); } \
        if (tid < 64) PB = CLp[(size_t)(64 * (t) + tid) * 8]; }
#define AT_COMMIT(PK, PV, PB, t, bo) { *(LAS u32x4*)(lds + (bo) + srow * 144 + sch * 16) = PK; *(LAS u32x4*)(lds + (bo) + 9216 + srow * 144 + sch * 16) = PV; \
        if (tid < 64) *(LAS float*)(lds + (bo) + 18432 + tid * 4) = (cref - Pfx[(t)] - PB) * LOG2E; }
    AT_ISSUE(pkB, pvB, pbB, NT - 1);
    if (NT >= 2) AT_ISSUE(pkA, pvA, pbA, NT - 2);
    u32x2 gte[4][2];
    { const bf16_t* yrow_ = Yp + (size_t)(32 * (active ? wave : 0) + r32) * 1024;
#pragma unroll
      for (int g = 0; g < 4; ++g) { gte[g][0] = *(const u32x2*)(yrow_ + 8 * g + 4 * hi); gte[g][1] = *(const u32x2*)(yrow_ + 32 + 8 * g + 4 * hi); } }
    float qn2 = 0.f;
#pragma unroll
    for (int d0 = 0; d0 < 4; ++d0) qn2 += sq8(__builtin_bit_cast(u32x4, qr[d0]));
    qn2 += __shfl_xor(qn2, 32);
#pragma unroll
    for (int o = 1; o < 32; o <<= 1) qn2 = fmaxf(qn2, __shfl_xor(qn2, o));
    if (lane == 0) red[wave] = qn2;
    __syncthreads();
    if (wave == 0) {
        float q2 = red[0];
#pragma unroll
        for (int w = 1; w < 8; ++w) q2 = fmaxf(q2, red[w]);
        const float Qmax = sqrtf(q2) * 1.002f;
        const float sa = wave_scan_incl(bt_a, lane), ta = __shfl(sa, 63), sb = wave_scan_incl(bt_b, lane);
        const float ea = sa - bt_a, eb = sb + ta - bt_b;
        Pfx[lane] = ea; Pfx[lane + 64] = eb;
        const float c0 = __shfl(ea, cref_tile & 63), c1 = __shfl(eb, cref_tile & 63);
        const float crf = (cref_tile < 64) ? c0 : c1;
        const float ua = (lane < NT) ? (kn_a * Qmax + (crf - ea - cm_a) * LOG2E) : -INFINITY;
        const float ub = (lane + 64 < NT) ? (kn_b * Qmax + (crf - eb - cm_b) * LOG2E) : -INFINITY;
        const float pa = wave_scan_max(ua, lane), tm = __shfl(pa, 63), pb = fmaxf(wave_scan_max(ub, lane), tm);
        PUB[lane] = pa; PUB[lane + 64] = pb;
    }
    __syncthreads();
    const float cref = Pfx[cref_tile];
    AT_COMMIT(pkB, pvB, pbB, NT - 1, 0);
    __syncthreads();
    float mrun = -INFINITY, lrun = 0.f, LB = 0.f;
    f32x16 o0, o1;
#pragma unroll
    for (int r = 0; r < 16; ++r) { o0[r] = 0.f; o1[r] = 0.f; }
    const int qlo = qpos0 + 32 * wave;
    int t = NT - 1, bo = 0;
#define AT_STEP(RCK, RCV, RCB, RNK, RNV, RNB) { \
        if (t < cref_tile && PUB[t] - LB < AT_THR) break;     \
        if (t >= 2) AT_ISSUE(RNK, RNV, RNB, t - 2); \
        if (active && 64 * t <= qlo + 31) attn_tile(lds, bo, qr, o0, o1, mrun, lrun, t, qlo, r32, hi); \
        if (t >= 1) AT_COMMIT(RCK, RCV, RCB, t - 1, AT_BUF - bo); \
        if (t == cref_tile) { const float mm = wave_min(active ? mrun : INFINITY); if (lane == 0) red[8 + wave] = mm; } \
        __syncthreads(); \
        if (t == cref_tile) { float m = red[8]; _Pragma("unroll") for (int w = 1; w < 8; ++w) m = fminf(m, red[8 + w]); LB = m; } \
        if (t == 0) break; \
        --t; bo = AT_BUF - bo; }
    for (;;) {
        AT_STEP(pkA, pvA, pbA, pkB, pvB, pbB)
        AT_STEP(pkB, pvB, pbB, pkA, pvA, pbA)
    }
    if (active) {
        const float lt = lrun + __shfl_xor(lrun, 32);
        const float inv = 1.0f / lt;
        bf16_t* yrow = Yp + (size_t)(32 * wave + r32) * 1024;
#pragma unroll
        for (int g = 0; g < 4; ++g) {
            { bf16_t* p = yrow + 8 * g + 4 * hi; const u32x2 gt = gte[g][0]; u32x2 w;
              w.x = pk2(o0[4 * g] * inv * bflo(gt.x), o0[4 * g + 1] * inv * bfhi(gt.x)); w.y = pk2(o0[4 * g + 2] * inv * bflo(gt.y), o0[4 * g + 3] * inv * bfhi(gt.y)); *(u32x2*)p = w; }
            { bf16_t* p = yrow + 32 + 8 * g + 4 * hi; const u32x2 gt = gte[g][1]; u32x2 w;
              w.x = pk2(o1[4 * g] * inv * bflo(gt.x), o1[4 * g + 1] * inv * bfhi(gt.x)); w.y = pk2(o1[4 * g + 2] * inv * bflo(gt.y), o1[4 * g + 3] * inv * bfhi(gt.y)); *(u32x2*)p = w; }
        }
    }
    __syncthreads();
#undef AT_ISSUE
#undef AT_COMMIT
#undef AT_STEP
}

__global__ void __launch_bounds__(512, 2) fwd_megakernel(Params P) {
    extern __shared__ __attribute__((aligned(16))) unsigned char lds_raw[];
    LAS unsigned char* lds = (LAS unsigned char*)lds_raw;
    cg::grid_group grid = cg::this_grid();
    const int tid = threadIdx.x, lane = tid & 63, wave = __builtin_amdgcn_readfirstlane(tid >> 6);
    unsigned char* ws = P.ws;
    volatile LAS int* slot = (volatile LAS int*)(lds + LDS_MISC);
    volatile LAS unsigned* bst = (volatile LAS unsigned*)(lds + LDS_MISC + 64);
    if (tid < 2) bst[tid] = 0u;
    __syncthreads();
    const XcdBarrier xbar = xcd_barrier_post((unsigned*)(ws + WS_BAR), bst);
#define GSYNC() xcd_barrier(xbar)

#ifndef NO_P0
    p0_prologue(P, lds, tid, lane, wave);
#endif
    grid.sync();

#ifndef NREP_L
#define NREP_L 1
#endif
#ifndef NREP_P1
#define NREP_P1 1
#endif
    for (int li = 0; li < DEPTH * NREP_L; ++li) {
      const int layer = li / NREP_L;
      const bool lastrep = (li % NREP_L == NREP_L - 1);
      {
        for (int rep1 = 0; rep1 < NREP_P1; ++rep1) {
            pg8::Gemm g{(const bf16_t*)(ws + WS_XB), (const bf16_t*)(ws + WS_WTIN) + (size_t)layer * NPAD * 1024, MT, NPAD, 1024};
            pg8::StaticOrder S; S.init(MT, NPAD, (int)gridDim.x, (int)blockIdx.x);
            EpiIn E; E.ws = ws; E.out = P.out; E.bfv = P.in[8] + layer * 8; E.layer = layer; E.S = S; E.rsl = lds + LDS_MISC + 1024; E.ui = 0;
#ifndef NO_P1
            pg8::gemm_phase<EpiIn, pg8::StaticOrder, true, true>(lds, g, S, E);
#endif
        }
        GSYNC();
        fox_cumsum(P, lds, layer, tid, lane, wave);
#ifndef NO_PP
        for (int u = (MP / 64) * 4 + blockIdx.x; u < NG * 4; u += gridDim.x) hg_prepass_unit(P, lds, layer, u >> 2, u & 3, tid, lane, wave);
#endif
        unsigned* sdone = (unsigned*)(ws + WS_CTL) + 16 + li;
        asm volatile("s_waitcnt vmcnt(0)" ::: "memory");
        __syncthreads();
        if (tid == 0) { __builtin_amdgcn_fence(__ATOMIC_RELEASE, "agent"); asm volatile("s_waitcnt vmcnt(0)" ::: "memory"); __hip_atomic_fetch_add(sdone, 1u, __ATOMIC_RELAXED, __HIP_MEMORY_SCOPE_AGENT); }
        bool stats_ready = false;
#ifndef PROBE_CUT
#define PROBE_CUT 9
#endif
        if (lastrep || PROBE_CUT >= 2) {
            unsigned* cnt = (unsigned*)(ws + WS_CTL) + li;
            constexpr int T_HP = 32 * NSEG, T_AP = T_HP + 2048, T_AS = T_AP + 128, T_HSM = T_AS + 64, T_SO = T_HSM + 16, T_FX = T_SO + 32 * NSEG;
            unsigned* segdone = (unsigned*)(ws + WS_CTL) + 32 + 32 * li;
            for (;;) {
                if (tid == 0) *slot = (int)atomicAdd(cnt, 1u);
                __syncthreads();
                const int pt = *slot;
                __syncthreads();
                if (pt >= T_FX) break;
                int tk;
                { constexpr int A1 = 1408, P1_ = T_HP + A1, P2_ = P1_ + 32 * NSEG, P3_ = P2_ + 128, P4_ = P3_ + 64, P5_ = P4_ + 16;
                  if (pt < P1_) tk = pt;
                  else if (pt < P2_) tk = T_SO + (pt - P1_);
                  else if (pt < P3_) tk = T_AP + (pt - P2_);
                  else if (pt < P4_) tk = T_AS + (pt - P3_);
                  else if (pt < P5_) tk = T_HSM + (pt - P4_);
                  else tk = T_HP + A1 + (pt - P5_); }
                if (tk >= T_HP && !stats_ready) {
                    if (tid == 0) {
                        for (unsigned spin = 0; spin < (1u << 20); ++spin) { if (__hip_atomic_load(sdone, __ATOMIC_RELAXED, __HIP_MEMORY_SCOPE_AGENT) >= gridDim.x) break; __builtin_amdgcn_s_sleep(4); }
                        __builtin_amdgcn_fence(__ATOMIC_ACQUIRE, "agent"); asm volatile("s_waitcnt vmcnt(0)" ::: "memory"); }
                    __syncthreads();
                    stats_ready = true;
                }
                unsigned* sampdone = (unsigned*)(ws + WS_CTL) + 96 + 4 * li;
                if (tk >= T_HSM && tk < T_SO) {
                    const int j = (tk - T_HSM) >> 2, pn = (tk - T_HSM) & 3;
                    if (tid == 0) {
                        for (unsigned spin = 0; spin < (1u << 20); ++spin) { if (__hip_atomic_load(sampdone + j, __ATOMIC_RELAXED, __HIP_MEMORY_SCOPE_AGENT) >= 48u) break; __builtin_amdgcn_s_sleep(4); }
                        __builtin_amdgcn_fence(__ATOMIC_ACQUIRE, "agent"); asm volatile("s_waitcnt vmcnt(0)" ::: "memory"); }
                    __syncthreads();
                    pg8::Gemm g1{(const bf16_t*)(ws + WS_YC), (const bf16_t*)(ws + WS_WTOUT) + (size_t)layer * 1024 * 1024, MT, 1024, 1024};
                    OneUnit S1; S1.pm = MP / 256 + j; S1.pn = pn;
                    EpiOut E1; E1.XB = (bf16_t*)(ws + WS_XB); E1.SS = (float*)(ws + WS_SS);
                    pg8::gemm_phase<EpiOut, OneUnit, true, true>(lds, g1, S1, E1);
                    __syncthreads();
                    continue;
                }
                if (tk < T_HP || tk >= T_AS) {
                    int g0, nch, h, mode, seg = 0; const float* S0; float* So;
                    if (tk < T_HP) { const int bh = tk >> 3, b = bh >> 2; seg = tk & 7; h = bh & 3; g0 = b * 128 + seg * SEGC; nch = SEGC; S0 = P.in[5]; mode = 1; So = (float*)(ws + WS_LB) + ((size_t)bh * NSEG + seg) * 16384; }
                    else if (tk < T_HSM) { const int bh = tk - T_AS, b = bh >> 2; h = bh & 3; g0 = 1024 + b; nch = 1; mode = 0; S0 = P.in[5] + ((size_t)(layer * DBAT + b) * 4 + h) * 16384; So = P.out + OFF_HS + ((size_t)(layer * DBAT + b) * 4 + h) * 16384; }
                    else { const int idx = tk - T_SO, bh = idx & 31, b = bh >> 2; seg = NSEG - 1 - (idx >> 5); h = bh & 3; g0 = b * 128 + seg * SEGC; nch = SEGC; mode = 2; S0 = P.in[5]; So = P.out + OFF_HP + ((size_t)(layer * NBAT + b) * 4 + h) * 16384;
                        if (tid == 0) {
                            for (unsigned spin = 0; spin < (1u << 20); ++spin) { if (__hip_atomic_load(segdone + bh, __ATOMIC_RELAXED, __HIP_MEMORY_SCOPE_AGENT) >= (unsigned)NSEG) break; __builtin_amdgcn_s_sleep(4); }
                            __builtin_amdgcn_fence(__ATOMIC_ACQUIRE, "agent"); asm volatile("s_waitcnt vmcnt(0)" ::: "memory"); }
                        __syncthreads(); }
#ifndef NO_HS
                    if (mode == 1) {
                        hg_local_unit(P, lds, layer, g0, h, So, tid, lane, wave);
                        asm volatile("s_waitcnt vmcnt(0)" ::: "memory");
                        __syncthreads();
                        if (tid == 0) { __builtin_amdgcn_fence(__ATOMIC_RELEASE, "agent"); asm volatile("s_waitcnt vmcnt(0)" ::: "memory"); __hip_atomic_fetch_add(segdone + (tk >> 3), 1u, __ATOMIC_RELAXED, __HIP_MEMORY_SCOPE_AGENT); }
                    } else { hg_seq_unit(P, lds, layer, g0, nch, h, S0, So, mode, seg, (const float*)(ws + WS_LB) + (size_t)(mode == 2 ? (tk - T_SO) & 31 : 0) * NSEG * 16384, tid, lane, wave);
                        if (mode == 0) {
                            asm volatile("s_waitcnt vmcnt(0)" ::: "memory");
                            __syncthreads();
                            if (tid == 0) { __builtin_amdgcn_fence(__ATOMIC_RELEASE, "agent"); asm volatile("s_waitcnt vmcnt(0)" ::: "memory"); __hip_atomic_fetch_add(sampdone + ((tk - T_AS) >> 4), 1u, __ATOMIC_RELAXED, __HIP_MEMORY_SCOPE_AGENT); }
                        } }
#endif
                } else {
                    const bf16_t *Qp, *Kp, *VTp; const float *CLp, *BTp, *CMp, *KNp, *Kc = P.in[2], *Vc = P.in[3]; bf16_t* Yp; int vpitch, NT, nqw, qpos0, creft, ncache = 0;
                    if (tk < T_AP) {
                        const int idx = tk - T_HP, qb = 31 - (idx >> 6), bh = idx & 63, b = bh >> 3, h = bh & 7;
                        Qp = (const bf16_t*)(ws + WS_QB) + ((size_t)b * SEQ + qb * 256) * 512 + h * 64; Kp = (const bf16_t*)(ws + WS_KBP) + (size_t)b * SEQ * 512 + h * 64;
                        VTp = (const bf16_t*)(ws + WS_VTP) + (size_t)b * SEQ * 512 + h * 64; vpitch = 512; CLp = (const float*)(ws + WS_CL) + ((size_t)layer * KROWS + (size_t)b * SEQ) * 8 + h;
                        BTp = (const float*)(ws + WS_BT) + ((size_t)layer * NKT + b * 128) * 8 + h; CMp = (const float*)(ws + WS_CM) + ((size_t)layer * NKT + b * 128) * 8 + h; KNp = (const float*)(ws + WS_KN) + ((size_t)layer * NKT + b * 128) * 8 + h; NT = 4 * (qb + 1); nqw = 8; qpos0 = qb * 256; creft = qb * 4;
                        Yp = (bf16_t*)(ws + WS_YC) + ((size_t)b * SEQ + qb * 256) * 1024 + h * 64;
                    } else {
                        const int bh = tk - T_AP, b = bh >> 3, h = bh & 7;
                        Qp = (const bf16_t*)(ws + WS_QB) + ((size_t)MP + b * 64) * 512 + h * 64; Kp = (const bf16_t*)(ws + WS_KBS) + ((size_t)layer * KSROWS + (size_t)b * SKV) * 512 + h * 64;
                        VTp = (const bf16_t*)(ws + WS_VTS) + ((size_t)layer * KSROWS + (size_t)b * SKV) * 512 + h * 64; vpitch = 512; CLp = (const float*)(ws + WS_CL) + ((size_t)layer * KROWS + MP + (size_t)b * SKV) * 8 + h;
                        BTp = (const float*)(ws + WS_BT) + ((size_t)layer * NKT + 1024 + b * 33) * 8 + h; CMp = (const float*)(ws + WS_CM) + ((size_t)layer * NKT + 1024 + b * 33) * 8 + h; KNp = (const float*)(ws + WS_KN) + ((size_t)layer * NKT + 1024 + b * 33) * 8 + h; NT = 33; nqw = 2; qpos0 = PAST; creft = 32; ncache = 32; Kc = P.in[2] + ((size_t)(layer * DBAT + b) * PAST) * 512 + h * 64; Vc = P.in[3] + ((size_t)(layer * DBAT + b) * PAST) * 512 + h * 64;
                        Yp = (bf16_t*)(ws + WS_YC) + ((size_t)MP + b * 64) * 1024 + h * 64;
                    }
#ifndef NO_AT
                    attn_unit(lds, Qp, Kp, VTp, vpitch, CLp, BTp, CMp, KNp, NT, nqw, qpos0, creft, Yp, Kc, Vc, ncache, tid, lane, wave);
                    if (tk >= T_AP) {
                        asm volatile("s_waitcnt vmcnt(0)" ::: "memory");
                        __syncthreads();
                        if (tid == 0) { __builtin_amdgcn_fence(__ATOMIC_RELEASE, "agent"); asm volatile("s_waitcnt vmcnt(0)" ::: "memory"); __hip_atomic_fetch_add(sampdone + ((tk - T_AP) >> 5), 1u, __ATOMIC_RELAXED, __HIP_MEMORY_SCOPE_AGENT); }
                    }
#endif
                }
            }
        }
        if (lastrep || PROBE_CUT >= 3) GSYNC();
      }
        if (li % NREP_L == NREP_L - 1) {
            pg8::Gemm g{(const bf16_t*)(ws + WS_YC), (const bf16_t*)(ws + WS_WTOUT) + (size_t)layer * 1024 * 1024, MP, 1024, 1024};
            pg8::StaticOrder S; S.init(MP, 1024, (int)gridDim.x, (int)blockIdx.x);
            EpiOut E; E.XB = (bf16_t*)(ws + WS_XB); E.SS = (float*)(ws + WS_SS);
#ifndef NO_P3
            pg8::gemm_phase<EpiOut, pg8::StaticOrder, true, true>(lds, g, S, E);
#endif
        }
        if (lastrep) GSYNC();
    }
    {
        const float* SS = (const float*)(ws + WS_SS); const float* fg = P.in[12]; float* y = P.out + OFF_Y; const bf16_t* XB = (const bf16_t*)(ws + WS_XB);
        const int gw = blockIdx.x * 8 + wave, NGW = gridDim.x * 8;
        f32x4 g4[4];
#pragma unroll
        for (int j = 0; j < 4; ++j) g4[j] = ((const f32x4*)fg)[4 * lane + j];
        for (int r0 = gw; r0 < MT; r0 += 4 * NGW) {
            float sv[4]; u32x4 v[4][2];
#pragma unroll
            for (int q = 0; q < 4; ++q) { const int r = min(r0 + q * NGW, MT - 1); sv[q] = (lane < 16) ? SS[(size_t)r * 16 + lane] : 0.f;
                v[q][0] = ((const u32x4*)(XB + (size_t)r * 1024))[2 * lane]; v[q][1] = ((const u32x4*)(XB + (size_t)r * 1024))[2 * lane + 1]; }
#pragma unroll
            for (int q = 0; q < 4; ++q) { const int r = r0 + q * NGW; const float rinv = rsqrtf(wave_sum(sv[q]) * (1.0f / 1024.0f) + EPS);
                if (r < MT) {
#pragma unroll
                    for (int j = 0; j < 4; ++j) { const unsigned w0 = v[q][j >> 1][(j & 1) * 2], w1 = v[q][j >> 1][(j & 1) * 2 + 1];
                        f32x4 o; o[0] = bflo(w0) * rinv * g4[j][0]; o[1] = bfhi(w0) * rinv * g4[j][1]; o[2] = bflo(w1) * rinv * g4[j][2]; o[3] = bfhi(w1) * rinv * g4[j][3];
                        ((f32x4*)(y + (size_t)r * 1024))[4 * lane + j] = o; } } }
        }
    }
}

extern "C" void kernel_launch(void* const* d_in, const int* in_sizes, int n_in, void* d_out, int out_size, void* d_ws, size_t ws_size, hipStream_t stream) {
    static int grid = 0;
    if (grid == 0) {
        if (n_in != 13 || (size_t)out_size != OUT_TOTAL || ws_size < WS_END) { fprintf(stderr, "kernel_launch: unexpected sizes n_in=%d out=%d ws=%zu (need %zu)\n", n_in, out_size, ws_size, (size_t)WS_END); grid = -1; return; }
        int dev = 0, cus = 0, per_cu = 0;
        hipGetDevice(&dev); hipDeviceGetAttribute(&cus, hipDeviceAttributeMultiprocessorCount, dev);
        if (hipFuncSetAttribute((const void*)fwd_megakernel, hipFuncAttributeMaxDynamicSharedMemorySize, LDS_BYTES) != hipSuccess) { fprintf(stderr, "kernel_launch: hipFuncSetAttribute failed\n"); grid = -1; return; }
        if (hipOccupancyMaxActiveBlocksPerMultiprocessor(&per_cu, (const void*)fwd_megakernel, 512, LDS_BYTES) != hipSuccess || per_cu < 1) { fprintf(stderr, "kernel_launch: occupancy query says %d\n", per_cu); per_cu = 1; }
        (void)hipGetLastError();
        grid = cus;
    }
    if (grid < 0) return;
    if (hipMemsetAsync(d_ws, 0, 32768, stream) != hipSuccess) { fprintf(stderr, "kernel_launch: hipMemsetAsync failed\n"); return; }
    Params p{};
    for (int i = 0; i < 13; ++i) p.in[i] = (const float*)d_in[i];
    p.out = (float*)d_out; p.ws = (unsigned char*)d_ws;
    void* args[] = {&p};
    hipError_t e = hipLaunchCooperativeKernel((const void*)fwd_megakernel, dim3(grid), dim3(512), args, LDS_BYTES, stream);
    if (e != hipSuccess) fprintf(stderr, "cooperative launch failed: %s (grid %d)\n", hipGetErrorString(e), grid);
}
```

```cpp
#include <hip/hip_runtime.h>
#include <hip/hip_cooperative_groups.h>
#include <cstdio>
#include <cstdint>
namespace cg = cooperative_groups;
namespace pg8 {
#define PG8_LAS __attribute__((address_space(3)))
typedef unsigned short bf16_t;
typedef short bf16x8 __attribute__((ext_vector_type(8)));
typedef float f32x4 __attribute__((ext_vector_type(4)));
typedef unsigned u32x4 __attribute__((ext_vector_type(4)));
constexpr int BM = 256, BK = 64, HALF = 128, HTB = HALF * BK * 2  , STAGE_BYTES = 8 * HTB, NXCD = 8, WGM = 8;

__host__ __device__ __forceinline__ int lds_byte(int r, int c) { const int st = (r >> 4) * 2 + (c >> 5), rr = r & 15, cc = c & 31, ob = rr * 64 + cc * 2; return st * 1024 + (ob ^ (((ob >> 9) & 1) << 5)); }
__host__ __device__ __forceinline__ void stage_rc(int b, int& R, int& C) { const int st = b / 1024, sb = b % 1024, swz = sb ^ (((sb >> 9) & 1) << 5); R = (st >> 1) * 16 + swz / 64; C = (st & 1) * 32 + (swz % 64) / 2; }
__host__ __device__ __forceinline__ int perm32(int rho) { const int n = rho >> 4, i = rho & 15; return 8 * (i >> 2) + 4 * n + (i & 3); }

struct Unit { int pm, pn; };
struct Gemm { const bf16_t* A; const bf16_t* Bt; int M, N, K; };

struct StaticOrder {
    int nM, nN, nwg, G, c;
    __host__ __device__ void init(int M, int N, int G_, int c_) { nM = M / BM; nN = N / BM; nwg = nM * nN; G = G_; c = c_; }
    __host__ __device__ bool next(int i, Unit& u) const {
        const long L = (long)i * G + c; if (L >= nwg) return false;
        int wgid = (int)L; { const int q = nwg / NXCD, r = nwg % NXCD, xcd = wgid % NXCD, off = wgid / NXCD; wgid = (xcd < r ? xcd * (q + 1) : r * (q + 1) + (xcd - r) * q) + off; }
        const int nig = WGM * nN, gid = wgid / nig, fm = gid * WGM, gsz = (nM - fm) < WGM ? (nM - fm) : WGM;
        u.pm = fm + ((wgid % nig) % gsz); u.pn = (wgid % nig) / gsz; return true;
    }
    __device__ __forceinline__ void a_ready(const Unit&) const {}
    __device__ __forceinline__ void done(const Unit&) const {}
};

template <class Epi, class Sched, bool ALIGN_EPI = false, bool SP2 = false>
__device__ __forceinline__ void gemm_phase(PG8_LAS unsigned char* lds, const Gemm g, const Sched& S, const Epi& E) {
    int tid_ = threadIdx.x; asm volatile("" : "+v"(tid_));
    const int tid = tid_, wid = __builtin_amdgcn_readfirstlane(tid >> 6), lane = tid & 63, wr = wid >> 2, wc = wid & 3, fr = lane & 15, fq = lane >> 4;
    const int K = g.K, nt = K / BK;
    unsigned voffA[2], voffB[2];
#pragma unroll
    for (int i = 0; i < 2; ++i) { int R, C; stage_rc(tid * 16 + i * 8192, R, C); const int Rb = Epi::PERM ? ((R & ~31) + perm32(R & 31)) : R;
        voffA[i] = (unsigned)(R * K + C) * 2u; voffB[i] = (unsigned)(Rb * K + C) * 2u; }
    const size_t kstep = (size_t)(BK * 2);
    const size_t hstep = (size_t)HALF * K * 2;
    const size_t tstep = 2 * hstep;
    const unsigned ldsw = (unsigned)wid * 1024u;
    const int aoff = lds_byte(wr * 64 + fr, fq * 8), boff = lds_byte(wc * 32 + fr, fq * 8);
#define PG8_SA(b, h) (((b) * 2 + (h)) * HTB)
#define PG8_SB(b, h) ((4 + (b) * 2 + (h)) * HTB)
#define PG8_STAGE(bufoff, gbase, voff) do { _Pragma("unroll") for (int _i = 0; _i < 2; ++_i) \
        __builtin_amdgcn_global_load_lds((const unsigned*)((const char*)(gbase) + (voff)[_i]), (PG8_LAS unsigned*)(lds + (bufoff) + ldsw + _i * 8192), 16, 0, 0); } while (0)
#define PG8_LDA(dst, b, h) do { _Pragma("unroll") for (int m = 0; m < 4; ++m) _Pragma("unroll") for (int k = 0; k < 2; ++k) dst[m][k] = *(const PG8_LAS bf16x8*)(lds + PG8_SA(b, h) + aoff + m * 2048 + k * 1024); } while (0)
#define PG8_LDB(dst, b, h) do { _Pragma("unroll") for (int n = 0; n < 2; ++n) _Pragma("unroll") for (int k = 0; k < 2; ++k) dst[n][k] = *(const PG8_LAS bf16x8*)(lds + PG8_SB(b, h) + boff + n * 2048 + k * 1024); } while (0)
#define PG8_MMA(ai, bj, At, Bt) do { __builtin_amdgcn_s_setprio(1); _Pragma("unroll") for (int m = 0; m < 4; ++m) _Pragma("unroll") for (int n = 0; n < 2; ++n) _Pragma("unroll") for (int k = 0; k < 2; ++k) \
        acc[ai][bj][m][n] = __builtin_amdgcn_mfma_f32_16x16x32_bf16(Bt[n][k], At[m][k], acc[ai][bj][m][n], 0, 0, 0); __builtin_amdgcn_s_setprio(0); } while (0)
#define PG8_WAIT_V(n) asm volatile("s_waitcnt vmcnt(" #n ")" ::: "memory")
#define PG8_WAIT_L(n) asm volatile("s_waitcnt lgkmcnt(" #n ")" ::: "memory")
#define PG8_BAR __builtin_amdgcn_s_barrier()
#define PG8_SCHED __builtin_amdgcn_sched_barrier(0)
    Unit cur, nxt; int ui = 0;
    if (!S.next(0, cur)) return;
    f32x4 acc[2][2][4][2];
#pragma unroll
    for (int a = 0; a < 2; ++a)
#pragma unroll
        for (int b = 0; b < 2; ++b)
#pragma unroll
            for (int m = 0; m < 4; ++m)
#pragma unroll
                for (int n = 0; n < 2; ++n) acc[a][b][m][n] = (f32x4){0.f, 0.f, 0.f, 0.f};
    bf16x8 At[4][2], B0[2][2], B1[2][2];
    const char* cA = (const char*)g.A + (size_t)cur.pm * tstep; const char* cB = (const char*)g.Bt + (size_t)cur.pn * tstep;
    S.a_ready(cur);
    if constexpr (SP2) {
        PG8_STAGE(PG8_SB(0, 0), cB, voffB); PG8_STAGE(PG8_SB(0, 1), cB + hstep, voffB); PG8_STAGE(PG8_SA(0, 0), cA, voffA); PG8_STAGE(PG8_SA(0, 1), cA + hstep, voffA);
        if (wr == 1) PG8_BAR;
        PG8_WAIT_V(2); PG8_BAR;
        PG8_STAGE(PG8_SB(1, 0), cB + kstep, voffB); PG8_STAGE(PG8_SA(1, 0), cA + kstep, voffA); PG8_STAGE(PG8_SB(1, 1), cB + hstep + kstep, voffB);
        PG8_WAIT_V(6); PG8_BAR;
    } else {
        PG8_STAGE(PG8_SB(0, 0), cB, voffB); PG8_STAGE(PG8_SA(0, 0), cA, voffA); PG8_STAGE(PG8_SB(0, 1), cB + hstep, voffB); PG8_STAGE(PG8_SA(0, 1), cA + hstep, voffA);
        if (wr == 1) PG8_BAR;
        PG8_WAIT_V(4); PG8_BAR;
        PG8_STAGE(PG8_SB(1, 0), cB + kstep, voffB); PG8_STAGE(PG8_SA(1, 0), cA + kstep, voffA); PG8_STAGE(PG8_SB(1, 1), cB + hstep + kstep, voffB);
        PG8_WAIT_V(6); PG8_BAR;
    }
    for (;;) {
        const bool has_next = S.next(ui + 1, nxt);
        const char* nA = has_next ? (const char*)g.A + (size_t)nxt.pm * tstep : cA; const char* nB = has_next ? (const char*)g.Bt + (size_t)nxt.pn * tstep : cB;
        for (int t = 0; t < nt; t += 2) {
            const bool last = (t == nt - 2);
            const char* a1 = cA + (size_t)(t + 1) * kstep;
            const char* a2 = last ? nA : cA + (size_t)(t + 2) * kstep; const char* b2 = last ? nB : cB + (size_t)(t + 2) * kstep;
            const char* a3 = a2 + kstep; const char* b3 = b2 + kstep;
            if (last && has_next) S.a_ready(nxt);
            if constexpr (SP2) {
            PG8_LDB(B0, 0, 0); PG8_LDB(B1, 0, 1); PG8_SCHED; PG8_LDA(At, 0, 0); PG8_STAGE(PG8_SA(1, 1), a1 + hstep, voffA);
            PG8_WAIT_V(8); PG8_WAIT_L(0); PG8_BAR; PG8_MMA(0, 0, At, B0); PG8_MMA(0, 1, At, B1); PG8_BAR; PG8_SCHED;
            PG8_LDA(At, 0, 1); PG8_STAGE(PG8_SB(0, 0), b2, voffB); PG8_STAGE(PG8_SB(0, 1), b2 + hstep, voffB); PG8_STAGE(PG8_SA(0, 0), a2, voffA);
            PG8_WAIT_V(8); PG8_WAIT_L(0); PG8_BAR; PG8_MMA(1, 0, At, B0); PG8_MMA(1, 1, At, B1); PG8_BAR; PG8_SCHED;
            PG8_LDB(B0, 1, 0); PG8_LDB(B1, 1, 1); PG8_SCHED; PG8_LDA(At, 1, 0); PG8_STAGE(PG8_SA(0, 1), a2 + hstep, voffA);
            PG8_WAIT_V(8); PG8_WAIT_L(0); PG8_BAR; PG8_MMA(0, 0, At, B0); PG8_MMA(0, 1, At, B1); PG8_BAR; PG8_SCHED;
            PG8_LDA(At, 1, 1); PG8_STAGE(PG8_SB(1, 0), b3, voffB); PG8_STAGE(PG8_SB(1, 1), b3 + hstep, voffB); PG8_STAGE(PG8_SA(1, 0), a3, voffA);
            PG8_WAIT_V(8); PG8_WAIT_L(0); PG8_BAR; PG8_MMA(1, 0, At, B0); PG8_MMA(1, 1, At, B1); PG8_BAR; PG8_SCHED;
            } else {
            PG8_LDB(B0, 0, 0); PG8_SCHED; PG8_LDA(At, 0, 0); PG8_STAGE(PG8_SA(1, 1), a1 + hstep, voffA);
            PG8_WAIT_L(8); PG8_BAR; PG8_WAIT_L(0); PG8_MMA(0, 0, At, B0); PG8_BAR; PG8_SCHED;
            PG8_LDB(B1, 0, 1); PG8_STAGE(PG8_SB(0, 0), b2, voffB);
            PG8_BAR; PG8_WAIT_L(0); PG8_MMA(0, 1, At, B1); PG8_BAR;
            PG8_LDA(At, 0, 1); PG8_STAGE(PG8_SA(0, 0), a2, voffA);
            PG8_BAR; PG8_WAIT_L(0); PG8_MMA(1, 0, At, B0); PG8_BAR; PG8_SCHED;
            PG8_STAGE(PG8_SB(0, 1), b2 + hstep, voffB);
            PG8_WAIT_V(6); PG8_BAR; PG8_MMA(1, 1, At, B1); PG8_BAR;
            PG8_LDB(B0, 1, 0); PG8_SCHED; PG8_LDA(At, 1, 0); PG8_STAGE(PG8_SA(0, 1), a2 + hstep, voffA);
            PG8_WAIT_L(8); PG8_BAR; PG8_WAIT_L(0); PG8_MMA(0, 0, At, B0); PG8_BAR; PG8_SCHED;
            PG8_LDB(B1, 1, 1); PG8_STAGE(PG8_SB(1, 0), b3, voffB);
            PG8_BAR; PG8_WAIT_L(0); PG8_MMA(0, 1, At, B1); PG8_BAR;
            PG8_LDA(At, 1, 1); PG8_STAGE(PG8_SA(1, 0), a3, voffA);
            PG8_BAR; PG8_WAIT_L(0); PG8_MMA(1, 0, At, B0); PG8_BAR; PG8_SCHED;
            PG8_STAGE(PG8_SB(1, 1), b3 + hstep, voffB);
            PG8_WAIT_V(6); PG8_BAR; PG8_MMA(1, 1, At, B1); PG8_BAR;
            }
        }
        if constexpr (ALIGN_EPI) { if (wr == 0) PG8_BAR; }
        if constexpr (!Epi::AFTER_DRAIN) { E(acc, cur, wr, wc, fr, fq); S.done(cur); }
        if (!has_next) break;
#pragma unroll
        for (int a = 0; a < 2; ++a)
#pragma unroll
            for (int b = 0; b < 2; ++b)
#pragma unroll
                for (int m = 0; m < 4; ++m)
#pragma unroll
                    for (int n = 0; n < 2; ++n) acc[a][b][m][n] = (f32x4){0.f, 0.f, 0.f, 0.f};
        cur = nxt; cA = nA; cB = nB; ++ui;
        if constexpr (ALIGN_EPI) { if (wr == 1) PG8_BAR; }
    }
    PG8_WAIT_V(0);
    if constexpr (!ALIGN_EPI) { if (wr == 0) PG8_BAR; }
    PG8_BAR;
    if constexpr (Epi::AFTER_DRAIN) { E.fused(acc, cur, wr, wc, fr, fq, lds, wid, lane); S.done(cur); }
#undef PG8_SA
#undef PG8_SB
#undef PG8_STAGE
#undef PG8_LDA
#undef PG8_LDB
#undef PG8_MMA
#undef PG8_WAIT_V
#undef PG8_WAIT_L
#undef PG8_BAR
#undef PG8_SCHED
}
}

#define LAS __attribute__((address_space(3)))
typedef unsigned short bf16_t;
typedef short bf16x8 __attribute__((ext_vector_type(8)));
typedef float f32x4 __attribute__((ext_vector_type(4)));
typedef float f32x16 __attribute__((ext_vector_type(16)));
typedef unsigned u32x4 __attribute__((ext_vector_type(4)));
typedef unsigned u32x2 __attribute__((ext_vector_type(2)));

constexpr int DMODEL = 1024, SEQ = 8192, NBAT = 8, DEPTH = 2, DBAT = 16, DSEQ = 64, PAST = 2048;
constexpr int MP = NBAT * SEQ;
constexpr int MS = DBAT * DSEQ;
constexpr int MT = MP + MS;
constexpr int DIN = 4104, NPAD = 4352;
constexpr int SKV = PAST + DSEQ;
constexpr int KSROWS = DBAT * SKV;
constexpr int KROWS = MP + KSROWS;
constexpr int NG = MT / 64;
constexpr int NKT = KROWS / 64;
constexpr float EPS = 1e-6f;
constexpr float LOG2E = 1.4426950408889634f;
constexpr float QSCALE = 0.125f * LOG2E;

constexpr size_t OFF_Y = 0;
constexpr size_t OFF_KP = (size_t)MT * 1024;
constexpr size_t OFF_VP = OFF_KP + (size_t)DEPTH * MP * 512;
constexpr size_t OFF_LP = OFF_VP + (size_t)DEPTH * MP * 512;
constexpr size_t OFF_HP = OFF_LP + (size_t)DEPTH * MP * 8;
constexpr size_t OFF_KS = OFF_HP + (size_t)DEPTH * NBAT * 4 * 16384;
constexpr size_t OFF_VS = OFF_KS + (size_t)DEPTH * MS * 512;
constexpr size_t OFF_LS = OFF_VS + (size_t)DEPTH * MS * 512;
constexpr size_t OFF_HS = OFF_LS + (size_t)DEPTH * MS * 8;
constexpr size_t OUT_TOTAL = OFF_HS + (size_t)DEPTH * DBAT * 4 * 16384;

constexpr size_t al256(size_t x) { return (x + 255) & ~(size_t)255; }
constexpr size_t WS_CTL = 0;
constexpr size_t WS_BAR = 8192;
constexpr size_t WS_WTIN = 32768;
constexpr size_t WS_WTOUT = WS_WTIN + al256((size_t)DEPTH * NPAD * 1024 * 2);
constexpr size_t WS_XB = WS_WTOUT + al256((size_t)DEPTH * 1024 * 1024 * 2);
constexpr size_t WS_YC = WS_XB + al256((size_t)MT * 1024 * 2);
constexpr size_t WS_QB = WS_YC + al256((size_t)MT * 1024 * 2);
constexpr size_t WS_KBP = WS_QB + al256((size_t)MT * 512 * 2);
constexpr size_t WS_KBS = WS_KBP + al256((size_t)MP * 512 * 2);
constexpr size_t WS_VTP = WS_KBS + al256((size_t)DEPTH * KSROWS * 512 * 2);
constexpr size_t WS_VTS = WS_VTP + al256((size_t)MP * 512 * 2);
constexpr size_t WS_QE = WS_VTS + al256((size_t)DEPTH * KSROWS * 512 * 2);
constexpr size_t WS_HF = WS_QE + al256((size_t)MT * 512 * 2);
constexpr size_t WS_KDT = WS_HF + al256((size_t)MT * 512 * 4);
constexpr size_t WS_VTH = WS_KDT + al256((size_t)NG * 4 * 8192 * 2);
constexpr size_t WS_DG = WS_VTH + al256((size_t)NG * 4 * 8192 * 2);
constexpr size_t WS_CL = WS_DG + al256((size_t)NG * 4 * 128 * 4);
constexpr size_t WS_BT = WS_CL + al256((size_t)DEPTH * KROWS * 8 * 4);
constexpr size_t WS_SS = WS_BT + al256((size_t)DEPTH * NKT * 8 * 4);
constexpr size_t WS_CM = WS_SS + al256((size_t)16 * MT * 4);
constexpr size_t WS_KN = WS_CM + al256((size_t)DEPTH * NKT * 8 * 4);
constexpr size_t WS_LG = WS_KN + al256((size_t)DEPTH * NKT * 8 * 4);
constexpr size_t WS_LB = WS_LG + al256((size_t)NG * 4 * 128 * 4);
constexpr size_t WS_END = WS_LB + al256((size_t)256 * 16384 * 4);

static_assert(WS_END <= (size_t)1073741824, "d_ws map must fit 1 GiB");
constexpr int LDS_BYTES = 147456;
constexpr int LDS_MISC = 131072;

struct Params {
    const float* in[13];
    float* out;
    unsigned char* ws;
};

__device__ __forceinline__ unsigned pk2(float lo, float hi) {
    typedef float f2_t __attribute__((ext_vector_type(2))); typedef __bf16 b2_t __attribute__((ext_vector_type(2)));
    f2_t v = {lo, hi}; b2_t b = __builtin_convertvector(v, b2_t); return __builtin_bit_cast(unsigned, b);
}
__device__ __forceinline__ float bf2f(unsigned short b) { return __uint_as_float((unsigned)b << 16); }
__device__ __forceinline__ float bflo(unsigned w) { return __uint_as_float(w << 16); }
__device__ __forceinline__ float bfhi(unsigned w) { return __uint_as_float(w & 0xffff0000u); }
__device__ __forceinline__ unsigned short f2bf(float f) { return (unsigned short)(pk2(f, 0.f) & 0xffffu); }
__device__ __forceinline__ float fsilu(float x) { return x * __builtin_amdgcn_rcpf(1.f + __expf(-x)); }
__device__ __forceinline__ float logsig(float z) { return fminf(z, 0.f) - __logf(1.f + __expf(-fabsf(z))); }
__device__ __forceinline__ float wave_sum(float v) {
#pragma unroll
    for (int o = 1; o < 64; o <<= 1) v += __shfl_xor(v, o);
    return v;
}
__device__ __forceinline__ float wave_scan_incl(float v, int lane) {
#pragma unroll
    for (int o = 1; o < 64; o <<= 1) { float t = __shfl_up(v, o); if (lane >= o) v += t; }
    return v;
}
__device__ __forceinline__ float wave_scan_max(float v, int lane) {
#pragma unroll
    for (int o = 1; o < 64; o <<= 1) { float t = __shfl_up(v, o); if (lane >= o) v = fmaxf(v, t); }
    return v;
}
__device__ __forceinline__ float wave_min(float v) {
#pragma unroll
    for (int o = 1; o < 64; o <<= 1) v = fminf(v, __shfl_xor(v, o));
    return v;
}
__device__ __forceinline__ float sq8(u32x4 w) {
    float s = 0.f;
#pragma unroll
    for (int i = 0; i < 4; ++i) { const float a = bflo(w[i]), b = bfhi(w[i]); s += a * a + b * b; }
    return s;
}
#define XB_TMO      128
#define XB_XCNT(j)  (256  + 64 * (j))
#define XB_XSUB(j)  (1280 + 64 * (j))
#define XB_XGEN(j)  (2304 + 64 * (j))
#define XB_TOP      3328
#define XB_TOPGEN   3392
#define XCD_BAR_WORDS 3456
#define XB_SPIN_CAP (1u << 18)

__device__ __forceinline__ unsigned xb_ld(unsigned* p)              { return __hip_atomic_load(p, __ATOMIC_RELAXED, __HIP_MEMORY_SCOPE_AGENT); }
__device__ __forceinline__ unsigned xb_add(unsigned* p, unsigned v) { return __hip_atomic_fetch_add(p, v, __ATOMIC_RELAXED, __HIP_MEMORY_SCOPE_AGENT); }
__device__ __forceinline__ unsigned xb_xcc_id() { return (unsigned)__builtin_amdgcn_s_getreg((3 << 11) | 20) & 0xFu; }
#define XB_SPIN(cond, bar) do { unsigned _sp = 0; while (cond) { __builtin_amdgcn_s_sleep(1); \
    if ((++_sp & 255u) == 0u) { if (xb_ld(&(bar)[XB_TMO])) break; if (_sp > XB_SPIN_CAP) { atomicAdd(&(bar)[XB_TMO], 1u); break; } } } } while (0)

struct XcdBarrier {
    unsigned* bar; unsigned x;
    volatile LAS unsigned* st;
};

__device__ __forceinline__ XcdBarrier xcd_barrier_post(unsigned* bar, volatile LAS unsigned* st) {
    XcdBarrier b; b.bar = bar; b.x = xb_xcc_id(); b.st = st;
    if (threadIdx.x == 0) (void)xb_add(&bar[XB_XCNT(b.x)], 1u);
    return b;
}
__device__ __forceinline__ void xcd_barrier_complete(unsigned* bar, unsigned x, unsigned& nloc, unsigned& nx) {
    const unsigned G = gridDim.x * gridDim.y * gridDim.z;
    unsigned sum, cnt, mine, sp = 0u;
    for (;;) {
        sum = 0u; cnt = 0u; mine = 0u;
#pragma unroll
        for (unsigned j = 0; j < 16; ++j) { const unsigned c = xb_ld(&bar[XB_XCNT(j)]); sum += c; cnt += (c > 0u) ? 1u : 0u; mine = (j == x) ? c : mine; }
        if (sum == G) break;
        __builtin_amdgcn_s_sleep(1);
        if ((++sp & 255u) == 0u) { if (xb_ld(&bar[XB_TMO])) break; if (sp > XB_SPIN_CAP) { atomicAdd(&bar[XB_TMO], 1u); break; } }
    }
    nloc = mine > 0u ? mine : 1u; nx = cnt > 0u ? cnt : 1u;
}

__device__ __forceinline__ void xcd_barrier(const XcdBarrier& b) {
    asm volatile("s_waitcnt vmcnt(0)" ::: "memory");
    __syncthreads();
    if (threadIdx.x == 0) {
        unsigned* bar = b.bar;
        __builtin_amdgcn_s_waitcnt(0);
        unsigned nloc = b.st[0], nx = b.st[1];
        if (nloc == 0u) { xcd_barrier_complete(bar, b.x, nloc, nx); b.st[0] = nloc; b.st[1] = nx; }
        const unsigned old = xb_add(&bar[XB_XSUB(b.x)], 1u);
        const unsigned gen = old / nloc;
        if (old + 1u == (gen + 1u) * nloc) {
            __builtin_amdgcn_fence(__ATOMIC_RELEASE, "agent");
            asm volatile("s_waitcnt vmcnt(0)" ::: "memory");
            const unsigned og = xb_add(&bar[XB_TOP], 1u);
            const unsigned tg = og / nx;
            if (og + 1u == (tg + 1u) * nx) xb_add(&bar[XB_TOPGEN], 1u);
            else XB_SPIN(xb_ld(&bar[XB_TOPGEN]) == tg, bar);
            __builtin_amdgcn_fence(__ATOMIC_ACQUIRE, "agent");
            xb_add(&bar[XB_XGEN(b.x)], 1u);
            asm volatile("s_waitcnt vmcnt(0)" ::: "memory");
        } else {
            XB_SPIN(xb_ld(&bar[XB_XGEN(b.x)]) == gen, bar);
            __builtin_amdgcn_fence(__ATOMIC_ACQUIRE, "agent");
            asm volatile("s_waitcnt vmcnt(0)" ::: "memory");
        }
    }
    __syncthreads();
}

typedef short v4i16_t __attribute__((ext_vector_type(4)));
__device__ __forceinline__ u32x2 ldtr(LAS unsigned char* p) { const v4i16_t v = __builtin_amdgcn_ds_read_tr16_b64_v4i16((LAS v4i16_t*)p); return __builtin_bit_cast(u32x2, v); }
#define LDSW() asm volatile("s_waitcnt lgkmcnt(0)" ::: "memory")

__device__ __forceinline__ float row_rs(const float* SS, int r, int fq) {
    const f32x4 p4 = *(const f32x4*)(SS + (size_t)r * 16 + 4 * fq);
    float s = (p4[0] + p4[1]) + (p4[2] + p4[3]);
    s += __shfl_xor(s, 16); s += __shfl_xor(s, 32);
    return rsqrtf(s * (1.0f / 1024.0f) + EPS);
}
struct EpiIn {
    static constexpr bool PERM = true, AFTER_DRAIN = false;
    unsigned char* ws; float* out; const float* bfv; int layer;
    pg8::StaticOrder S; LAS unsigned char* rsl; mutable int ui;
    __device__ __forceinline__ void operator()(const f32x4 (&acc)[2][2][4][2], const pg8::Unit& u, int wr, int wc, int fr, int fq) const {
        unsigned char* ws = this->ws; float* out = this->out; const float* bfv = this->bfv;
        size_t zo = 0;
        asm volatile("" : "+v"(fr), "+v"(fq), "+s"(wr), "+s"(wc), "+s"(zo));
        ws += zo; out += zo; bfv += zo;
        const int cat = u.pn >> 1;
        const int rowb = u.pm * 256 + wr * 64 + fr;
        const bool samp = (u.pm >= MP / 256);
        const float* SS = (const float*)(ws + WS_SS);
        const int cb = (u.pn & 1) * 256 + wc * 32 + 8 * fq;
        LAS float* slot = (LAS float*)(rsl + (wr * 4 + wc) * 512);
        float rs[2][4];
        if (ui == 0) {
#pragma unroll
            for (int ai = 0; ai < 2; ++ai)
#pragma unroll
                for (int m = 0; m < 4; ++m) rs[ai][m] = row_rs(SS, rowb + ai * 128 + m * 16, fq);
        } else {
#pragma unroll
            for (int ai = 0; ai < 2; ++ai)
#pragma unroll
                for (int m = 0; m < 4; ++m) rs[ai][m] = slot[(ai * 4 + m) * 16 + fr];
        }
        pg8::Unit nx; const bool hasn = S.next(ui + 1, nx);
        f32x4 np[8];
        if (hasn) { const int nrowb = nx.pm * 256 + wr * 64 + fr;
#pragma unroll
            for (int q = 0; q < 8; ++q) np[q] = *(const f32x4*)(SS + (size_t)(nrowb + (q >> 2) * 128 + (q & 3) * 16) * 16 + 4 * fq); }
        if (cat == 0 || cat == 3 || cat == 4 || cat == 6 || cat == 7) {
            bf16_t* base; int pitch;
            if (cat == 0) { base = (bf16_t*)(ws + WS_QB); pitch = 512; } else if (cat == 3) { base = (bf16_t*)(ws + WS_YC); pitch = 1024; }
            else if (cat == 4) { base = (bf16_t*)(ws + WS_QE); pitch = 512; } else if (cat == 6) { base = (bf16_t*)(ws + WS_VTH); pitch = 512; } else { base = (bf16_t*)(ws + WS_YC) + 512; pitch = 1024; }
#pragma unroll
            for (int ai = 0; ai < 2; ++ai)
#pragma unroll
                for (int m = 0; m < 4; ++m) { const int r = rowb + ai * 128 + m * 16; const float sc = rs[ai][m];
#pragma unroll
                    for (int bj = 0; bj < 2; ++bj) { u32x4 w;
#pragma unroll
                        for (int n = 0; n < 2; ++n) { f32x4 v = acc[ai][bj][m][n] * sc;
                            if (cat == 0) v = v * QSCALE; else if (cat != 6) { v[0] = fsilu(v[0]); v[1] = fsilu(v[1]); v[2] = fsilu(v[2]); v[3] = fsilu(v[3]); }
                            w[2 * n] = pk2(v[0], v[1]); w[2 * n + 1] = pk2(v[2], v[3]); }
                        *(u32x4*)(base + (size_t)r * pitch + cb + bj * 128) = w; } }
        } else if (cat == 1 || cat == 2) {
#pragma unroll
            for (int ai = 0; ai < 2; ++ai)
#pragma unroll
                for (int m = 0; m < 4; ++m) { const int r = rowb + ai * 128 + m * 16; const float sc = rs[ai][m];
                    float* fo; bf16_t* bo;
                    if (!samp) { fo = out + (cat == 1 ? OFF_KP : OFF_VP) + ((size_t)layer * MP + r) * 512; bo = (bf16_t*)(ws + (cat == 1 ? WS_KBP : WS_VTP)) + (size_t)r * 512; }
                    else { const int q = r - MP; fo = out + (cat == 1 ? OFF_KS : OFF_VS) + ((size_t)layer * MS + q) * 512; bo = (bf16_t*)(ws + (cat == 1 ? WS_KBS : WS_VTS)) + ((size_t)layer * KSROWS + (size_t)((q >> 6) * SKV + PAST + (q & 63))) * 512; }
#pragma unroll
                    for (int bj = 0; bj < 2; ++bj) { u32x4 w;
#pragma unroll
                        for (int n = 0; n < 2; ++n) { const f32x4 v = acc[ai][bj][m][n] * sc; *(f32x4*)(fo + cb + bj * 128 + 4 * n) = v; w[2 * n] = pk2(v[0], v[1]); w[2 * n + 1] = pk2(v[2], v[3]); }
                        *(u32x4*)(bo + cb + bj * 128) = w; } }
        } else if (cat == 5) {
            float* HF = (float*)(ws + WS_HF);
#pragma unroll
            for (int ai = 0; ai < 2; ++ai)
#pragma unroll
                for (int m = 0; m < 4; ++m) { const int r = rowb + ai * 128 + m * 16; const float sc = rs[ai][m];
#pragma unroll
                    for (int bj = 0; bj < 2; ++bj)
#pragma unroll
                        for (int n = 0; n < 2; ++n) *(f32x4*)(HF + (size_t)r * 512 + cb + bj * 128 + n * 4) = acc[ai][bj][m][n] * sc; }
        } else {
            const f32x4 b0 = *(const f32x4*)(bfv), b1 = *(const f32x4*)(bfv + 4);
#pragma unroll
            for (int ai = 0; ai < 2; ++ai)
#pragma unroll
                for (int m = 0; m < 4; ++m) { const int r = rowb + ai * 128 + m * 16; const float sc = rs[ai][m];
                    if (wc == 0 && fq == 0) {
                        const f32x4 v0 = acc[ai][0][m][0] * sc + b0, v1 = acc[ai][0][m][1] * sc + b1; f32x4 o0, o1;
#pragma unroll
                        for (int i = 0; i < 4; ++i) { o0[i] = logsig(v0[i]); o1[i] = logsig(v1[i]); }
                        float* dst = samp ? (out + OFF_LS + ((size_t)layer * MS + (r - MP)) * 8) : (out + OFF_LP + ((size_t)layer * MP + r) * 8);
                        *(f32x4*)(dst) = o0; *(f32x4*)(dst + 4) = o1; } }
        }
        if (hasn) {
#pragma unroll
            for (int q = 0; q < 8; ++q) { float s_ = (np[q][0] + np[q][1]) + (np[q][2] + np[q][3]); s_ += __shfl_xor(s_, 16); s_ += __shfl_xor(s_, 32);
                if (fq == 0) slot[q * 16 + fr] = rsqrtf(s_ * (1.0f / 1024.0f) + EPS); }
        }
        ++ui;
    }
};

struct OneUnit {
    int pm, pn;
    __device__ __forceinline__ bool next(int i, pg8::Unit& u) const { if (i != 0) return false; u.pm = pm; u.pn = pn; return true; }
    __device__ __forceinline__ void a_ready(const pg8::Unit&) const {}
    __device__ __forceinline__ void done(const pg8::Unit&) const {}
};
struct EpiOut {
    static constexpr bool PERM = true, AFTER_DRAIN = false;
    bf16_t* XB;
    float* SS;
    __device__ __forceinline__ void operator()(const f32x4 (&acc)[2][2][4][2], const pg8::Unit& u, int wr, int wc, int fr, int fq) const {
        bf16_t* XB = this->XB; float* SS = this->SS;
        size_t zo = 0;
        asm volatile("" : "+v"(fr), "+v"(fq), "+s"(wr), "+s"(wc), "+s"(zo));
        XB += zo; SS += zo;
        const int rowb = u.pm * 256 + wr * 64 + fr;
        const int cb = u.pn * 256 + wc * 32 + 8 * fq;
#pragma unroll
        for (int ai = 0; ai < 2; ++ai)
#pragma unroll
            for (int m = 0; m < 4; ++m) { const int r = rowb + ai * 128 + m * 16;
                u32x4 rw[2];
#pragma unroll
                for (int bj = 0; bj < 2; ++bj) rw[bj] = *(const u32x4*)(XB + (size_t)r * 1024 + cb + bj * 128);
                float ss = 0.f;
#pragma unroll
                for (int bj = 0; bj < 2; ++bj) { u32x4 w;
#pragma unroll
                    for (int n = 0; n < 2; ++n) { f32x4 v = acc[ai][bj][m][n];
                        v[0] += bflo(rw[bj][2 * n]); v[1] += bfhi(rw[bj][2 * n]); v[2] += bflo(rw[bj][2 * n + 1]); v[3] += bfhi(rw[bj][2 * n + 1]);
                        ss += (v[0] * v[0] + v[1] * v[1]) + (v[2] * v[2] + v[3] * v[3]);
                        w[2 * n] = pk2(v[0], v[1]); w[2 * n + 1] = pk2(v[2], v[3]); }
                    *(u32x4*)(XB + (size_t)r * 1024 + cb + bj * 128) = w; }
                ss += __shfl_xor(ss, 16); ss += __shfl_xor(ss, 32);
                if (fq == 0) SS[(size_t)r * 16 + (u.pn * 4 + wc)] = ss; }
    }
};

__device__ __forceinline__ void tr_item(const float* src, size_t spitch, int nvalid, const float* scale, bf16_t* dst, size_t dpitch, LAS float* scr, int lane) {
    const int n = lane & 31;
#pragma unroll 16
    for (int i = 0; i < 32; ++i) { const int kk = 2 * i + (lane >> 5); float v = (n < nvalid) ? src[(size_t)kk * spitch + n] : 0.f; if (scale) v *= scale[kk]; scr[kk * 33 + n] = v; }
    LDSW();
    const int c = lane & 7;
#pragma unroll
    for (int j = 0; j < 4; ++j) { const int nn = (lane >> 3) + 8 * j; const LAS float* s = scr + (8 * c) * 33 + nn;
        u32x4 o; o.x = pk2(s[0 * 33], s[1 * 33]); o.y = pk2(s[2 * 33], s[3 * 33]); o.z = pk2(s[4 * 33], s[5 * 33]); o.w = pk2(s[6 * 33], s[7 * 33]);
        *(u32x4*)(dst + (size_t)nn * dpitch + 8 * c) = o; }
    LDSW();
}

__device__ __forceinline__ void p0_prologue(const Params& P, LAS unsigned char* lds, int tid, int lane, int wave) {
    unsigned char* ws = P.ws;
    LAS float* scr = (LAS float*)(lds + wave * 16384);
    const int gw = blockIdx.x * 8 + wave, NGW = gridDim.x * 8;
    const float* w_in = P.in[7]; const float* w_out = P.in[11]; const float* norm_g = P.in[6];
    bf16_t* WTIN = (bf16_t*)(ws + WS_WTIN); bf16_t* WTOUT = (bf16_t*)(ws + WS_WTOUT);
    constexpr int I_IN = 16 * (NPAD / 32), I_OUT = 16 * 32;
    constexpr int NIT = DEPTH * I_IN + DEPTH * I_OUT;
    for (int it = gw; it < NIT; it += NGW) {
        int r = it;
        if (r < DEPTH * I_IN) { const int l = r / I_IN; r -= l * I_IN; const int kb = r / (NPAD / 32), nb = r % (NPAD / 32), n0 = nb * 32;
            int sc = n0, nv = 32; if (n0 >= 4104) { sc = 0; nv = 0; } else if (n0 >= 4096) { sc = 1536; nv = 8; } else if (n0 >= 1536) sc = n0 + 8;
            tr_item(w_in + (size_t)l * 1024 * DIN + (size_t)(64 * kb) * DIN + sc, DIN, nv, norm_g + l * 1024 + 64 * kb, WTIN + ((size_t)l * NPAD + n0) * 1024 + 64 * kb, 1024, scr, lane);
            continue; }
        r -= DEPTH * I_IN;
        if (r < DEPTH * I_OUT) { const int l = r / I_OUT; r -= l * I_OUT; const int kb = r / 32, nb = r % 32;
            tr_item(w_out + (size_t)l * 1024 * 1024 + (size_t)(64 * kb) * 1024 + nb * 32, 1024, 32, nullptr, WTOUT + ((size_t)l * 1024 + nb * 32) * 1024 + 64 * kb, 1024, scr, lane);
            continue; }
    }
    bf16_t* XB = (bf16_t*)(ws + WS_XB); float* SS = (float*)(ws + WS_SS);
    for (int r0 = gw; r0 < MT; r0 += 4 * NGW) {
        f32x4 v[4][4];
#pragma unroll
        for (int q = 0; q < 4; ++q) { const int r = min(r0 + q * NGW, MT - 1);
            const float* src = (r < MP) ? (P.in[0] + (size_t)r * 1024) : (P.in[1] + (size_t)(r - MP) * 1024);
#pragma unroll
            for (int j = 0; j < 4; ++j) v[q][j] = ((const f32x4*)src)[lane + 64 * j]; }
#pragma unroll
        for (int q = 0; q < 4; ++q) { const int r = r0 + q * NGW;
            float s = 0.f;
#pragma unroll
            for (int j = 0; j < 4; ++j) s += (v[q][j][0] * v[q][j][0] + v[q][j][1] * v[q][j][1]) + (v[q][j][2] * v[q][j][2] + v[q][j][3] * v[q][j][3]);
            s = wave_sum(s);
            if (r < MT) {
#pragma unroll
                for (int j = 0; j < 4; ++j) { u32x2 w; w.x = pk2(v[q][j][0], v[q][j][1]); w.y = pk2(v[q][j][2], v[q][j][3]); ((u32x2*)(XB + (size_t)r * 1024))[lane + 64 * j] = w; }
                if (lane < 16) SS[(size_t)r * 16 + lane] = (lane == 0) ? s : 0.f;
            } }
    }
    for (int tl = gw; tl < DEPTH * DBAT * 32; tl += NGW) {
        const int l = tl / (DBAT * 32), q = tl % (DBAT * 32), b = q / 32, t = q % 32;
        const float* src = P.in[2] + ((size_t)(l * DBAT + b) * PAST + t * 64) * 512;
        float nmax = 0.f;
#pragma unroll 16
        for (int r = 0; r < 64; ++r) {
            const f32x4 a = ((const f32x4*)(src + (size_t)r * 512))[2 * lane], c = ((const f32x4*)(src + (size_t)r * 512))[2 * lane + 1];
            u32x4 w; w.x = pk2(a[0], a[1]); w.y = pk2(a[2], a[3]); w.z = pk2(c[0], c[1]); w.w = pk2(c[2], c[3]);
            float n2 = sq8(w); n2 += __shfl_xor(n2, 1); n2 += __shfl_xor(n2, 2); n2 += __shfl_xor(n2, 4); nmax = fmaxf(nmax, n2);
        }
        if ((lane & 7) == 0) ((float*)(ws + WS_KN))[((size_t)l * NKT + 1024 + b * 33 + t) * 8 + (lane >> 3)] = sqrtf(nmax);
    }
    float* CL = (float*)(ws + WS_CL); float* BT = (float*)(ws + WS_BT);
    for (int r = gw; r < DEPTH * DBAT * 32; r += NGW) {
        const int l = r / (DBAT * 32), q = r % (DBAT * 32), b = q / 32, t = q % 32;
        const float* src = P.in[4] + ((size_t)(l * DBAT + b) * PAST + t * 64 + lane) * 8;
        const size_t krow = (size_t)MP + (size_t)b * SKV + t * 64 + lane;
#pragma unroll
        for (int h = 0; h < 8; ++h) { const float c = wave_scan_incl(src[h], lane); CL[((size_t)l * KROWS + krow) * 8 + h] = c; const float cm = wave_min(c);
            if (lane == 63) { BT[((size_t)l * NKT + (krow >> 6)) * 8 + h] = c; ((float*)(ws + WS_CM))[((size_t)l * NKT + (krow >> 6)) * 8 + h] = cm; } }
    }
}

__device__ __forceinline__ void fox_cumsum(const Params& P, LAS unsigned char* lds, int layer, int tid, int lane, int wave) {
    asm volatile("" : "+v"(lane));
    float* CL = (float*)(P.ws + WS_CL) + (size_t)layer * KROWS * 8; float* BT = (float*)(P.ws + WS_BT) + (size_t)layer * NKT * 8;
    float* CM = (float*)(P.ws + WS_CM) + (size_t)layer * NKT * 8; float* KN = (float*)(P.ws + WS_KN) + (size_t)layer * NKT * 8;
    const float* lfP = P.out + OFF_LP + (size_t)layer * MP * 8; const float* lfS = P.out + OFF_LS + (size_t)layer * MS * 8;
    LAS float* part = (LAS float*)lds;
    for (int g = blockIdx.x; g < NG; g += gridDim.x) {
        const float* src; size_t krow0;
        if (g < MP / 64) { src = lfP + (size_t)g * 64 * 8; krow0 = (size_t)g * 64; }
        else { const int b = g - MP / 64; src = lfS + (size_t)b * 64 * 8; krow0 = (size_t)MP + (size_t)b * SKV + PAST; }
        const bf16_t* kb = (g < MP / 64) ? ((const bf16_t*)(P.ws + WS_KBP) + krow0 * 512) : ((const bf16_t*)(P.ws + WS_KBS) + ((size_t)layer * KSROWS + (krow0 - MP)) * 512);
        u32x4 kw[8];
#pragma unroll
        for (int r = 0; r < 8; ++r) kw[r] = ((const u32x4*)(kb + (size_t)(8 * wave + r) * 512))[lane];
        float hv[8];
        if (wave == 0) {
#pragma unroll
            for (int h = 0; h < 8; ++h) hv[h] = src[(size_t)lane * 8 + h];
        }
        float nmax = 0.f;
#pragma unroll
        for (int r = 0; r < 8; ++r) { float n2 = sq8(kw[r]); n2 += __shfl_xor(n2, 1); n2 += __shfl_xor(n2, 2); n2 += __shfl_xor(n2, 4); nmax = fmaxf(nmax, n2); }
        if ((lane & 7) == 0) part[wave * 8 + (lane >> 3)] = nmax;
        if (wave == 0) {
#pragma unroll
            for (int h = 0; h < 8; ++h) { const float c = wave_scan_incl(hv[h], lane); CL[(krow0 + lane) * 8 + h] = c; const float cm = wave_min(c);
                if (lane == 63) { BT[(krow0 >> 6) * 8 + h] = c; CM[(krow0 >> 6) * 8 + h] = cm; } }
        }
        __syncthreads();
        if (tid < 8) { float m = part[tid];
#pragma unroll
            for (int w = 1; w < 8; ++w) m = fmaxf(m, part[w * 8 + tid]);
            KN[(krow0 >> 6) * 8 + tid] = sqrtf(m); }
        __syncthreads();
    }
}

#define MFMA16(a, b, c) __builtin_amdgcn_mfma_f32_16x16x32_bf16((a), (b), (c), 0, 0, 0)
#define MFMA32(a, b, c) __builtin_amdgcn_mfma_f32_32x32x16_bf16((a), (b), (c), 0, 0, 0)

constexpr int PP_QT = 0, PP_KT = 17408, PP_VT = 34816, PP_AM = 53248, PP_TOT = 62464;
__device__ __forceinline__ void hg_prepass_unit(const Params& P, LAS unsigned char* lds, int layer, int g, int h, int tid, int lane, int wave) {
    unsigned char* ws = P.ws; const float* hl = P.in[9];
    size_t zo = 0;
    asm volatile("" : "+v"(tid), "+v"(lane), "+s"(zo), "+s"(g), "+s"(h));
    ws += zo; hl += zo;
    const int k = tid & 127, tq = tid >> 7, fr = lane & 15, fq = lane >> 4;
    float* HF = (float*)(ws + WS_HF); bf16_t* QE = (bf16_t*)(ws + WS_QE); bf16_t* KDT = (bf16_t*)(ws + WS_KDT) + (size_t)(g * 4 + h) * 8192;
    const bf16_t* HI = (const bf16_t*)(ws + WS_VTH) + (size_t)g * 64 * 512 + h * 128; float* DG = (float*)(ws + WS_DG) + (size_t)(g * 4 + h) * 128;
    float lbv = 0.f;
    if (layer > 0) { lbv = __builtin_amdgcn_rcpf(1.f + __expf(hl[h * 128 + k] - hl[512 + h * 128 + k])); }
    const float oml = 1.f - lbv;
    const size_t e0 = ((size_t)g * 64 + tq * 16) * 512 + h * 128 + k;
    float bc[16], kk[16]; unsigned short qv[16];
    float run = 0.f;
#pragma unroll
    for (int i = 0; i < 16; ++i) qv[i] = QE[e0 + (size_t)i * 512];
#pragma unroll
    for (int i = 0; i < 16; ++i) { const float z = HF[e0 + (size_t)i * 512]; const float ls = logsig(z);
        const float lf = (layer == 0) ? ls : __logf(lbv + oml * __expf(ls)); run += lf; bc[i] = run; kk[i] = oml * __builtin_amdgcn_rcpf(1.f + __expf(z)); }
    LAS float* tot = (LAS float*)(lds + PP_TOT);
    tot[tq * 128 + k] = run;
#pragma unroll
    for (int j = 0; j < 2; ++j) { const int idx = tid + 512 * j, rc = idx >> 4, ch = idx & 15; const u32x4 v = *(const u32x4*)(HI + (size_t)rc * 512 + ch * 8); *(LAS u32x4*)(lds + PP_VT + rc * 272 + ch * 16) = v; }
    __syncthreads();
    const float t0 = tot[k], t1 = tot[128 + k], t2 = tot[256 + k], t3 = tot[384 + k];
    const float off = (tq > 0 ? t0 : 0.f) + (tq > 1 ? t1 : 0.f) + (tq > 2 ? t2 : 0.f);
    const float bmid = t0 + t1, blast = (t0 + t1) + (t2 + t3);
    unsigned kdp[8];
#pragma unroll
    for (int i = 0; i < 16; i += 2) {
        float kd2[2];
#pragma unroll
        for (int j = 0; j < 2; ++j) { const int ii = i + j; const float b = bc[ii] + off; const float q = bf2f(qv[ii]);
            const float qe = q * __expf(b), kd = kk[ii] * __expf(blast - b), qt = q * __expf(b - bmid), kt = kk[ii] * __expf(bmid - b);
            QE[e0 + (size_t)ii * 512] = f2bf(qe); kd2[j] = kd;
            const int t = tq * 16 + ii;
            *(LAS bf16_t*)(lds + PP_QT + t * 272 + k * 2) = f2bf(qt); *(LAS bf16_t*)(lds + PP_KT + t * 272 + k * 2) = f2bf(kt); }
        kdp[i >> 1] = pk2(kd2[0], kd2[1]);
    }
    { u32x4 w0 = {kdp[0], kdp[1], kdp[2], kdp[3]}, w1 = {kdp[4], kdp[5], kdp[6], kdp[7]};
      *(u32x4*)(KDT + k * 64 + tq * 16) = w0; *(u32x4*)(KDT + k * 64 + tq * 16 + 8) = w1; }
    if (tq == 0) { DG[k] = __expf(blast); ((float*)(ws + WS_LG))[(size_t)(g * 4 + h) * 128 + k] = blast; }
    __syncthreads();
    { const int mt = wave >> 1;
#pragma unroll
      for (int nn = 0; nn < 2; ++nn) { const int nt = 2 * (wave & 1) + nn; f32x4 a4 = {0.f, 0.f, 0.f, 0.f};
#pragma unroll
          for (int ks = 0; ks < 4; ++ks) { const bf16x8 a = *(const LAS bf16x8*)(lds + PP_QT + (16 * mt + fr) * 272 + (32 * ks + 8 * fq) * 2);
              const bf16x8 b = *(const LAS bf16x8*)(lds + PP_KT + (16 * nt + fr) * 272 + (32 * ks + 8 * fq) * 2); a4 = MFMA16(a, b, a4); }
#pragma unroll
          for (int rg = 0; rg < 4; ++rg) { const int t = 16 * mt + 4 * fq + rg, s = 16 * nt + fr; const float v = (s <= t) ? a4[rg] : 0.f;
              *(LAS bf16_t*)(lds + PP_AM + t * 144 + s * 2) = f2bf(v); } } }
    __syncthreads();
    { float* OI = HF + (size_t)g * 64 * 512 + h * 128 + 16 * wave + fr;
#pragma unroll
      for (int mt = 0; mt < 4; ++mt) { f32x4 a4 = {0.f, 0.f, 0.f, 0.f};
#pragma unroll
          for (int ks = 0; ks < 2; ++ks) { const bf16x8 a = *(const LAS bf16x8*)(lds + PP_AM + (16 * mt + fr) * 144 + (32 * ks + 8 * fq) * 2);
              const int trq = (lane & 15) >> 2, trp = lane & 3;
              const u32x2 bl = ldtr(lds + PP_VT + (32 * ks + 8 * fq + trq) * 272 + (16 * wave + 4 * trp) * 2), bh = ldtr(lds + PP_VT + (32 * ks + 8 * fq + 4 + trq) * 272 + (16 * wave + 4 * trp) * 2);
              const u32x4 bw = {bl.x, bl.y, bh.x, bh.y}; a4 = MFMA16(a, __builtin_bit_cast(bf16x8, bw), a4); }
#pragma unroll
          for (int rg = 0; rg < 4; ++rg) OI[(size_t)(16 * mt + 4 * fq + rg) * 512] = a4[rg]; } }
    __syncthreads();
}

constexpr int HS_QE = 0, HS_KD = 17408, HS_VT = 35840, HS_D = 54272, HS_O = 54784, HS_G = 54784 + 33792, HS_DS = HS_G + 512, HS_DC = HS_DS + 4096;
constexpr int NSEG = 8, SEGC = 16;
__device__ __forceinline__ void hg_seq_unit(const Params& P, LAS unsigned char* lds, int layer, int g0, int nch, int h, const float* S0, float* Sout, int mode, int seg, const float* Lb, int tid, int lane, int wave) {
    unsigned char* ws = P.ws; const float* gnp = P.in[10] + layer * 512 + h * 128;
    size_t zo = 0;
    asm volatile("" : "+v"(tid), "+v"(lane), "+s"(zo), "+s"(g0), "+s"(nch), "+s"(h), "+s"(mode), "+s"(seg));
    ws += zo; gnp += zo; S0 += zo; Sout += zo; Lb += zo;
    const int fr = lane & 15, fq = lane >> 4;
    const bf16_t* QE = (const bf16_t*)(ws + WS_QE); const bf16_t* KDT = (const bf16_t*)(ws + WS_KDT); const bf16_t* HI = (const bf16_t*)(ws + WS_VTH);
    const float* DG = (const float*)(ws + WS_DG); float* OI = (float*)(ws + WS_HF); bf16_t* YC = (bf16_t*)(ws + WS_YC);
    f32x4 S[8];
#pragma unroll
    for (int kb = 0; kb < 8; ++kb) S[kb] = (f32x4){0.f, 0.f, 0.f, 0.f};
    if (mode == 0) {
#pragma unroll
        for (int kb = 0; kb < 8; ++kb)
#pragma unroll
            for (int rg = 0; rg < 4; ++rg) S[kb][rg] = S0[(size_t)(16 * kb + 4 * fq + rg) * 128 + 16 * wave + fr];
    }
    if (mode == 2) {
        const float* LG = (const float*)(ws + WS_LG);
        if (tid < 128) {
            const int gb = g0 - seg * SEGC;
            for (int j = 0; j < seg; ++j) { float a = 0.f;
#pragma unroll
                for (int c = 0; c < SEGC; ++c) a += LG[((size_t)(gb + SEGC * j + c) * 4 + h) * 128 + tid];
                *(LAS float*)(lds + HS_DS + (j * 128 + tid) * 4) = __expf(a); }
            float run = 0.f;
#pragma unroll
            for (int c = 0; c < SEGC; ++c) { *(LAS float*)(lds + HS_DC + (c * 128 + tid) * 4) = __expf(run); run += LG[((size_t)(g0 + c) * 4 + h) * 128 + tid]; }
            *(LAS float*)(lds + HS_DS + (seg * 128 + tid) * 4) = __expf(run);
        }
        __syncthreads();
        for (int j = 0; j < seg; ++j) { const float* Lj = Lb + (size_t)j * 16384;
#pragma unroll
            for (int kb = 0; kb < 8; ++kb) { const f32x4 d4 = *(const LAS f32x4*)(lds + HS_DS + (j * 128 + 16 * kb + 4 * fq) * 4);
#pragma unroll
                for (int rg = 0; rg < 4; ++rg) S[kb][rg] = S[kb][rg] * d4[rg] + Lj[(size_t)(16 * kb + 4 * fq + rg) * 128 + 16 * wave + fr]; } }
    }
    const int nt = tid >> 3, nseg = tid & 7;
    if (tid < 128) *(LAS float*)(lds + HS_G + tid * 4) = gnp[tid];
    u32x4 pq[2], pkd[2], pv[2]; f32x4 pd;
#define HS_ISSUE(g) do { _Pragma("unroll") for (int j = 0; j < 2; ++j) { const int idx = tid + 512 * j; \
        pq[j] = *(const u32x4*)(QE + ((size_t)(g) * 64 + (idx >> 4)) * 512 + h * 128 + (idx & 15) * 8); \
        if (mode != 2) { pkd[j] = *(const u32x4*)(KDT + (size_t)((g) * 4 + h) * 8192 + idx * 8); pv[j] = *(const u32x4*)(HI + ((size_t)(g) * 64 + (idx >> 4)) * 512 + h * 128 + (idx & 15) * 8); } } \
        if (mode != 2 && tid < 32) pd = *(const f32x4*)(DG + (size_t)((g) * 4 + h) * 128 + tid * 4); } while (0)
#define HS_COMMIT() do { _Pragma("unroll") for (int j = 0; j < 2; ++j) { const int idx = tid + 512 * j; \
        *(LAS u32x4*)(lds + HS_QE + (idx >> 4) * 272 + (idx & 15) * 16) = pq[j]; \
        if (mode != 2) { *(LAS u32x4*)(lds + HS_KD + (idx >> 3) * 144 + (idx & 7) * 16) = pkd[j]; *(LAS u32x4*)(lds + HS_VT + (idx >> 4) * 272 + (idx & 15) * 16) = pv[j]; } } \
        if (mode != 2 && tid < 32) *(LAS f32x4*)(lds + HS_D + tid * 16) = pd; } while (0)
    HS_ISSUE(g0); HS_COMMIT();
    u32x4 gt0 = {0u, 0u, 0u, 0u}, gt1 = {0u, 0u, 0u, 0u}; f32x4 oi[4];
#define HS_LOAD_OI(g) do { _Pragma("unroll") for (int mt = 0; mt < 4; ++mt) _Pragma("unroll") for (int rg = 0; rg < 4; ++rg) \
        oi[mt][rg] = OI[((size_t)(g) * 64 + 16 * mt + 4 * fq + rg) * 512 + h * 128 + 16 * wave + fr]; } while (0)
#define HS_LOAD_GT(g) do { const size_t yo_ = ((size_t)(g) * 64 + nt) * 1024 + 512 + h * 128 + 16 * nseg; gt0 = *(const u32x4*)(YC + yo_); gt1 = *(const u32x4*)(YC + yo_ + 8); } while (0)
    HS_LOAD_OI(g0); if (mode != 1) HS_LOAD_GT(g0);
    __syncthreads();
    for (int c = 0; c < nch; ++c) {
        const int g = g0 + c;
        if (c + 1 < nch) HS_ISSUE(g + 1);
        const size_t yoff = ((size_t)g * 64 + nt) * 1024 + 512 + h * 128 + 16 * nseg;
        bf16x8 sb[4];
        if (mode == 2) {
#pragma unroll
            for (int ks = 0; ks < 4; ++ks) { const f32x4 da = *(const LAS f32x4*)(lds + HS_DC + (c * 128 + 32 * ks + 4 * fq) * 4), db = *(const LAS f32x4*)(lds + HS_DC + (c * 128 + 32 * ks + 16 + 4 * fq) * 4);
                const f32x4 x = S[2 * ks] * da, y = S[2 * ks + 1] * db; u32x4 w; w.x = pk2(x[0], x[1]); w.y = pk2(x[2], x[3]); w.z = pk2(y[0], y[1]); w.w = pk2(y[2], y[3]); sb[ks] = __builtin_bit_cast(bf16x8, w); }
        } else {
#pragma unroll
            for (int ks = 0; ks < 4; ++ks) { u32x4 w; w.x = pk2(S[2 * ks][0], S[2 * ks][1]); w.y = pk2(S[2 * ks][2], S[2 * ks][3]); w.z = pk2(S[2 * ks + 1][0], S[2 * ks + 1][1]); w.w = pk2(S[2 * ks + 1][2], S[2 * ks + 1][3]);
                sb[ks] = __builtin_bit_cast(bf16x8, w); }
        }
#pragma unroll
        for (int mp = 0; mp < 2; ++mp) { u32x2 alo[2][4], ahi[2][4];
#pragma unroll
          for (int m2 = 0; m2 < 2; ++m2)
#pragma unroll
              for (int ks = 0; ks < 4; ++ks) { const int mt = 2 * mp + m2; alo[m2][ks] = *(const LAS u32x2*)(lds + HS_QE + (16 * mt + fr) * 272 + (32 * ks + 4 * fq) * 2);
                  ahi[m2][ks] = *(const LAS u32x2*)(lds + HS_QE + (16 * mt + fr) * 272 + (32 * ks + 16 + 4 * fq) * 2); }
          __builtin_amdgcn_sched_barrier(0);
#pragma unroll
          for (int m2 = 0; m2 < 2; ++m2) { const int mt = 2 * mp + m2; f32x4 o4 = oi[mt];
#pragma unroll
              for (int ks = 0; ks < 4; ++ks) { const u32x4 aw = {alo[m2][ks].x, alo[m2][ks].y, ahi[m2][ks].x, ahi[m2][ks].y}; o4 = MFMA16(__builtin_bit_cast(bf16x8, aw), sb[ks], o4); }
              if (mode == 1) {
#pragma unroll
                  for (int rg = 0; rg < 4; ++rg) OI[((size_t)g * 64 + 16 * mt + 4 * fq + rg) * 512 + h * 128 + 16 * wave + fr] = o4[rg];
              } else {
#pragma unroll
                  for (int rg = 0; rg < 4; ++rg) *(LAS float*)(lds + HS_O + ((16 * mt + 4 * fq + rg) * 132 + 16 * wave + fr) * 4) = o4[rg];
              } } }
        if (c + 1 < nch) HS_LOAD_OI(g + 1);
        if (mode != 2) {
          const int trq = (lane & 15) >> 2, trp = lane & 3;
          const u32x2 v0 = ldtr(lds + HS_VT + (8 * fq + trq) * 272 + (16 * wave + 4 * trp) * 2), v1 = ldtr(lds + HS_VT + (8 * fq + 4 + trq) * 272 + (16 * wave + 4 * trp) * 2);
          const u32x2 v2 = ldtr(lds + HS_VT + (32 + 8 * fq + trq) * 272 + (16 * wave + 4 * trp) * 2), v3 = ldtr(lds + HS_VT + (32 + 8 * fq + 4 + trq) * 272 + (16 * wave + 4 * trp) * 2);
          const u32x4 bw0 = {v0.x, v0.y, v1.x, v1.y}, bw1 = {v2.x, v2.y, v3.x, v3.y};
          const bf16x8 b0 = __builtin_bit_cast(bf16x8, bw0), b1 = __builtin_bit_cast(bf16x8, bw1);
#pragma unroll
          for (int hf = 0; hf < 2; ++hf) { f32x4 d4[4]; bf16x8 a0[4], a1[4];
#pragma unroll
              for (int q = 0; q < 4; ++q) { const int kb = 4 * hf + q; d4[q] = *(const LAS f32x4*)(lds + HS_D + (16 * kb + 4 * fq) * 4);
                  a0[q] = *(const LAS bf16x8*)(lds + HS_KD + (16 * kb + fr) * 144 + (8 * fq) * 2); a1[q] = *(const LAS bf16x8*)(lds + HS_KD + (16 * kb + fr) * 144 + (32 + 8 * fq) * 2); }
              __builtin_amdgcn_sched_barrier(0);
#pragma unroll
              for (int q = 0; q < 4; ++q) { const int kb = 4 * hf + q; S[kb] = S[kb] * d4[q]; S[kb] = MFMA16(a0[q], b0, S[kb]); S[kb] = MFMA16(a1[q], b1, S[kb]); } } }
        __syncthreads();
        if (mode != 1) { f32x4 v[4]; float ss = 0.f;
#pragma unroll
          for (int j = 0; j < 4; ++j) { v[j] = *(const LAS f32x4*)(lds + HS_O + (nt * 132 + 16 * nseg + 4 * j) * 4); ss += (v[j][0] * v[j][0] + v[j][1] * v[j][1]) + (v[j][2] * v[j][2] + v[j][3] * v[j][3]); }
          ss += __shfl_xor(ss, 1); ss += __shfl_xor(ss, 2); ss += __shfl_xor(ss, 4);
          const float rinv = rsqrtf(ss * (1.0f / 128.0f) + EPS);
          const unsigned gw_[8] = {gt0.x, gt0.y, gt0.z, gt0.w, gt1.x, gt1.y, gt1.z, gt1.w};
          unsigned ow[8];
#pragma unroll
          for (int j = 0; j < 8; ++j) { const f32x4 gq = *(const LAS f32x4*)(lds + HS_G + (16 * nseg + 4 * (j >> 1)) * 4); const float g0_ = gq[(j & 1) * 2], g1_ = gq[(j & 1) * 2 + 1];
              const float a = v[j >> 1][(j & 1) * 2] * rinv * g0_ * bflo(gw_[j]); const float b = v[j >> 1][(j & 1) * 2 + 1] * rinv * g1_ * bfhi(gw_[j]); ow[j] = pk2(a, b); }
          const u32x4 o0 = {ow[0], ow[1], ow[2], ow[3]}, o1 = {ow[4], ow[5], ow[6], ow[7]};
          *(u32x4*)(YC + yoff) = o0; *(u32x4*)(YC + yoff + 8) = o1;
          if (c + 1 < nch) HS_LOAD_GT(g + 1); }
        if (c + 1 < nch) HS_COMMIT();
        __syncthreads();
    }
    if (mode == 2) {
        if (seg == NSEG - 1) {
            const float* Lj = Lb + (size_t)seg * 16384;
#pragma unroll
            for (int kb = 0; kb < 8; ++kb) { const f32x4 d4 = *(const LAS f32x4*)(lds + HS_DS + (seg * 128 + 16 * kb + 4 * fq) * 4);
#pragma unroll
                for (int rg = 0; rg < 4; ++rg) Sout[(size_t)(16 * kb + 4 * fq + rg) * 128 + 16 * wave + fr] = S[kb][rg] * d4[rg] + Lj[(size_t)(16 * kb + 4 * fq + rg) * 128 + 16 * wave + fr]; }
        }
    } else {
#pragma unroll
        for (int kb = 0; kb < 8; ++kb)
#pragma unroll
            for (int rg = 0; rg < 4; ++rg) Sout[(size_t)(16 * kb + 4 * fq + rg) * 128 + 16 * wave + fr] = S[kb][rg];
    }
    __syncthreads();
#undef HS_ISSUE
#undef HS_COMMIT
#undef HS_LOAD_OI
#undef HS_LOAD_GT
}

constexpr int HL_QE = 0, HL_KD = 17408, HL_VT = 35840, HL_D = 53248, HL_QT = 53760, HL_KT = 71168, HL_AM = 88576, HL_TOT = 97792;
__device__ __forceinline__ void hg_local_unit(const Params& P, LAS unsigned char* lds, int layer, int g0, int h, float* Sout, int tid, int lane, int wave) {
    unsigned char* ws = P.ws; const float* hl = P.in[9];
    size_t zo = 0;
    asm volatile("" : "+v"(tid), "+v"(lane), "+s"(zo), "+s"(g0), "+s"(h));
    ws += zo; hl += zo; Sout += zo;
    const int k = tid & 127, tq = tid >> 7, fr = lane & 15, fq = lane >> 4;
    float* HF = (float*)(ws + WS_HF); bf16_t* QE = (bf16_t*)(ws + WS_QE); const bf16_t* HIb = (const bf16_t*)(ws + WS_VTH); float* LG = (float*)(ws + WS_LG);
    float lbv = 0.f;
    if (layer > 0) lbv = __builtin_amdgcn_rcpf(1.f + __expf(hl[h * 128 + k] - hl[512 + h * 128 + k]));
    const float oml = 1.f - lbv;
    f32x4 S[8];
#pragma unroll
    for (int kb = 0; kb < 8; ++kb) S[kb] = (f32x4){0.f, 0.f, 0.f, 0.f};
    float z[16]; unsigned short qv[16]; u32x4 hv[2];
#define HL_E0(gg) (((size_t)(gg) * 64 + tq * 16) * 512 + h * 128 + k)
#define HL_LOADZ(gg) do { const size_t e_ = HL_E0(gg); _Pragma("unroll") for (int i = 0; i < 16; ++i) z[i] = HF[e_ + (size_t)i * 512]; } while (0)
#define HL_LOADQ(gg) do { const size_t e_ = HL_E0(gg); _Pragma("unroll") for (int i = 0; i < 16; ++i) qv[i] = QE[e_ + (size_t)i * 512]; } while (0)
#define HL_LOADH(gg) do { const bf16_t* hi_ = HIb + (size_t)(gg) * 64 * 512 + h * 128; _Pragma("unroll") for (int j = 0; j < 2; ++j) { const int idx = tid + 512 * j; hv[j] = *(const u32x4*)(hi_ + (size_t)(idx >> 4) * 512 + (idx & 15) * 8); } } while (0)
    HL_LOADZ(g0); HL_LOADQ(g0); HL_LOADH(g0);
    for (int c = 0; c < SEGC; ++c) {
        const int g = g0 + c;
        const size_t e0 = HL_E0(g);
        float bc[16], kk[16];
#pragma unroll
        for (int j = 0; j < 2; ++j) { const int idx = tid + 512 * j; *(LAS u32x4*)(lds + HL_VT + (idx >> 4) * 272 + (idx & 15) * 16) = hv[j]; }
        float run = 0.f;
#pragma unroll
        for (int i = 0; i < 16; ++i) { const float zz = z[i]; const float e = __expf(-fabsf(zz)), r = __builtin_amdgcn_rcpf(1.f + e), er = e * r;
            const float lf = (layer == 0) ? (fminf(zz, 0.f) - __logf(1.f + e)) : __logf(lbv + oml * (zz > 0.f ? r : er));
            run += lf; bc[i] = run; kk[i] = oml * (zz > 0.f ? er : r); }
        *(LAS float*)(lds + HL_TOT + (tq * 128 + k) * 4) = run;
        if (c + 1 < SEGC) { HL_LOADZ(g + 1); HL_LOADH(g + 1); }
        __syncthreads();
        const float t0 = *(const LAS float*)(lds + HL_TOT + k * 4), t1 = *(const LAS float*)(lds + HL_TOT + (128 + k) * 4), t2 = *(const LAS float*)(lds + HL_TOT + (256 + k) * 4), t3 = *(const LAS float*)(lds + HL_TOT + (384 + k) * 4);
        const float off = (tq > 0 ? t0 : 0.f) + (tq > 1 ? t1 : 0.f) + (tq > 2 ? t2 : 0.f);
        const float bmid = t0 + t1, blast = (t0 + t1) + (t2 + t3);
        unsigned kdp[8];
        const float cA = __expf(bmid), cB = __expf(blast - bmid);
#pragma unroll
        for (int i = 0; i < 16; i += 2) {
            float kd2[2];
#pragma unroll
            for (int j = 0; j < 2; ++j) { const int ii = i + j; const float b = bc[ii] + off; const float q = bf2f(qv[ii]);
                const float qt = q * __expf(b - bmid), kt = kk[ii] * __expf(bmid - b), qe = qt * cA, kd = kt * cB;
                const unsigned short qeb = f2bf(qe);
                QE[e0 + (size_t)ii * 512] = qeb; kd2[j] = kd;
                const int t = tq * 16 + ii;
                *(LAS bf16_t*)(lds + HL_QE + t * 272 + k * 2) = qeb;
                *(LAS bf16_t*)(lds + HL_QT + t * 272 + k * 2) = f2bf(qt); *(LAS bf16_t*)(lds + HL_KT + t * 272 + k * 2) = f2bf(kt); }
            kdp[i >> 1] = pk2(kd2[0], kd2[1]);
        }
        { const u32x4 w0 = {kdp[0], kdp[1], kdp[2], kdp[3]}, w1 = {kdp[4], kdp[5], kdp[6], kdp[7]};
          *(LAS u32x4*)(lds + HL_KD + k * 144 + tq * 32) = w0; *(LAS u32x4*)(lds + HL_KD + k * 144 + tq * 32 + 16) = w1; }
        if (tq == 0) { *(LAS float*)(lds + HL_D + k * 4) = __expf(blast); LG[(size_t)(g * 4 + h) * 128 + k] = blast; }
        if (c + 1 < SEGC) HL_LOADQ(g + 1);
        __syncthreads();
        { const int mt = wave >> 1;
#pragma unroll
          for (int nn = 0; nn < 2; ++nn) { const int nt = 2 * (wave & 1) + nn; f32x4 a4 = {0.f, 0.f, 0.f, 0.f};
#pragma unroll
              for (int ks = 0; ks < 4; ++ks) { const bf16x8 a = *(const LAS bf16x8*)(lds + HL_QT + (16 * mt + fr) * 272 + (32 * ks + 8 * fq) * 2);
                  const bf16x8 b = *(const LAS bf16x8*)(lds + HL_KT + (16 * nt + fr) * 272 + (32 * ks + 8 * fq) * 2); a4 = MFMA16(a, b, a4); }
#pragma unroll
              for (int rg = 0; rg < 4; ++rg) { const int t = 16 * mt + 4 * fq + rg, s_ = 16 * nt + fr; const float v = (s_ <= t) ? a4[rg] : 0.f;
                  *(LAS bf16_t*)(lds + HL_AM + t * 144 + s_ * 2) = f2bf(v); } } }
        __syncthreads();
        const int trq = (lane & 15) >> 2, trp = lane & 3;
        bf16x8 vb0, vb1;
        { const u32x2 v0 = ldtr(lds + HL_VT + (8 * fq + trq) * 272 + (16 * wave + 4 * trp) * 2), v1 = ldtr(lds + HL_VT + (8 * fq + 4 + trq) * 272 + (16 * wave + 4 * trp) * 2);
          const u32x2 v2 = ldtr(lds + HL_VT + (32 + 8 * fq + trq) * 272 + (16 * wave + 4 * trp) * 2), v3 = ldtr(lds + HL_VT + (32 + 8 * fq + 4 + trq) * 272 + (16 * wave + 4 * trp) * 2);
          const u32x4 bw0 = {v0.x, v0.y, v1.x, v1.y}, bw1 = {v2.x, v2.y, v3.x, v3.y}; vb0 = __builtin_bit_cast(bf16x8, bw0); vb1 = __builtin_bit_cast(bf16x8, bw1); }
        bf16x8 sb[4];
#pragma unroll
        for (int ks = 0; ks < 4; ++ks) { u32x4 w; w.x = pk2(S[2 * ks][0], S[2 * ks][1]); w.y = pk2(S[2 * ks][2], S[2 * ks][3]); w.z = pk2(S[2 * ks + 1][0], S[2 * ks + 1][1]); w.w = pk2(S[2 * ks + 1][2], S[2 * ks + 1][3]);
            sb[ks] = __builtin_bit_cast(bf16x8, w); }
#pragma unroll
        for (int mt = 0; mt < 4; ++mt) {
            const bf16x8 am0 = *(const LAS bf16x8*)(lds + HL_AM + (16 * mt + fr) * 144 + (8 * fq) * 2), am1 = *(const LAS bf16x8*)(lds + HL_AM + (16 * mt + fr) * 144 + (32 + 8 * fq) * 2);
            u32x2 alo[4], ahi[4];
#pragma unroll
            for (int ks = 0; ks < 4; ++ks) { alo[ks] = *(const LAS u32x2*)(lds + HL_QE + (16 * mt + fr) * 272 + (32 * ks + 4 * fq) * 2); ahi[ks] = *(const LAS u32x2*)(lds + HL_QE + (16 * mt + fr) * 272 + (32 * ks + 16 + 4 * fq) * 2); }
            f32x4 o4 = {0.f, 0.f, 0.f, 0.f};
            o4 = MFMA16(am0, vb0, o4); o4 = MFMA16(am1, vb1, o4);
#pragma unroll
            for (int ks = 0; ks < 4; ++ks) { const u32x4 aw = {alo[ks].x, alo[ks].y, ahi[ks].x, ahi[ks].y}; o4 = MFMA16(__builtin_bit_cast(bf16x8, aw), sb[ks], o4); }
#pragma unroll
            for (int rg = 0; rg < 4; ++rg) HF[((size_t)g * 64 + 16 * mt + 4 * fq + rg) * 512 + h * 128 + 16 * wave + fr] = o4[rg];
        }
#pragma unroll
        for (int hf = 0; hf < 2; ++hf) { f32x4 d4[4]; bf16x8 a0[4], a1[4];
#pragma unroll
            for (int q = 0; q < 4; ++q) { const int kb = 4 * hf + q; d4[q] = *(const LAS f32x4*)(lds + HL_D + (16 * kb + 4 * fq) * 4);
                a0[q] = *(const LAS bf16x8*)(lds + HL_KD + (16 * kb + fr) * 144 + (8 * fq) * 2); a1[q] = *(const LAS bf16x8*)(lds + HL_KD + (16 * kb + fr) * 144 + (32 + 8 * fq) * 2); }
#pragma unroll
            for (int q = 0; q < 4; ++q) { const int kb = 4 * hf + q; S[kb] = S[kb] * d4[q]; S[kb] = MFMA16(a0[q], vb0, S[kb]); S[kb] = MFMA16(a1[q], vb1, S[kb]); } }
        __syncthreads();
    }
#pragma unroll
    for (int kb = 0; kb < 8; ++kb)
#pragma unroll
        for (int rg = 0; rg < 4; ++rg) Sout[(size_t)(16 * kb + 4 * fq + rg) * 128 + 16 * wave + fr] = S[kb][rg];
#undef HL_E0
#undef HL_LOADZ
#undef HL_LOADQ
#undef HL_LOADH
}

constexpr int AT_BUF = 9216 + 9216 + 256, AT_PFX = 2 * AT_BUF, AT_PUB = AT_PFX + 528, AT_RED = AT_PUB + 528;
constexpr float AT_THR = -160.f;
__device__ __forceinline__ int crow(int r, int hi) { return (r & 3) + 8 * (r >> 2) + 4 * hi; }
__device__ __forceinline__ void attn_tile(LAS unsigned char* lds, int bo, const bf16x8 (&qr)[4], f32x16& o0, f32x16& o1, float& mrun, float& lrun, int t, int qlo, int r32, int hi) {
    f32x16 p0, p1;
#pragma unroll
    for (int g = 0; g < 4; ++g) { const f32x4 x0 = *(const LAS f32x4*)(lds + bo + 18432 + (8 * g + 4 * hi) * 4), x1 = *(const LAS f32x4*)(lds + bo + 18432 + (32 + 8 * g + 4 * hi) * 4);
#pragma unroll
        for (int i = 0; i < 4; ++i) { p0[4 * g + i] = x0[i]; p1[4 * g + i] = x1[i]; } }
    { bf16x8 k0[4], k1[4];
#pragma unroll
      for (int d0 = 0; d0 < 4; ++d0) { k0[d0] = *(const LAS bf16x8*)(lds + bo + r32 * 144 + (16 * d0 + 8 * hi) * 2); k1[d0] = *(const LAS bf16x8*)(lds + bo + (32 + r32) * 144 + (16 * d0 + 8 * hi) * 2); }
      __builtin_amdgcn_sched_barrier(0);
#pragma unroll
      for (int d0 = 0; d0 < 4; ++d0) { p0 = MFMA32(k0[d0], qr[d0], p0); p1 = MFMA32(k1[d0], qr[d0], p1); } }
    if (64 * t + 63 > qlo) {
        const int qp = qlo + r32, kb = 64 * t + 4 * hi;
#pragma unroll
        for (int r = 0; r < 16; ++r) { const int kv = kb + (r & 3) + 8 * (r >> 2); if (kv > qp) p0[r] = -INFINITY; if (kv + 32 > qp) p1[r] = -INFINITY; }
    }
    float mx = fmaxf(p0[0], p1[0]);
#pragma unroll
    for (int r = 1; r < 16; ++r) mx = fmaxf(mx, fmaxf(p0[r], p1[r]));
    mx = fmaxf(mx, __shfl_xor(mx, 32));
    if (__any(mx > mrun)) {
        const float mnew = fmaxf(mrun, mx);
        const float alpha = __builtin_amdgcn_exp2f(mrun - mnew);
        mrun = mnew; lrun *= alpha;
#pragma unroll
        for (int r = 0; r < 16; ++r) { o0[r] *= alpha; o1[r] *= alpha; }
    }
    float rsum = 0.f;
#pragma unroll
    for (int r = 0; r < 16; ++r) { p0[r] = __builtin_amdgcn_exp2f(p0[r] - mrun); p1[r] = __builtin_amdgcn_exp2f(p1[r] - mrun); rsum += p0[r] + p1[r]; }
    lrun += rsum;
    const int trq = (r32 & 15) >> 2, trp = r32 & 3, blk = r32 >> 4;
    u32x2 va[4][2][2];
#pragma unroll
    for (int st = 0; st < 4; ++st) { const int kvb = 16 * st + 4 * hi;
#pragma unroll
        for (int d0 = 0; d0 < 2; ++d0) { va[st][d0][0] = ldtr(lds + bo + 9216 + (kvb + trq) * 144 + (32 * d0 + 16 * blk + 4 * trp) * 2); va[st][d0][1] = ldtr(lds + bo + 9216 + (kvb + 8 + trq) * 144 + (32 * d0 + 16 * blk + 4 * trp) * 2); } }
    __builtin_amdgcn_sched_barrier(0);
#pragma unroll
    for (int st = 0; st < 4; ++st) {
        u32x4 w;
        if (st < 2) { w.x = pk2(p0[8 * st], p0[8 * st + 1]); w.y = pk2(p0[8 * st + 2], p0[8 * st + 3]); w.z = pk2(p0[8 * st + 4], p0[8 * st + 5]); w.w = pk2(p0[8 * st + 6], p0[8 * st + 7]); }
        else { const int s2 = st - 2; w.x = pk2(p1[8 * s2], p1[8 * s2 + 1]); w.y = pk2(p1[8 * s2 + 2], p1[8 * s2 + 3]); w.z = pk2(p1[8 * s2 + 4], p1[8 * s2 + 5]); w.w = pk2(p1[8 * s2 + 6], p1[8 * s2 + 7]); }
        const bf16x8 pf = __builtin_bit_cast(bf16x8, w);
        { const u32x4 aw = {va[st][0][0].x, va[st][0][0].y, va[st][0][1].x, va[st][0][1].y}; o0 = MFMA32(__builtin_bit_cast(bf16x8, aw), pf, o0); }
        { const u32x4 aw = {va[st][1][0].x, va[st][1][0].y, va[st][1][1].x, va[st][1][1].y}; o1 = MFMA32(__builtin_bit_cast(bf16x8, aw), pf, o1); }
    }
}
__device__ __forceinline__ void attn_unit(LAS unsigned char* lds, const bf16_t* Qp, const bf16_t* Kp, const bf16_t* VTp, int vpitch, const float* CLp, const float* BTp, const float* CMp, const float* KNp,
                                          int NT, int nqw, int qpos0, int cref_tile, bf16_t* Yp, const float* Kc, const float* Vc, int ncache, int tid, int lane, int wave) {
    size_t zo = 0;
    asm volatile("" : "+v"(tid), "+v"(lane), "+s"(zo), "+s"(vpitch), "+s"(NT), "+s"(nqw), "+s"(qpos0), "+s"(cref_tile), "+s"(ncache));
    Qp += zo; Kp += zo; VTp += zo; CLp += zo; BTp += zo; CMp += zo; KNp += zo; Yp += zo; Kc += zo; Vc += zo;
    const int r32 = lane & 31, hi = lane >> 5;
    LAS float* Pfx = (LAS float*)(lds + AT_PFX); LAS float* PUB = (LAS float*)(lds + AT_PUB); LAS float* red = (LAS float*)(lds + AT_RED);
    const int srow = tid >> 3, sch = tid & 7;
    float bt_a = 0.f, bt_b = 0.f, kn_a = 0.f, kn_b = 0.f, cm_a = 0.f, cm_b = 0.f;
    if (wave == 0) {
        if (lane < NT) { bt_a = BTp[(size_t)lane * 8]; kn_a = KNp[(size_t)lane * 8]; cm_a = CMp[(size_t)lane * 8]; }
        if (lane + 64 < NT) { bt_b = BTp[(size_t)(lane + 64) * 8]; kn_b = KNp[(size_t)(lane + 64) * 8]; cm_b = CMp[(size_t)(lane + 64) * 8]; }
    }
    bf16x8 qr[4];
    const bool active = wave < nqw;
    if (active) {
#pragma unroll
        for (int d0 = 0; d0 < 4; ++d0) qr[d0] = *(const bf16x8*)(Qp + (size_t)(32 * wave + r32) * 512 + 16 * d0 + 8 * hi);
    } else {
#pragma unroll
        for (int d0 = 0; d0 < 4; ++d0) qr[d0] = (bf16x8){0, 0, 0, 0, 0, 0, 0, 0};
    }
    u32x4 pkA, pvA, pkB, pvB; float pbA = 0.f, pbB = 0.f;
#define AT_ISSUE(PK, PV, PB, t) { if ((t) < ncache) { const size_t co_ = ((size_t)(64 * (t) + srow)) * 512 + sch * 8;     \
            const f32x4 ka_ = *(const f32x4*)(Kc + co_), kc_ = *(const f32x4*)(Kc + co_ + 4), va_ = *(const f32x4*)(Vc + co_), vc_ = *(const f32x4*)(Vc + co_ + 4); \
            PK = (u32x4){pk2(ka_[0], ka_[1]), pk2(ka_[2], ka_[3]), pk2(kc_[0], kc_[1]), pk2(kc_[2], kc_[3])}; PV = (u32x4){pk2(va_[0], va_[1]), pk2(va_[2], va_[3]), pk2(vc_[0], vc_[1]), pk2(vc_[2], vc_[3])}; } \
        else { PK = *(const u32x4*)(Kp + ((size_t)(64 * (t) + srow)) * 512 + sch * 8); PV = *(const u32x4*)(VTp + ((size_t)(64 * (t) + srow)) * 512 + sch * 8); } \
        if (tid < 64) PB = CLp[(size_t)(64 * (t) + tid) * 8]; }
#define AT_COMMIT(PK, PV, PB, t, bo) { *(LAS u32x4*)(lds + (bo) + srow * 144 + sch * 16) = PK; *(LAS u32x4*)(lds + (bo) + 9216 + srow * 144 + sch * 16) = PV; \
        if (tid < 64) *(LAS float*)(lds + (bo) + 18432 + tid * 4) = (cref - Pfx[(t)] - PB) * LOG2E; }
    AT_ISSUE(pkB, pvB, pbB, NT - 1);
    if (NT >= 2) AT_ISSUE(pkA, pvA, pbA, NT - 2);
    u32x2 gte[4][2];
    { const bf16_t* yrow_ = Yp + (size_t)(32 * (active ? wave : 0) + r32) * 1024;
#pragma unroll
      for (int g = 0; g < 4; ++g) { gte[g][0] = *(const u32x2*)(yrow_ + 8 * g + 4 * hi); gte[g][1] = *(const u32x2*)(yrow_ + 32 + 8 * g + 4 * hi); } }
    float qn2 = 0.f;
#pragma unroll
    for (int d0 = 0; d0 < 4; ++d0) qn2 += sq8(__builtin_bit_cast(u32x4, qr[d0]));
    qn2 += __shfl_xor(qn2, 32);
#pragma unroll
    for (int o = 1; o < 32; o <<= 1) qn2 = fmaxf(qn2, __shfl_xor(qn2, o));
    if (lane == 0) red[wave] = qn2;
    __syncthreads();
    if (wave == 0) {
        float q2 = red[0];
#pragma unroll
        for (int w = 1; w < 8; ++w) q2 = fmaxf(q2, red[w]);
        const float Qmax = sqrtf(q2) * 1.002f;
        const float sa = wave_scan_incl(bt_a, lane), ta = __shfl(sa, 63), sb = wave_scan_incl(bt_b, lane);
        const float ea = sa - bt_a, eb = sb + ta - bt_b;
        Pfx[lane] = ea; Pfx[lane + 64] = eb;
        const float c0 = __shfl(ea, cref_tile & 63), c1 = __shfl(eb, cref_tile & 63);
        const float crf = (cref_tile < 64) ? c0 : c1;
        const float ua = (lane < NT) ? (kn_a * Qmax + (crf - ea - cm_a) * LOG2E) : -INFINITY;
        const float ub = (lane + 64 < NT) ? (kn_b * Qmax + (crf - eb - cm_b) * LOG2E) : -INFINITY;
        const float pa = wave_scan_max(ua, lane), tm = __shfl(pa, 63), pb = fmaxf(wave_scan_max(ub, lane), tm);
        PUB[lane] = pa; PUB[lane + 64] = pb;
    }
    __syncthreads();
    const float cref = Pfx[cref_tile];
    AT_COMMIT(pkB, pvB, pbB, NT - 1, 0);
    __syncthreads();
    float mrun = -INFINITY, lrun = 0.f, LB = 0.f;
    f32x16 o0, o1;
#pragma unroll
    for (int r = 0; r < 16; ++r) { o0[r] = 0.f; o1[r] = 0.f; }
    const int qlo = qpos0 + 32 * wave;
    int t = NT - 1, bo = 0;
#define AT_STEP(RCK, RCV, RCB, RNK, RNV, RNB) { \
        if (t < cref_tile && PUB[t] - LB < AT_THR) break;     \
        if (t >= 2) AT_ISSUE(RNK, RNV, RNB, t - 2); \
        if (active && 64 * t <= qlo + 31) attn_tile(lds, bo, qr, o0, o1, mrun, lrun, t, qlo, r32, hi); \
        if (t >= 1) AT_COMMIT(RCK, RCV, RCB, t - 1, AT_BUF - bo); \
        if (t == cref_tile) { const float mm = wave_min(active ? mrun : INFINITY); if (lane == 0) red[8 + wave] = mm; } \
        __syncthreads(); \
        if (t == cref_tile) { float m = red[8]; _Pragma("unroll") for (int w = 1; w < 8; ++w) m = fminf(m, red[8 + w]); LB = m; } \
        if (t == 0) break; \
        --t; bo = AT_BUF - bo; }
    for (;;) {
        AT_STEP(pkA, pvA, pbA, pkB, pvB, pbB)
        AT_STEP(pkB, pvB, pbB, pkA, pvA, pbA)
    }
    if (active) {
        const float lt = lrun + __shfl_xor(lrun, 32);
        const float inv = 1.0f / lt;
        bf16_t* yrow = Yp + (size_t)(32 * wave + r32) * 1024;
#pragma unroll
        for (int g = 0; g < 4; ++g) {
            { bf16_t* p = yrow + 8 * g + 4 * hi; const u32x2 gt = gte[g][0]; u32x2 w;
              w.x = pk2(o0[4 * g] * inv * bflo(gt.x), o0[4 * g + 1] * inv * bfhi(gt.x)); w.y = pk2(o0[4 * g + 2] * inv * bflo(gt.y), o0[4 * g + 3] * inv * bfhi(gt.y)); *(u32x2*)p = w; }
            { bf16_t* p = yrow + 32 + 8 * g + 4 * hi; const u32x2 gt = gte[g][1]; u32x2 w;
              w.x = pk2(o1[4 * g] * inv * bflo(gt.x), o1[4 * g + 1] * inv * bfhi(gt.x)); w.y = pk2(o1[4 * g + 2] * inv * bflo(gt.y), o1[4 * g + 3] * inv * bfhi(gt.y)); *(u32x2*)p = w; }
        }
    }
    __syncthreads();
#undef AT_ISSUE
#undef AT_COMMIT
#undef AT_STEP
}

__global__ void __launch_bounds__(512, 2) fwd_megakernel(Params P) {
    extern __shared__ __attribute__((aligned(16))) unsigned char lds_raw[];
    LAS unsigned char* lds = (LAS unsigned char*)lds_raw;
    cg::grid_group grid = cg::this_grid();
    const int tid = threadIdx.x, lane = tid & 63, wave = __builtin_amdgcn_readfirstlane(tid >> 6);
    unsigned char* ws = P.ws;
    volatile LAS int* slot = (volatile LAS int*)(lds + LDS_MISC);
    volatile LAS unsigned* bst = (volatile LAS unsigned*)(lds + LDS_MISC + 64);
    if (tid < 2) bst[tid] = 0u;
    if (blockIdx.x == 0) {
#pragma unroll
        for (int i = 0; i < 4; ++i) ((u32x4*)(ws + WS_CTL))[tid * 4 + i] = (u32x4){0u, 0u, 0u, 0u};
    }
    __syncthreads();

#ifndef NO_P0
    p0_prologue(P, lds, tid, lane, wave);
#endif
    grid.sync();
    const XcdBarrier xbar = xcd_barrier_post((unsigned*)(ws + WS_BAR), bst);
#define GSYNC() xcd_barrier(xbar)

#ifndef NREP_L
#define NREP_L 1
#endif
#ifndef NREP_P1
#define NREP_P1 1
#endif
    for (int li = 0; li < DEPTH * NREP_L; ++li) {
      const int layer = li / NREP_L;
      const bool lastrep = (li % NREP_L == NREP_L - 1);
      {
        for (int rep1 = 0; rep1 < NREP_P1; ++rep1) {
            pg8::Gemm g{(const bf16_t*)(ws + WS_XB), (const bf16_t*)(ws + WS_WTIN) + (size_t)layer * NPAD * 1024, MT, NPAD, 1024};
            pg8::StaticOrder S; S.init(MT, NPAD, (int)gridDim.x, (int)blockIdx.x);
            EpiIn E; E.ws = ws; E.out = P.out; E.bfv = P.in[8] + layer * 8; E.layer = layer; E.S = S; E.rsl = lds + LDS_MISC + 1024; E.ui = 0;
#ifndef NO_P1
            pg8::gemm_phase<EpiIn, pg8::StaticOrder, true, true>(lds, g, S, E);
#endif
        }
        GSYNC();
        fox_cumsum(P, lds, layer, tid, lane, wave);
#ifndef NO_PP
        for (int u = (MP / 64) * 4 + blockIdx.x; u < NG * 4; u += gridDim.x) hg_prepass_unit(P, lds, layer, u >> 2, u & 3, tid, lane, wave);
#endif
        unsigned* sdone = (unsigned*)(ws + WS_CTL) + 16 + li;
        asm volatile("s_waitcnt vmcnt(0)" ::: "memory");
        __syncthreads();
        if (tid == 0) { __builtin_amdgcn_fence(__ATOMIC_RELEASE, "agent"); asm volatile("s_waitcnt vmcnt(0)" ::: "memory"); __hip_atomic_fetch_add(sdone, 1u, __ATOMIC_RELAXED, __HIP_MEMORY_SCOPE_AGENT); }
        bool stats_ready = false;
#ifndef PROBE_CUT
#define PROBE_CUT 9
#endif
        if (lastrep || PROBE_CUT >= 2) {
            unsigned* cnt = (unsigned*)(ws + WS_CTL) + li;
            constexpr int T_HP = 32 * NSEG, T_AP = T_HP + 2048, T_AS = T_AP + 128, T_HSM = T_AS + 64, T_SO = T_HSM + 16, T_FX = T_SO + 32 * NSEG;
            unsigned* segdone = (unsigned*)(ws + WS_CTL) + 32 + 32 * li;
            for (;;) {
                if (tid == 0) *slot = (int)atomicAdd(cnt, 1u);
                __syncthreads();
                const int pt = *slot;
                __syncthreads();
                if (pt >= T_FX) break;
                int tk;
                { constexpr int A1 = 1408, P1_ = T_HP + A1, P2_ = P1_ + 32 * NSEG, P3_ = P2_ + 128, P4_ = P3_ + 64, P5_ = P4_ + 16;
                  if (pt < P1_) tk = pt;
                  else if (pt < P2_) tk = T_SO + (pt - P1_);
                  else if (pt < P3_) tk = T_AP + (pt - P2_);
                  else if (pt < P4_) tk = T_AS + (pt - P3_);
                  else if (pt < P5_) tk = T_HSM + (pt - P4_);
                  else tk = T_HP + A1 + (pt - P5_); }
                if (tk >= T_HP && !stats_ready) {
                    if (tid == 0) {
                        for (unsigned spin = 0; spin < (1u << 20); ++spin) { if (__hip_atomic_load(sdone, __ATOMIC_RELAXED, __HIP_MEMORY_SCOPE_AGENT) >= gridDim.x) break; __builtin_amdgcn_s_sleep(4); }
                        __builtin_amdgcn_fence(__ATOMIC_ACQUIRE, "agent"); asm volatile("s_waitcnt vmcnt(0)" ::: "memory"); }
                    __syncthreads();
                    stats_ready = true;
                }
                unsigned* sampdone = (unsigned*)(ws + WS_CTL) + 96 + 4 * li;
                if (tk >= T_HSM && tk < T_SO) {
                    const int j = (tk - T_HSM) >> 2, pn = (tk - T_HSM) & 3;
                    if (tid == 0) {
                        for (unsigned spin = 0; spin < (1u << 20); ++spin) { if (__hip_atomic_load(sampdone + j, __ATOMIC_RELAXED, __HIP_MEMORY_SCOPE_AGENT) >= 48u) break; __builtin_amdgcn_s_sleep(4); }
                        __builtin_amdgcn_fence(__ATOMIC_ACQUIRE, "agent"); asm volatile("s_waitcnt vmcnt(0)" ::: "memory"); }
                    __syncthreads();
                    pg8::Gemm g1{(const bf16_t*)(ws + WS_YC), (const bf16_t*)(ws + WS_WTOUT) + (size_t)layer * 1024 * 1024, MT, 1024, 1024};
                    OneUnit S1; S1.pm = MP / 256 + j; S1.pn = pn;
                    EpiOut E1; E1.XB = (bf16_t*)(ws + WS_XB); E1.SS = (float*)(ws + WS_SS);
                    pg8::gemm_phase<EpiOut, OneUnit, true, true>(lds, g1, S1, E1);
                    __syncthreads();
                    continue;
                }
                if (tk < T_HP || tk >= T_AS) {
                    int g0, nch, h, mode, seg = 0; const float* S0; float* So;
                    if (tk < T_HP) { const int bh = tk >> 3, b = bh >> 2; seg = tk & 7; h = bh & 3; g0 = b * 128 + seg * SEGC; nch = SEGC; S0 = P.in[5]; mode = 1; So = (float*)(ws + WS_LB) + ((size_t)bh * NSEG + seg) * 16384; }
                    else if (tk < T_HSM) { const int bh = tk - T_AS, b = bh >> 2; h = bh & 3; g0 = 1024 + b; nch = 1; mode = 0; S0 = P.in[5] + ((size_t)(layer * DBAT + b) * 4 + h) * 16384; So = P.out + OFF_HS + ((size_t)(layer * DBAT + b) * 4 + h) * 16384; }
                    else { const int idx = tk - T_SO, bh = idx & 31, b = bh >> 2; seg = NSEG - 1 - (idx >> 5); h = bh & 3; g0 = b * 128 + seg * SEGC; nch = SEGC; mode = 2; S0 = P.in[5]; So = P.out + OFF_HP + ((size_t)(layer * NBAT + b) * 4 + h) * 16384;
                        if (tid == 0) {
                            for (unsigned spin = 0; spin < (1u << 20); ++spin) { if (__hip_atomic_load(segdone + bh, __ATOMIC_RELAXED, __HIP_MEMORY_SCOPE_AGENT) >= (unsigned)NSEG) break; __builtin_amdgcn_s_sleep(4); }
                            __builtin_amdgcn_fence(__ATOMIC_ACQUIRE, "agent"); asm volatile("s_waitcnt vmcnt(0)" ::: "memory"); }
                        __syncthreads(); }
#ifndef NO_HS
                    if (mode == 1) {
                        hg_local_unit(P, lds, layer, g0, h, So, tid, lane, wave);
                        asm volatile("s_waitcnt vmcnt(0)" ::: "memory");
                        __syncthreads();
                        if (tid == 0) { __builtin_amdgcn_fence(__ATOMIC_RELEASE, "agent"); asm volatile("s_waitcnt vmcnt(0)" ::: "memory"); __hip_atomic_fetch_add(segdone + (tk >> 3), 1u, __ATOMIC_RELAXED, __HIP_MEMORY_SCOPE_AGENT); }
                    } else { hg_seq_unit(P, lds, layer, g0, nch, h, S0, So, mode, seg, (const float*)(ws + WS_LB) + (size_t)(mode == 2 ? (tk - T_SO) & 31 : 0) * NSEG * 16384, tid, lane, wave);
                        if (mode == 0) {
                            asm volatile("s_waitcnt vmcnt(0)" ::: "memory");
                            __syncthreads();
                            if (tid == 0) { __builtin_amdgcn_fence(__ATOMIC_RELEASE, "agent"); asm volatile("s_waitcnt vmcnt(0)" ::: "memory"); __hip_atomic_fetch_add(sampdone + ((tk - T_AS) >> 4), 1u, __ATOMIC_RELAXED, __HIP_MEMORY_SCOPE_AGENT); }
                        } }
#endif
                } else {
                    const bf16_t *Qp, *Kp, *VTp; const float *CLp, *BTp, *CMp, *KNp, *Kc = P.in[2], *Vc = P.in[3]; bf16_t* Yp; int vpitch, NT, nqw, qpos0, creft, ncache = 0;
                    if (tk < T_AP) {
                        const int idx = tk - T_HP, qb = 31 - (idx >> 6), bh = idx & 63, b = bh >> 3, h = bh & 7;
                        Qp = (const bf16_t*)(ws + WS_QB) + ((size_t)b * SEQ + qb * 256) * 512 + h * 64; Kp = (const bf16_t*)(ws + WS_KBP) + (size_t)b * SEQ * 512 + h * 64;
                        VTp = (const bf16_t*)(ws + WS_VTP) + (size_t)b * SEQ * 512 + h * 64; vpitch = 512; CLp = (const float*)(ws + WS_CL) + ((size_t)layer * KROWS + (size_t)b * SEQ) * 8 + h;
                        BTp = (const float*)(ws + WS_BT) + ((size_t)layer * NKT + b * 128) * 8 + h; CMp = (const float*)(ws + WS_CM) + ((size_t)layer * NKT + b * 128) * 8 + h; KNp = (const float*)(ws + WS_KN) + ((size_t)layer * NKT + b * 128) * 8 + h; NT = 4 * (qb + 1); nqw = 8; qpos0 = qb * 256; creft = qb * 4;
                        Yp = (bf16_t*)(ws + WS_YC) + ((size_t)b * SEQ + qb * 256) * 1024 + h * 64;
                    } else {
                        const int bh = tk - T_AP, b = bh >> 3, h = bh & 7;
                        Qp = (const bf16_t*)(ws + WS_QB) + ((size_t)MP + b * 64) * 512 + h * 64; Kp = (const bf16_t*)(ws + WS_KBS) + ((size_t)layer * KSROWS + (size_t)b * SKV) * 512 + h * 64;
                        VTp = (const bf16_t*)(ws + WS_VTS) + ((size_t)layer * KSROWS + (size_t)b * SKV) * 512 + h * 64; vpitch = 512; CLp = (const float*)(ws + WS_CL) + ((size_t)layer * KROWS + MP + (size_t)b * SKV) * 8 + h;
                        BTp = (const float*)(ws + WS_BT) + ((size_t)layer * NKT + 1024 + b * 33) * 8 + h; CMp = (const float*)(ws + WS_CM) + ((size_t)layer * NKT + 1024 + b * 33) * 8 + h; KNp = (const float*)(ws + WS_KN) + ((size_t)layer * NKT + 1024 + b * 33) * 8 + h; NT = 33; nqw = 2; qpos0 = PAST; creft = 32; ncache = 32; Kc = P.in[2] + ((size_t)(layer * DBAT + b) * PAST) * 512 + h * 64; Vc = P.in[3] + ((size_t)(layer * DBAT + b) * PAST) * 512 + h * 64;
                        Yp = (bf16_t*)(ws + WS_YC) + ((size_t)MP + b * 64) * 1024 + h * 64;
                    }
#ifndef NO_AT
                    attn_unit(lds, Qp, Kp, VTp, vpitch, CLp, BTp, CMp, KNp, NT, nqw, qpos0, creft, Yp, Kc, Vc, ncache, tid, lane, wave);
                    if (tk >= T_AP) {
                        asm volatile("s_waitcnt vmcnt(0)" ::: "memory");
                        __syncthreads();
                        if (tid == 0) { __builtin_amdgcn_fence(__ATOMIC_RELEASE, "agent"); asm volatile("s_waitcnt vmcnt(0)" ::: "memory"); __hip_atomic_fetch_add(sampdone + ((tk - T_AP) >> 5), 1u, __ATOMIC_RELAXED, __HIP_MEMORY_SCOPE_AGENT); }
                    }
#endif
                }
            }
        }
        if (lastrep || PROBE_CUT >= 3) GSYNC();
      }
        if (li % NREP_L == NREP_L - 1) {
            pg8::Gemm g{(const bf16_t*)(ws + WS_YC), (const bf16_t*)(ws + WS_WTOUT) + (size_t)layer * 1024 * 1024, MP, 1024, 1024};
            pg8::StaticOrder S; S.init(MP, 1024, (int)gridDim.x, (int)blockIdx.x);
            EpiOut E; E.XB = (bf16_t*)(ws + WS_XB); E.SS = (float*)(ws + WS_SS);
#ifndef NO_P3
            pg8::gemm_phase<EpiOut, pg8::StaticOrder, true, true>(lds, g, S, E);
#endif
        }
        if (lastrep) GSYNC();
    }
    {
        const float* SS = (const float*)(ws + WS_SS); const float* fg = P.in[12]; float* y = P.out + OFF_Y; const bf16_t* XB = (const bf16_t*)(ws + WS_XB);
        const int gw = blockIdx.x * 8 + wave, NGW = gridDim.x * 8;
        f32x4 g4[4];
#pragma unroll
        for (int j = 0; j < 4; ++j) g4[j] = ((const f32x4*)fg)[4 * lane + j];
        for (int r0 = gw; r0 < MT; r0 += 4 * NGW) {
            float sv[4]; u32x4 v[4][2];
#pragma unroll
            for (int q = 0; q < 4; ++q) { const int r = min(r0 + q * NGW, MT - 1); sv[q] = (lane < 16) ? SS[(size_t)r * 16 + lane] : 0.f;
                v[q][0] = ((const u32x4*)(XB + (size_t)r * 1024))[2 * lane]; v[q][1] = ((const u32x4*)(XB + (size_t)r * 1024))[2 * lane + 1]; }
#pragma unroll
            for (int q = 0; q < 4; ++q) { const int r = r0 + q * NGW; const float rinv = rsqrtf(wave_sum(sv[q]) * (1.0f / 1024.0f) + EPS);
                if (r < MT) {
#pragma unroll
                    for (int j = 0; j < 4; ++j) { const unsigned w0 = v[q][j >> 1][(j & 1) * 2], w1 = v[q][j >> 1][(j & 1) * 2 + 1];
                        f32x4 o; o[0] = bflo(w0) * rinv * g4[j][0]; o[1] = bfhi(w0) * rinv * g4[j][1]; o[2] = bflo(w1) * rinv * g4[j][2]; o[3] = bfhi(w1) * rinv * g4[j][3];
                        ((f32x4*)(y + (size_t)r * 1024))[4 * lane + j] = o; } } }
        }
    }
}

extern "C" void kernel_launch(void* const* d_in, const int* in_sizes, int n_in, void* d_out, int out_size, void* d_ws, size_t ws_size, hipStream_t stream) {
    static int grid = 0;
    if (grid == 0) {
        if (n_in != 13 || (size_t)out_size != OUT_TOTAL || ws_size < WS_END) { fprintf(stderr, "kernel_launch: unexpected sizes n_in=%d out=%d ws=%zu (need %zu)\n", n_in, out_size, ws_size, (size_t)WS_END); grid = -1; return; }
        int dev = 0, cus = 0, per_cu = 0;
        hipGetDevice(&dev); hipDeviceGetAttribute(&cus, hipDeviceAttributeMultiprocessorCount, dev);
        if (hipFuncSetAttribute((const void*)fwd_megakernel, hipFuncAttributeMaxDynamicSharedMemorySize, LDS_BYTES) != hipSuccess) { fprintf(stderr, "kernel_launch: hipFuncSetAttribute failed\n"); grid = -1; return; }
        if (hipOccupancyMaxActiveBlocksPerMultiprocessor(&per_cu, (const void*)fwd_megakernel, 512, LDS_BYTES) != hipSuccess || per_cu < 1) { fprintf(stderr, "kernel_launch: occupancy query says %d\n", per_cu); per_cu = 1; }
        (void)hipGetLastError();
        grid = cus;
    }
    if (grid < 0) return;
    Params p{};
    for (int i = 0; i < 13; ++i) p.in[i] = (const float*)d_in[i];
    p.out = (float*)d_out; p.ws = (unsigned char*)d_ws;
    void* args[] = {&p};
    hipError_t e = hipLaunchCooperativeKernel((const void*)fwd_megakernel, dim3(grid), dim3(512), args, LDS_BYTES, stream);
    if (e != hipSuccess) fprintf(stderr, "cooperative launch failed: %s (grid %d)\n", hipGetErrorString(e), grid);
}
```

```cpp
#include <hip/hip_runtime.h>
#include <hip/hip_cooperative_groups.h>
#include <cstdio>
#include <cstdint>
namespace cg = cooperative_groups;
namespace pg8 {
#define PG8_LAS __attribute__((address_space(3)))
typedef unsigned short bf16_t;
typedef short bf16x8 __attribute__((ext_vector_type(8)));
typedef float f32x4 __attribute__((ext_vector_type(4)));
typedef unsigned u32x4 __attribute__((ext_vector_type(4)));
constexpr int BM = 256, BK = 64, HALF = 128, HTB = HALF * BK * 2  , STAGE_BYTES = 8 * HTB, NXCD = 8, WGM = 8;

__host__ __device__ __forceinline__ int lds_byte(int r, int c) { const int st = (r >> 4) * 2 + (c >> 5), rr = r & 15, cc = c & 31, ob = rr * 64 + cc * 2; return st * 1024 + (ob ^ (((ob >> 9) & 1) << 5)); }
__host__ __device__ __forceinline__ void stage_rc(int b, int& R, int& C) { const int st = b / 1024, sb = b % 1024, swz = sb ^ (((sb >> 9) & 1) << 5); R = (st >> 1) * 16 + swz / 64; C = (st & 1) * 32 + (swz % 64) / 2; }
__host__ __device__ __forceinline__ int perm32(int rho) { const int n = rho >> 4, i = rho & 15; return 8 * (i >> 2) + 4 * n + (i & 3); }

struct Unit { int pm, pn; };
struct Gemm { const bf16_t* A; const bf16_t* Bt; int M, N, K; };

struct StaticOrder {
    int nM, nN, nwg, G, c;
    __host__ __device__ void init(int M, int N, int G_, int c_) { nM = M / BM; nN = N / BM; nwg = nM * nN; G = G_; c = c_; }
    __host__ __device__ bool next(int i, Unit& u) const {
        const long L = (long)i * G + c; if (L >= nwg) return false;
        int wgid = (int)L; { const int q = nwg / NXCD, r = nwg % NXCD, xcd = wgid % NXCD, off = wgid / NXCD; wgid = (xcd < r ? xcd * (q + 1) : r * (q + 1) + (xcd - r) * q) + off; }
        const int nig = WGM * nN, gid = wgid / nig, fm = gid * WGM, gsz = (nM - fm) < WGM ? (nM - fm) : WGM;
        u.pm = fm + ((wgid % nig) % gsz); u.pn = (wgid % nig) / gsz; return true;
    }
    __device__ __forceinline__ void a_ready(const Unit&) const {}
    __device__ __forceinline__ void done(const Unit&) const {}
};

template <class Epi, class Sched, bool ALIGN_EPI = false, bool SP2 = false>
__device__ __forceinline__ void gemm_phase(PG8_LAS unsigned char* lds, const Gemm g, const Sched& S, const Epi& E) {
    int tid_ = threadIdx.x; asm volatile("" : "+v"(tid_));
    const int tid = tid_, wid = __builtin_amdgcn_readfirstlane(tid >> 6), lane = tid & 63, wr = wid >> 2, wc = wid & 3, fr = lane & 15, fq = lane >> 4;
    const int K = g.K, nt = K / BK;
    unsigned voffA[2], voffB[2];
#pragma unroll
    for (int i = 0; i < 2; ++i) { int R, C; stage_rc(tid * 16 + i * 8192, R, C); const int Rb = Epi::PERM ? ((R & ~31) + perm32(R & 31)) : R;
        voffA[i] = (unsigned)(R * K + C) * 2u; voffB[i] = (unsigned)(Rb * K + C) * 2u; }
    const size_t kstep = (size_t)(BK * 2);
    const size_t hstep = (size_t)HALF * K * 2;
    const size_t tstep = 2 * hstep;
    const unsigned ldsw = (unsigned)wid * 1024u;
    const int aoff = lds_byte(wr * 64 + fr, fq * 8), boff = lds_byte(wc * 32 + fr, fq * 8);
#define PG8_SA(b, h) (((b) * 2 + (h)) * HTB)
#define PG8_SB(b, h) ((4 + (b) * 2 + (h)) * HTB)
#define PG8_STAGE(bufoff, gbase, voff) do { _Pragma("unroll") for (int _i = 0; _i < 2; ++_i) \
        __builtin_amdgcn_global_load_lds((const unsigned*)((const char*)(gbase) + (voff)[_i]), (PG8_LAS unsigned*)(lds + (bufoff) + ldsw + _i * 8192), 16, 0, 0); } while (0)
#define PG8_LDA(dst, b, h) do { _Pragma("unroll") for (int m = 0; m < 4; ++m) _Pragma("unroll") for (int k = 0; k < 2; ++k) dst[m][k] = *(const PG8_LAS bf16x8*)(lds + PG8_SA(b, h) + aoff + m * 2048 + k * 1024); } while (0)
#define PG8_LDB(dst, b, h) do { _Pragma("unroll") for (int n = 0; n < 2; ++n) _Pragma("unroll") for (int k = 0; k < 2; ++k) dst[n][k] = *(const PG8_LAS bf16x8*)(lds + PG8_SB(b, h) + boff + n * 2048 + k * 1024); } while (0)
#define PG8_MMA(ai, bj, At, Bt) do { __builtin_amdgcn_s_setprio(1); _Pragma("unroll") for (int m = 0; m < 4; ++m) _Pragma("unroll") for (int n = 0; n < 2; ++n) _Pragma("unroll") for (int k = 0; k < 2; ++k) \
        acc[ai][bj][m][n] = __builtin_amdgcn_mfma_f32_16x16x32_bf16(Bt[n][k], At[m][k], acc[ai][bj][m][n], 0, 0, 0); __builtin_amdgcn_s_setprio(0); } while (0)
#define PG8_WAIT_V(n) asm volatile("s_waitcnt vmcnt(" #n ")" ::: "memory")
#define PG8_WAIT_L(n) asm volatile("s_waitcnt lgkmcnt(" #n ")" ::: "memory")
#define PG8_BAR __builtin_amdgcn_s_barrier()
#define PG8_SCHED __builtin_amdgcn_sched_barrier(0)
    Unit cur, nxt; int ui = 0;
    if (!S.next(0, cur)) return;
    f32x4 acc[2][2][4][2];
#pragma unroll
    for (int a = 0; a < 2; ++a)
#pragma unroll
        for (int b = 0; b < 2; ++b)
#pragma unroll
            for (int m = 0; m < 4; ++m)
#pragma unroll
                for (int n = 0; n < 2; ++n) acc[a][b][m][n] = (f32x4){0.f, 0.f, 0.f, 0.f};
    bf16x8 At[4][2], B0[2][2], B1[2][2];
    const char* cA = (const char*)g.A + (size_t)cur.pm * tstep; const char* cB = (const char*)g.Bt + (size_t)cur.pn * tstep;
    S.a_ready(cur);
    if constexpr (SP2) {
        PG8_STAGE(PG8_SB(0, 0), cB, voffB); PG8_STAGE(PG8_SB(0, 1), cB + hstep, voffB); PG8_STAGE(PG8_SA(0, 0), cA, voffA); PG8_STAGE(PG8_SA(0, 1), cA + hstep, voffA);
        if (wr == 1) PG8_BAR;
        PG8_WAIT_V(2); PG8_BAR;
        PG8_STAGE(PG8_SB(1, 0), cB + kstep, voffB); PG8_STAGE(PG8_SA(1, 0), cA + kstep, voffA); PG8_STAGE(PG8_SB(1, 1), cB + hstep + kstep, voffB);
        PG8_WAIT_V(6); PG8_BAR;
    } else {
        PG8_STAGE(PG8_SB(0, 0), cB, voffB); PG8_STAGE(PG8_SA(0, 0), cA, voffA); PG8_STAGE(PG8_SB(0, 1), cB + hstep, voffB); PG8_STAGE(PG8_SA(0, 1), cA + hstep, voffA);
        if (wr == 1) PG8_BAR;
        PG8_WAIT_V(4); PG8_BAR;
        PG8_STAGE(PG8_SB(1, 0), cB + kstep, voffB); PG8_STAGE(PG8_SA(1, 0), cA + kstep, voffA); PG8_STAGE(PG8_SB(1, 1), cB + hstep + kstep, voffB);
        PG8_WAIT_V(6); PG8_BAR;
    }
    for (;;) {
        const bool has_next = S.next(ui + 1, nxt);
        const char* nA = has_next ? (const char*)g.A + (size_t)nxt.pm * tstep : cA; const char* nB = has_next ? (const char*)g.Bt + (size_t)nxt.pn * tstep : cB;
        for (int t = 0; t < nt; t += 2) {
            const bool last = (t == nt - 2);
            const char* a1 = cA + (size_t)(t + 1) * kstep;
            const char* a2 = last ? nA : cA + (size_t)(t + 2) * kstep; const char* b2 = last ? nB : cB + (size_t)(t + 2) * kstep;
            const char* a3 = a2 + kstep; const char* b3 = b2 + kstep;
            if (last && has_next) S.a_ready(nxt);
            if constexpr (SP2) {
            PG8_LDB(B0, 0, 0); PG8_LDB(B1, 0, 1); PG8_SCHED; PG8_LDA(At, 0, 0); PG8_STAGE(PG8_SA(1, 1), a1 + hstep, voffA);
            PG8_WAIT_V(8); PG8_WAIT_L(0); PG8_BAR; PG8_MMA(0, 0, At, B0); PG8_MMA(0, 1, At, B1); PG8_BAR; PG8_SCHED;
            PG8_LDA(At, 0, 1); PG8_STAGE(PG8_SB(0, 0), b2, voffB); PG8_STAGE(PG8_SB(0, 1), b2 + hstep, voffB); PG8_STAGE(PG8_SA(0, 0), a2, voffA);
            PG8_WAIT_V(8); PG8_WAIT_L(0); PG8_BAR; PG8_MMA(1, 0, At, B0); PG8_MMA(1, 1, At, B1); PG8_BAR; PG8_SCHED;
            PG8_LDB(B0, 1, 0); PG8_LDB(B1, 1, 1); PG8_SCHED; PG8_LDA(At, 1, 0); PG8_STAGE(PG8_SA(0, 1), a2 + hstep, voffA);
            PG8_WAIT_V(8); PG8_WAIT_L(0); PG8_BAR; PG8_MMA(0, 0, At, B0); PG8_MMA(0, 1, At, B1); PG8_BAR; PG8_SCHED;
            PG8_LDA(At, 1, 1); PG8_STAGE(PG8_SB(1, 0), b3, voffB); PG8_STAGE(PG8_SB(1, 1), b3 + hstep, voffB); PG8_STAGE(PG8_SA(1, 0), a3, voffA);
            PG8_WAIT_V(8); PG8_WAIT_L(0); PG8_BAR; PG8_MMA(1, 0, At, B0); PG8_MMA(1, 1, At, B1); PG8_BAR; PG8_SCHED;
            } else {
            PG8_LDB(B0, 0, 0); PG8_SCHED; PG8_LDA(At, 0, 0); PG8_STAGE(PG8_SA(1, 1), a1 + hstep, voffA);
            PG8_WAIT_L(8); PG8_BAR; PG8_WAIT_L(0); PG8_MMA(0, 0, At, B0); PG8_BAR; PG8_SCHED;
            PG8_LDB(B1, 0, 1); PG8_STAGE(PG8_SB(0, 0), b2, voffB);
            PG8_BAR; PG8_WAIT_L(0); PG8_MMA(0, 1, At, B1); PG8_BAR;
            PG8_LDA(At, 0, 1); PG8_STAGE(PG8_SA(0, 0), a2, voffA);
            PG8_BAR; PG8_WAIT_L(0); PG8_MMA(1, 0, At, B0); PG8_BAR; PG8_SCHED;
            PG8_STAGE(PG8_SB(0, 1), b2 + hstep, voffB);
            PG8_WAIT_V(6); PG8_BAR; PG8_MMA(1, 1, At, B1); PG8_BAR;
            PG8_LDB(B0, 1, 0); PG8_SCHED; PG8_LDA(At, 1, 0); PG8_STAGE(PG8_SA(0, 1), a2 + hstep, voffA);
            PG8_WAIT_L(8); PG8_BAR; PG8_WAIT_L(0); PG8_MMA(0, 0, At, B0); PG8_BAR; PG8_SCHED;
            PG8_LDB(B1, 1, 1); PG8_STAGE(PG8_SB(1, 0), b3, voffB);
            PG8_BAR; PG8_WAIT_L(0); PG8_MMA(0, 1, At, B1); PG8_BAR;
            PG8_LDA(At, 1, 1); PG8_STAGE(PG8_SA(1, 0), a3, voffA);
            PG8_BAR; PG8_WAIT_L(0); PG8_MMA(1, 0, At, B0); PG8_BAR; PG8_SCHED;
            PG8_STAGE(PG8_SB(1, 1), b3 + hstep, voffB);
            PG8_WAIT_V(6); PG8_BAR; PG8_MMA(1, 1, At, B1); PG8_BAR;
            }
        }
        if constexpr (ALIGN_EPI) { if (wr == 0) PG8_BAR; }
        if constexpr (!Epi::AFTER_DRAIN) { E(acc, cur, wr, wc, fr, fq); S.done(cur); }
        if (!has_next) break;
#pragma unroll
        for (int a = 0; a < 2; ++a)
#pragma unroll
            for (int b = 0; b < 2; ++b)
#pragma unroll
                for (int m = 0; m < 4; ++m)
#pragma unroll
                    for (int n = 0; n < 2; ++n) acc[a][b][m][n] = (f32x4){0.f, 0.f, 0.f, 0.f};
        cur = nxt; cA = nA; cB = nB; ++ui;
        if constexpr (ALIGN_EPI) { if (wr == 1) PG8_BAR; }
    }
    PG8_WAIT_V(0);
    if constexpr (!ALIGN_EPI) { if (wr == 0) PG8_BAR; }
    PG8_BAR;
    if constexpr (Epi::AFTER_DRAIN) { E.fused(acc, cur, wr, wc, fr, fq, lds, wid, lane); S.done(cur); }
#undef PG8_SA
#undef PG8_SB
#undef PG8_STAGE
#undef PG8_LDA
#undef PG8_LDB
#undef PG8_MMA
#undef PG8_WAIT_V
#undef PG8_WAIT_L
#undef PG8_BAR
#undef PG8_SCHED
}
}

#define LAS __attribute__((address_space(3)))
typedef unsigned short bf16_t;
typedef short bf16x8 __attribute__((ext_vector_type(8)));
typedef float f32x4 __attribute__((ext_vector_type(4)));
typedef float f32x16 __attribute__((ext_vector_type(16)));
typedef unsigned u32x4 __attribute__((ext_vector_type(4)));
typedef unsigned u32x2 __attribute__((ext_vector_type(2)));

constexpr int DMODEL = 1024, SEQ = 8192, NBAT = 8, DEPTH = 2, DBAT = 16, DSEQ = 64, PAST = 2048;
constexpr int MP = NBAT * SEQ;
constexpr int MS = DBAT * DSEQ;
constexpr int MT = MP + MS;
constexpr int DIN = 4104, NPAD = 4352;
constexpr int SKV = PAST + DSEQ;
constexpr int KSROWS = DBAT * SKV;
constexpr int KROWS = MP + KSROWS;
constexpr int NG = MT / 64;
constexpr int NKT = KROWS / 64;
constexpr float EPS = 1e-6f;
constexpr float LOG2E = 1.4426950408889634f;
constexpr float QSCALE = 0.125f * LOG2E;

constexpr size_t OFF_Y = 0;
constexpr size_t OFF_KP = (size_t)MT * 1024;
constexpr size_t OFF_VP = OFF_KP + (size_t)DEPTH * MP * 512;
constexpr size_t OFF_LP = OFF_VP + (size_t)DEPTH * MP * 512;
constexpr size_t OFF_HP = OFF_LP + (size_t)DEPTH * MP * 8;
constexpr size_t OFF_KS = OFF_HP + (size_t)DEPTH * NBAT * 4 * 16384;
constexpr size_t OFF_VS = OFF_KS + (size_t)DEPTH * MS * 512;
constexpr size_t OFF_LS = OFF_VS + (size_t)DEPTH * MS * 512;
constexpr size_t OFF_HS = OFF_LS + (size_t)DEPTH * MS * 8;
constexpr size_t OUT_TOTAL = OFF_HS + (size_t)DEPTH * DBAT * 4 * 16384;

constexpr size_t al256(size_t x) { return (x + 255) & ~(size_t)255; }
constexpr size_t WS_CTL = 0;
constexpr size_t WS_BAR = 8192;
constexpr size_t WS_WTIN = 32768;
constexpr size_t WS_WTOUT = WS_WTIN + al256((size_t)DEPTH * NPAD * 1024 * 2);
constexpr size_t WS_XB = WS_WTOUT + al256((size_t)DEPTH * 1024 * 1024 * 2);
constexpr size_t WS_YC = WS_XB + al256((size_t)MT * 1024 * 2);
constexpr size_t WS_QB = WS_YC + al256((size_t)MT * 1024 * 2);
constexpr size_t WS_KBP = WS_QB + al256((size_t)MT * 512 * 2);
constexpr size_t WS_KBS = WS_KBP + al256((size_t)MP * 512 * 2);
constexpr size_t WS_VTP = WS_KBS + al256((size_t)DEPTH * KSROWS * 512 * 2);
constexpr size_t WS_VTS = WS_VTP + al256((size_t)MP * 512 * 2);
constexpr size_t WS_QE = WS_VTS + al256((size_t)DEPTH * KSROWS * 512 * 2);
constexpr size_t WS_HF = WS_QE + al256((size_t)MT * 512 * 2);
constexpr size_t WS_KDT = WS_HF + al256((size_t)MT * 512 * 4);
constexpr size_t WS_VTH = WS_KDT + al256((size_t)NG * 4 * 8192 * 2);
constexpr size_t WS_DG = WS_VTH + al256((size_t)NG * 4 * 8192 * 2);
constexpr size_t WS_CL = WS_DG + al256((size_t)NG * 4 * 128 * 4);
constexpr size_t WS_BT = WS_CL + al256((size_t)DEPTH * KROWS * 8 * 4);
constexpr size_t WS_SS = WS_BT + al256((size_t)DEPTH * NKT * 8 * 4);
constexpr size_t WS_CM = WS_SS + al256((size_t)16 * MT * 4);
constexpr size_t WS_KN = WS_CM + al256((size_t)DEPTH * NKT * 8 * 4);
constexpr size_t WS_LG = WS_KN + al256((size_t)DEPTH * NKT * 8 * 4);
constexpr size_t WS_LB = WS_LG + al256((size_t)NG * 4 * 128 * 4);
constexpr size_t WS_END = WS_LB + al256((size_t)256 * 16384 * 4);

static_assert(WS_END <= (size_t)1073741824, "d_ws map must fit 1 GiB");
constexpr int LDS_BYTES = 147456;
constexpr int LDS_MISC = 131072;

struct Params {
    const float* in[13];
    float* out;
    unsigned char* ws;
};

__device__ __forceinline__ unsigned pk2(float lo, float hi) {
    typedef float f2_t __attribute__((ext_vector_type(2))); typedef __bf16 b2_t __attribute__((ext_vector_type(2)));
    f2_t v = {lo, hi}; b2_t b = __builtin_convertvector(v, b2_t); return __builtin_bit_cast(unsigned, b);
}
__device__ __forceinline__ float bf2f(unsigned short b) { return __uint_as_float((unsigned)b << 16); }
__device__ __forceinline__ float bflo(unsigned w) { return __uint_as_float(w << 16); }
__device__ __forceinline__ float bfhi(unsigned w) { return __uint_as_float(w & 0xffff0000u); }
__device__ __forceinline__ unsigned short f2bf(float f) { return (unsigned short)(pk2(f, 0.f) & 0xffffu); }
__device__ __forceinline__ float fsilu(float x) { return x * __builtin_amdgcn_rcpf(1.f + __expf(-x)); }
__device__ __forceinline__ float logsig(float z) { return fminf(z, 0.f) - __logf(1.f + __expf(-fabsf(z))); }
__device__ __forceinline__ float wave_sum(float v) {
#pragma unroll
    for (int o = 1; o < 64; o <<= 1) v += __shfl_xor(v, o);
    return v;
}
__device__ __forceinline__ float wave_scan_incl(float v, int lane) {
#pragma unroll
    for (int o = 1; o < 64; o <<= 1) { float t = __shfl_up(v, o); if (lane >= o) v += t; }
    return v;
}
__device__ __forceinline__ float wave_scan_max(float v, int lane) {
#pragma unroll
    for (int o = 1; o < 64; o <<= 1) { float t = __shfl_up(v, o); if (lane >= o) v = fmaxf(v, t); }
    return v;
}
__device__ __forceinline__ float wave_min(float v) {
#pragma unroll
    for (int o = 1; o < 64; o <<= 1) v = fminf(v, __shfl_xor(v, o));
    return v;
}
__device__ __forceinline__ float sq8(u32x4 w) {
    float s = 0.f;
#pragma unroll
    for (int i = 0; i < 4; ++i) { const float a = bflo(w[i]), b = bfhi(w[i]); s += a * a + b * b; }
    return s;
}
#define XB_TMO      128
#define XB_XCNT(j)  (256  + 64 * (j))
#define XB_XSUB(j)  (1280 + 64 * (j))
#define XB_XGEN(j)  (2304 + 64 * (j))
#define XB_TOP      3328
#define XB_TOPGEN   3392
#define XCD_BAR_WORDS 3456
#define XB_SPIN_CAP (1u << 18)

__device__ __forceinline__ unsigned xb_ld(unsigned* p)              { return __hip_atomic_load(p, __ATOMIC_RELAXED, __HIP_MEMORY_SCOPE_AGENT); }
__device__ __forceinline__ unsigned xb_add(unsigned* p, unsigned v) { return __hip_atomic_fetch_add(p, v, __ATOMIC_RELAXED, __HIP_MEMORY_SCOPE_AGENT); }
__device__ __forceinline__ unsigned xb_xcc_id() { return (unsigned)__builtin_amdgcn_s_getreg((3 << 11) | 20) & 0xFu; }
#define XB_SPIN(cond, bar) do { unsigned _sp = 0; while (cond) { __builtin_amdgcn_s_sleep(1); \
    if ((++_sp & 255u) == 0u) { if (xb_ld(&(bar)[XB_TMO])) break; if (_sp > XB_SPIN_CAP) { atomicAdd(&(bar)[XB_TMO], 1u); break; } } } } while (0)

struct XcdBarrier {
    unsigned* bar; unsigned x;
    volatile LAS unsigned* st;
};

__device__ __forceinline__ XcdBarrier xcd_barrier_post(unsigned* bar, volatile LAS unsigned* st) {
    XcdBarrier b; b.bar = bar; b.x = xb_xcc_id(); b.st = st;
    if (threadIdx.x == 0) (void)xb_add(&bar[XB_XCNT(b.x)], 1u);
    return b;
}
__device__ __forceinline__ void xcd_barrier_complete(unsigned* bar, unsigned x, unsigned& nloc, unsigned& nx) {
    const unsigned G = gridDim.x * gridDim.y * gridDim.z;
    unsigned sum, cnt, mine, sp = 0u;
    for (;;) {
        sum = 0u; cnt = 0u; mine = 0u;
#pragma unroll
        for (unsigned j = 0; j < 16; ++j) { const unsigned c = xb_ld(&bar[XB_XCNT(j)]); sum += c; cnt += (c > 0u) ? 1u : 0u; mine = (j == x) ? c : mine; }
        if (sum == G) break;
        __builtin_amdgcn_s_sleep(1);
        if ((++sp & 255u) == 0u) { if (xb_ld(&bar[XB_TMO])) break; if (sp > XB_SPIN_CAP) { atomicAdd(&bar[XB_TMO], 1u); break; } }
    }
    nloc = mine > 0u ? mine : 1u; nx = cnt > 0u ? cnt : 1u;
}

__device__ __forceinline__ void xcd_barrier(const XcdBarrier& b) {
    asm volatile("s_waitcnt vmcnt(0)" ::: "memory");
    __syncthreads();
    if (threadIdx.x == 0) {
        unsigned* bar = b.bar;
        __builtin_amdgcn_s_waitcnt(0);
        unsigned nloc = b.st[0], nx = b.st[1];
        if (nloc == 0u) { xcd_barrier_complete(bar, b.x, nloc, nx); b.st[0] = nloc; b.st[1] = nx; }
        const unsigned old = xb_add(&bar[XB_XSUB(b.x)], 1u);
        const unsigned gen = old / nloc;
        if (old + 1u == (gen + 1u) * nloc) {
            __builtin_amdgcn_fence(__ATOMIC_RELEASE, "agent");
            asm volatile("s_waitcnt vmcnt(0)" ::: "memory");
            const unsigned og = xb_add(&bar[XB_TOP], 1u);
            const unsigned tg = og / nx;
            if (og + 1u == (tg + 1u) * nx) xb_add(&bar[XB_TOPGEN], 1u);
            else XB_SPIN(xb_ld(&bar[XB_TOPGEN]) == tg, bar);
            __builtin_amdgcn_fence(__ATOMIC_ACQUIRE, "agent");
            xb_add(&bar[XB_XGEN(b.x)], 1u);
            asm volatile("s_waitcnt vmcnt(0)" ::: "memory");
        } else {
            XB_SPIN(xb_ld(&bar[XB_XGEN(b.x)]) == gen, bar);
            __builtin_amdgcn_fence(__ATOMIC_ACQUIRE, "agent");
            asm volatile("s_waitcnt vmcnt(0)" ::: "memory");
        }
    }
    __syncthreads();
}

typedef short v4i16_t __attribute__((ext_vector_type(4)));
__device__ __forceinline__ u32x2 ldtr(LAS unsigned char* p) { const v4i16_t v = __builtin_amdgcn_ds_read_tr16_b64_v4i16((LAS v4i16_t*)p); return __builtin_bit_cast(u32x2, v); }
#define LDSW() asm volatile("s_waitcnt lgkmcnt(0)" ::: "memory")

__device__ __forceinline__ float row_rs(const float* SS, int r, int fq) {
    const f32x4 p4 = *(const f32x4*)(SS + (size_t)r * 16 + 4 * fq);
    float s = (p4[0] + p4[1]) + (p4[2] + p4[3]);
    s += __shfl_xor(s, 16); s += __shfl_xor(s, 32);
    return rsqrtf(s * (1.0f / 1024.0f) + EPS);
}
struct EpiIn {
    static constexpr bool PERM = true, AFTER_DRAIN = false;
    unsigned char* ws; float* out; const float* bfv; int layer;
    pg8::StaticOrder S; LAS unsigned char* rsl; mutable int ui;
    __device__ __forceinline__ void operator()(const f32x4 (&acc)[2][2][4][2], const pg8::Unit& u, int wr, int wc, int fr, int fq) const {
        unsigned char* ws = this->ws; float* out = this->out; const float* bfv = this->bfv;
        size_t zo = 0;
        asm volatile("" : "+v"(fr), "+v"(fq), "+s"(wr), "+s"(wc), "+s"(zo));
        ws += zo; out += zo; bfv += zo;
        const int cat = u.pn >> 1;
        const int rowb = u.pm * 256 + wr * 64 + fr;
        const bool samp = (u.pm >= MP / 256);
        const float* SS = (const float*)(ws + WS_SS);
        const int cb = (u.pn & 1) * 256 + wc * 32 + 8 * fq;
        LAS float* slot = (LAS float*)(rsl + (wr * 4 + wc) * 512);
        float rs[2][4];
        if (ui == 0) {
#pragma unroll
            for (int ai = 0; ai < 2; ++ai)
#pragma unroll
                for (int m = 0; m < 4; ++m) rs[ai][m] = row_rs(SS, rowb + ai * 128 + m * 16, fq);
        } else {
#pragma unroll
            for (int ai = 0; ai < 2; ++ai)
#pragma unroll
                for (int m = 0; m < 4; ++m) rs[ai][m] = slot[(ai * 4 + m) * 16 + fr];
        }
        pg8::Unit nx; const bool hasn = S.next(ui + 1, nx);
        f32x4 np[8];
        if (hasn) { const int nrowb = nx.pm * 256 + wr * 64 + fr;
#pragma unroll
            for (int q = 0; q < 8; ++q) np[q] = *(const f32x4*)(SS + (size_t)(nrowb + (q >> 2) * 128 + (q & 3) * 16) * 16 + 4 * fq); }
        if (cat == 0 || cat == 3 || cat == 4 || cat == 6 || cat == 7) {
            bf16_t* base; int pitch;
            if (cat == 0) { base = (bf16_t*)(ws + WS_QB); pitch = 512; } else if (cat == 3) { base = (bf16_t*)(ws + WS_YC); pitch = 1024; }
            else if (cat == 4) { base = (bf16_t*)(ws + WS_QE); pitch = 512; } else if (cat == 6) { base = (bf16_t*)(ws + WS_VTH); pitch = 512; } else { base = (bf16_t*)(ws + WS_YC) + 512; pitch = 1024; }
#pragma unroll
            for (int ai = 0; ai < 2; ++ai)
#pragma unroll
                for (int m = 0; m < 4; ++m) { const int r = rowb + ai * 128 + m * 16; const float sc = rs[ai][m];
#pragma unroll
                    for (int bj = 0; bj < 2; ++bj) { u32x4 w;
#pragma unroll
                        for (int n = 0; n < 2; ++n) { f32x4 v = acc[ai][bj][m][n] * sc;
                            if (cat == 0) v = v * QSCALE; else if (cat != 6) { v[0] = fsilu(v[0]); v[1] = fsilu(v[1]); v[2] = fsilu(v[2]); v[3] = fsilu(v[3]); }
                            w[2 * n] = pk2(v[0], v[1]); w[2 * n + 1] = pk2(v[2], v[3]); }
                        *(u32x4*)(base + (size_t)r * pitch + cb + bj * 128) = w; } }
        } else if (cat == 1 || cat == 2) {
#pragma unroll
            for (int ai = 0; ai < 2; ++ai)
#pragma unroll
                for (int m = 0; m < 4; ++m) { const int r = rowb + ai * 128 + m * 16; const float sc = rs[ai][m];
                    float* fo; bf16_t* bo;
                    if (!samp) { fo = out + (cat == 1 ? OFF_KP : OFF_VP) + ((size_t)layer * MP + r) * 512; bo = (bf16_t*)(ws + (cat == 1 ? WS_KBP : WS_VTP)) + (size_t)r * 512; }
                    else { const int q = r - MP; fo = out + (cat == 1 ? OFF_KS : OFF_VS) + ((size_t)layer * MS + q) * 512; bo = (bf16_t*)(ws + (cat == 1 ? WS_KBS : WS_VTS)) + ((size_t)layer * KSROWS + (size_t)((q >> 6) * SKV + PAST + (q & 63))) * 512; }
#pragma unroll
                    for (int bj = 0; bj < 2; ++bj) { u32x4 w;
#pragma unroll
                        for (int n = 0; n < 2; ++n) { const f32x4 v = acc[ai][bj][m][n] * sc; *(f32x4*)(fo + cb + bj * 128 + 4 * n) = v; w[2 * n] = pk2(v[0], v[1]); w[2 * n + 1] = pk2(v[2], v[3]); }
                        *(u32x4*)(bo + cb + bj * 128) = w; } }
        } else if (cat == 5) {
            float* HF = (float*)(ws + WS_HF);
#pragma unroll
            for (int ai = 0; ai < 2; ++ai)
#pragma unroll
                for (int m = 0; m < 4; ++m) { const int r = rowb + ai * 128 + m * 16; const float sc = rs[ai][m];
#pragma unroll
                    for (int bj = 0; bj < 2; ++bj)
#pragma unroll
                        for (int n = 0; n < 2; ++n) *(f32x4*)(HF + (size_t)r * 512 + cb + bj * 128 + n * 4) = acc[ai][bj][m][n] * sc; }
        } else {
            const f32x4 b0 = *(const f32x4*)(bfv), b1 = *(const f32x4*)(bfv + 4);
#pragma unroll
            for (int ai = 0; ai < 2; ++ai)
#pragma unroll
                for (int m = 0; m < 4; ++m) { const int r = rowb + ai * 128 + m * 16; const float sc = rs[ai][m];
                    if (wc == 0 && fq == 0) {
                        const f32x4 v0 = acc[ai][0][m][0] * sc + b0, v1 = acc[ai][0][m][1] * sc + b1; f32x4 o0, o1;
#pragma unroll
                        for (int i = 0; i < 4; ++i) { o0[i] = logsig(v0[i]); o1[i] = logsig(v1[i]); }
                        float* dst = samp ? (out + OFF_LS + ((size_t)layer * MS + (r - MP)) * 8) : (out + OFF_LP + ((size_t)layer * MP + r) * 8);
                        *(f32x4*)(dst) = o0; *(f32x4*)(dst + 4) = o1; } }
        }
        if (hasn) {
#pragma unroll
            for (int q = 0; q < 8; ++q) { float s_ = (np[q][0] + np[q][1]) + (np[q][2] + np[q][3]); s_ += __shfl_xor(s_, 16); s_ += __shfl_xor(s_, 32);
                if (fq == 0) slot[q * 16 + fr] = rsqrtf(s_ * (1.0f / 1024.0f) + EPS); }
        }
        ++ui;
    }
};

struct OneUnit {
    int pm, pn;
    __device__ __forceinline__ bool next(int i, pg8::Unit& u) const { if (i != 0) return false; u.pm = pm; u.pn = pn; return true; }
    __device__ __forceinline__ void a_ready(const pg8::Unit&) const {}
    __device__ __forceinline__ void done(const pg8::Unit&) const {}
};
struct EpiOut {
    static constexpr bool PERM = true, AFTER_DRAIN = false;
    bf16_t* XB;
    float* SS;
    __device__ __forceinline__ void operator()(const f32x4 (&acc)[2][2][4][2], const pg8::Unit& u, int wr, int wc, int fr, int fq) const {
        bf16_t* XB = this->XB; float* SS = this->SS;
        size_t zo = 0;
        asm volatile("" : "+v"(fr), "+v"(fq), "+s"(wr), "+s"(wc), "+s"(zo));
        XB += zo; SS += zo;
        const int rowb = u.pm * 256 + wr * 64 + fr;
        const int cb = u.pn * 256 + wc * 32 + 8 * fq;
#pragma unroll
        for (int ai = 0; ai < 2; ++ai)
#pragma unroll
            for (int m = 0; m < 4; ++m) { const int r = rowb + ai * 128 + m * 16;
                u32x4 rw[2];
#pragma unroll
                for (int bj = 0; bj < 2; ++bj) rw[bj] = *(const u32x4*)(XB + (size_t)r * 1024 + cb + bj * 128);
                float ss = 0.f;
#pragma unroll
                for (int bj = 0; bj < 2; ++bj) { u32x4 w;
#pragma unroll
                    for (int n = 0; n < 2; ++n) { f32x4 v = acc[ai][bj][m][n];
                        v[0] += bflo(rw[bj][2 * n]); v[1] += bfhi(rw[bj][2 * n]); v[2] += bflo(rw[bj][2 * n + 1]); v[3] += bfhi(rw[bj][2 * n + 1]);
                        ss += (v[0] * v[0] + v[1] * v[1]) + (v[2] * v[2] + v[3] * v[3]);
                        w[2 * n] = pk2(v[0], v[1]); w[2 * n + 1] = pk2(v[2], v[3]); }
                    *(u32x4*)(XB + (size_t)r * 1024 + cb + bj * 128) = w; }
                ss += __shfl_xor(ss, 16); ss += __shfl_xor(ss, 32);
                if (fq == 0) SS[(size_t)r * 16 + (u.pn * 4 + wc)] = ss; }
    }
};

__device__ __forceinline__ void tr_item(const float* src, size_t spitch, int nvalid, const float* scale, bf16_t* dst, size_t dpitch, LAS float* scr, int lane) {
    const int n = lane & 31;
#pragma unroll 16
    for (int i = 0; i < 32; ++i) { const int kk = 2 * i + (lane >> 5); float v = (n < nvalid) ? src[(size_t)kk * spitch + n] : 0.f; if (scale) v *= scale[kk]; scr[kk * 33 + n] = v; }
    LDSW();
    const int c = lane & 7;
#pragma unroll
    for (int j = 0; j < 4; ++j) { const int nn = (lane >> 3) + 8 * j; const LAS float* s = scr + (8 * c) * 33 + nn;
        u32x4 o; o.x = pk2(s[0 * 33], s[1 * 33]); o.y = pk2(s[2 * 33], s[3 * 33]); o.z = pk2(s[4 * 33], s[5 * 33]); o.w = pk2(s[6 * 33], s[7 * 33]);
        *(u32x4*)(dst + (size_t)nn * dpitch + 8 * c) = o; }
    LDSW();
}

__device__ __forceinline__ void p0_prologue(const Params& P, LAS unsigned char* lds, int tid, int lane, int wave) {
    unsigned char* ws = P.ws;
    LAS float* scr = (LAS float*)(lds + wave * 16384);
    const bool roleA = wave < 4;
    const int gw = roleA ? (blockIdx.x * 4 + wave) : (blockIdx.x * 4 + (wave - 4)), NGW = gridDim.x * 4;
    const float* w_in = P.in[7]; const float* w_out = P.in[11]; const float* norm_g = P.in[6];
    bf16_t* WTIN = (bf16_t*)(ws + WS_WTIN); bf16_t* WTOUT = (bf16_t*)(ws + WS_WTOUT);
    constexpr int I_IN = 16 * (NPAD / 32), I_OUT = 16 * 32;
    constexpr int NIT = DEPTH * I_IN + DEPTH * I_OUT;
    if (roleA)
    for (int it = gw; it < NIT; it += NGW) {
        int r = it;
        if (r < DEPTH * I_IN) { const int l = r / I_IN; r -= l * I_IN; const int kb = r / (NPAD / 32), nb = r % (NPAD / 32), n0 = nb * 32;
            int sc = n0, nv = 32; if (n0 >= 4104) { sc = 0; nv = 0; } else if (n0 >= 4096) { sc = 1536; nv = 8; } else if (n0 >= 1536) sc = n0 + 8;
            tr_item(w_in + (size_t)l * 1024 * DIN + (size_t)(64 * kb) * DIN + sc, DIN, nv, norm_g + l * 1024 + 64 * kb, WTIN + ((size_t)l * NPAD + n0) * 1024 + 64 * kb, 1024, scr, lane);
            continue; }
        r -= DEPTH * I_IN;
        if (r < DEPTH * I_OUT) { const int l = r / I_OUT; r -= l * I_OUT; const int kb = r / 32, nb = r % 32;
            tr_item(w_out + (size_t)l * 1024 * 1024 + (size_t)(64 * kb) * 1024 + nb * 32, 1024, 32, nullptr, WTOUT + ((size_t)l * 1024 + nb * 32) * 1024 + 64 * kb, 1024, scr, lane);
            continue; }
    }
    bf16_t* XB = (bf16_t*)(ws + WS_XB); float* SS = (float*)(ws + WS_SS);
    if (!roleA)
    for (int r0 = gw; r0 < MT; r0 += 4 * NGW) {
        f32x4 v[4][4];
#pragma unroll
        for (int q = 0; q < 4; ++q) { const int r = min(r0 + q * NGW, MT - 1);
            const float* src = (r < MP) ? (P.in[0] + (size_t)r * 1024) : (P.in[1] + (size_t)(r - MP) * 1024);
#pragma unroll
            for (int j = 0; j < 4; ++j) v[q][j] = ((const f32x4*)src)[lane + 64 * j]; }
#pragma unroll
        for (int q = 0; q < 4; ++q) { const int r = r0 + q * NGW;
            float s = 0.f;
#pragma unroll
            for (int j = 0; j < 4; ++j) s += (v[q][j][0] * v[q][j][0] + v[q][j][1] * v[q][j][1]) + (v[q][j][2] * v[q][j][2] + v[q][j][3] * v[q][j][3]);
            s = wave_sum(s);
            if (r < MT) {
#pragma unroll
                for (int j = 0; j < 4; ++j) { u32x2 w; w.x = pk2(v[q][j][0], v[q][j][1]); w.y = pk2(v[q][j][2], v[q][j][3]); ((u32x2*)(XB + (size_t)r * 1024))[lane + 64 * j] = w; }
                if (lane < 16) SS[(size_t)r * 16 + lane] = (lane == 0) ? s : 0.f;
            } }
    }
    if (roleA)
    for (int tl = gw; tl < DEPTH * DBAT * 32; tl += NGW) {
        const int l = tl / (DBAT * 32), q = tl % (DBAT * 32), b = q / 32, t = q % 32;
        const float* src = P.in[2] + ((size_t)(l * DBAT + b) * PAST + t * 64) * 512;
        float nmax = 0.f;
#pragma unroll 16
        for (int r = 0; r < 64; ++r) {
            const f32x4 a = ((const f32x4*)(src + (size_t)r * 512))[2 * lane], c = ((const f32x4*)(src + (size_t)r * 512))[2 * lane + 1];
            u32x4 w; w.x = pk2(a[0], a[1]); w.y = pk2(a[2], a[3]); w.z = pk2(c[0], c[1]); w.w = pk2(c[2], c[3]);
            float n2 = sq8(w); n2 += __shfl_xor(n2, 1); n2 += __shfl_xor(n2, 2); n2 += __shfl_xor(n2, 4); nmax = fmaxf(nmax, n2);
        }
        if ((lane & 7) == 0) ((float*)(ws + WS_KN))[((size_t)l * NKT + 1024 + b * 33 + t) * 8 + (lane >> 3)] = sqrtf(nmax);
    }
    float* CL = (float*)(ws + WS_CL); float* BT = (float*)(ws + WS_BT);
    if (roleA)
    for (int r = gw; r < DEPTH * DBAT * 32; r += NGW) {
        const int l = r / (DBAT * 32), q = r % (DBAT * 32), b = q / 32, t = q % 32;
        const float* src = P.in[4] + ((size_t)(l * DBAT + b) * PAST + t * 64 + lane) * 8;
        const size_t krow = (size_t)MP + (size_t)b * SKV + t * 64 + lane;
#pragma unroll
        for (int h = 0; h < 8; ++h) { const float c = wave_scan_incl(src[h], lane); CL[((size_t)l * KROWS + krow) * 8 + h] = c; const float cm = wave_min(c);
            if (lane == 63) { BT[((size_t)l * NKT + (krow >> 6)) * 8 + h] = c; ((float*)(ws + WS_CM))[((size_t)l * NKT + (krow >> 6)) * 8 + h] = cm; } }
    }
}

__device__ __forceinline__ void fox_cumsum(const Params& P, LAS unsigned char* lds, int layer, int tid, int lane, int wave) {
    asm volatile("" : "+v"(lane));
    float* CL = (float*)(P.ws + WS_CL) + (size_t)layer * KROWS * 8; float* BT = (float*)(P.ws + WS_BT) + (size_t)layer * NKT * 8;
    float* CM = (float*)(P.ws + WS_CM) + (size_t)layer * NKT * 8; float* KN = (float*)(P.ws + WS_KN) + (size_t)layer * NKT * 8;
    const float* lfP = P.out + OFF_LP + (size_t)layer * MP * 8; const float* lfS = P.out + OFF_LS + (size_t)layer * MS * 8;
    LAS float* part = (LAS float*)lds;
    for (int g = blockIdx.x; g < NG; g += gridDim.x) {
        const float* src; size_t krow0;
        if (g < MP / 64) { src = lfP + (size_t)g * 64 * 8; krow0 = (size_t)g * 64; }
        else { const int b = g - MP / 64; src = lfS + (size_t)b * 64 * 8; krow0 = (size_t)MP + (size_t)b * SKV + PAST; }
        const bf16_t* kb = (g < MP / 64) ? ((const bf16_t*)(P.ws + WS_KBP) + krow0 * 512) : ((const bf16_t*)(P.ws + WS_KBS) + ((size_t)layer * KSROWS + (krow0 - MP)) * 512);
        u32x4 kw[8];
#pragma unroll
        for (int r = 0; r < 8; ++r) kw[r] = ((const u32x4*)(kb + (size_t)(8 * wave + r) * 512))[lane];
        float hv[8];
        if (wave == 0) {
#pragma unroll
            for (int h = 0; h < 8; ++h) hv[h] = src[(size_t)lane * 8 + h];
        }
        float nmax = 0.f;
#pragma unroll
        for (int r = 0; r < 8; ++r) { float n2 = sq8(kw[r]); n2 += __shfl_xor(n2, 1); n2 += __shfl_xor(n2, 2); n2 += __shfl_xor(n2, 4); nmax = fmaxf(nmax, n2); }
        if ((lane & 7) == 0) part[wave * 8 + (lane >> 3)] = nmax;
        if (wave == 0) {
#pragma unroll
            for (int h = 0; h < 8; ++h) { const float c = wave_scan_incl(hv[h], lane); CL[(krow0 + lane) * 8 + h] = c; const float cm = wave_min(c);
                if (lane == 63) { BT[(krow0 >> 6) * 8 + h] = c; CM[(krow0 >> 6) * 8 + h] = cm; } }
        }
        __syncthreads();
        if (tid < 8) { float m = part[tid];
#pragma unroll
            for (int w = 1; w < 8; ++w) m = fmaxf(m, part[w * 8 + tid]);
            KN[(krow0 >> 6) * 8 + tid] = sqrtf(m); }
        __syncthreads();
    }
}

#define MFMA16(a, b, c) __builtin_amdgcn_mfma_f32_16x16x32_bf16((a), (b), (c), 0, 0, 0)
#define MFMA32(a, b, c) __builtin_amdgcn_mfma_f32_32x32x16_bf16((a), (b), (c), 0, 0, 0)

constexpr int PP_QT = 0, PP_KT = 17408, PP_VT = 34816, PP_AM = 53248, PP_TOT = 62464;
__device__ __forceinline__ void hg_prepass_unit(const Params& P, LAS unsigned char* lds, int layer, int g, int h, int tid, int lane, int wave) {
    unsigned char* ws = P.ws; const float* hl = P.in[9];
    size_t zo = 0;
    asm volatile("" : "+v"(tid), "+v"(lane), "+s"(zo), "+s"(g), "+s"(h));
    ws += zo; hl += zo;
    const int k = tid & 127, tq = tid >> 7, fr = lane & 15, fq = lane >> 4;
    float* HF = (float*)(ws + WS_HF); bf16_t* QE = (bf16_t*)(ws + WS_QE); bf16_t* KDT = (bf16_t*)(ws + WS_KDT) + (size_t)(g * 4 + h) * 8192;
    const bf16_t* HI = (const bf16_t*)(ws + WS_VTH) + (size_t)g * 64 * 512 + h * 128; float* DG = (float*)(ws + WS_DG) + (size_t)(g * 4 + h) * 128;
    float lbv = 0.f;
    if (layer > 0) { lbv = __builtin_amdgcn_rcpf(1.f + __expf(hl[h * 128 + k] - hl[512 + h * 128 + k])); }
    const float oml = 1.f - lbv;
    const size_t e0 = ((size_t)g * 64 + tq * 16) * 512 + h * 128 + k;
    float bc[16], kk[16]; unsigned short qv[16];
    float run = 0.f;
#pragma unroll
    for (int i = 0; i < 16; ++i) qv[i] = QE[e0 + (size_t)i * 512];
#pragma unroll
    for (int i = 0; i < 16; ++i) { const float z = HF[e0 + (size_t)i * 512]; const float ls = logsig(z);
        const float lf = (layer == 0) ? ls : __logf(lbv + oml * __expf(ls)); run += lf; bc[i] = run; kk[i] = oml * __builtin_amdgcn_rcpf(1.f + __expf(z)); }
    LAS float* tot = (LAS float*)(lds + PP_TOT);
    tot[tq * 128 + k] = run;
#pragma unroll
    for (int j = 0; j < 2; ++j) { const int idx = tid + 512 * j, rc = idx >> 4, ch = idx & 15; const u32x4 v = *(const u32x4*)(HI + (size_t)rc * 512 + ch * 8); *(LAS u32x4*)(lds + PP_VT + rc * 272 + ch * 16) = v; }
    __syncthreads();
    const float t0 = tot[k], t1 = tot[128 + k], t2 = tot[256 + k], t3 = tot[384 + k];
    const float off = (tq > 0 ? t0 : 0.f) + (tq > 1 ? t1 : 0.f) + (tq > 2 ? t2 : 0.f);
    const float bmid = t0 + t1, blast = (t0 + t1) + (t2 + t3);
    unsigned kdp[8];
#pragma unroll
    for (int i = 0; i < 16; i += 2) {
        float kd2[2];
#pragma unroll
        for (int j = 0; j < 2; ++j) { const int ii = i + j; const float b = bc[ii] + off; const float q = bf2f(qv[ii]);
            const float qe = q * __expf(b), kd = kk[ii] * __expf(blast - b), qt = q * __expf(b - bmid), kt = kk[ii] * __expf(bmid - b);
            QE[e0 + (size_t)ii * 512] = f2bf(qe); kd2[j] = kd;
            const int t = tq * 16 + ii;
            *(LAS bf16_t*)(lds + PP_QT + t * 272 + k * 2) = f2bf(qt); *(LAS bf16_t*)(lds + PP_KT + t * 272 + k * 2) = f2bf(kt); }
        kdp[i >> 1] = pk2(kd2[0], kd2[1]);
    }
    { u32x4 w0 = {kdp[0], kdp[1], kdp[2], kdp[3]}, w1 = {kdp[4], kdp[5], kdp[6], kdp[7]};
      *(u32x4*)(KDT + k * 64 + tq * 16) = w0; *(u32x4*)(KDT + k * 64 + tq * 16 + 8) = w1; }
    if (tq == 0) { DG[k] = __expf(blast); ((float*)(ws + WS_LG))[(size_t)(g * 4 + h) * 128 + k] = blast; }
    __syncthreads();
    { const int mt = wave >> 1;
#pragma unroll
      for (int nn = 0; nn < 2; ++nn) { const int nt = 2 * (wave & 1) + nn; f32x4 a4 = {0.f, 0.f, 0.f, 0.f};
#pragma unroll
          for (int ks = 0; ks < 4; ++ks) { const bf16x8 a = *(const LAS bf16x8*)(lds + PP_QT + (16 * mt + fr) * 272 + (32 * ks + 8 * fq) * 2);
              const bf16x8 b = *(const LAS bf16x8*)(lds + PP_KT + (16 * nt + fr) * 272 + (32 * ks + 8 * fq) * 2); a4 = MFMA16(a, b, a4); }
#pragma unroll
          for (int rg = 0; rg < 4; ++rg) { const int t = 16 * mt + 4 * fq + rg, s = 16 * nt + fr; const float v = (s <= t) ? a4[rg] : 0.f;
              *(LAS bf16_t*)(lds + PP_AM + t * 144 + s * 2) = f2bf(v); } } }
    __syncthreads();
    { float* OI = HF + (size_t)g * 64 * 512 + h * 128 + 16 * wave + fr;
#pragma unroll
      for (int mt = 0; mt < 4; ++mt) { f32x4 a4 = {0.f, 0.f, 0.f, 0.f};
#pragma unroll
          for (int ks = 0; ks < 2; ++ks) { const bf16x8 a = *(const LAS bf16x8*)(lds + PP_AM + (16 * mt + fr) * 144 + (32 * ks + 8 * fq) * 2);
              const int trq = (lane & 15) >> 2, trp = lane & 3;
              const u32x2 bl = ldtr(lds + PP_VT + (32 * ks + 8 * fq + trq) * 272 + (16 * wave + 4 * trp) * 2), bh = ldtr(lds + PP_VT + (32 * ks + 8 * fq + 4 + trq) * 272 + (16 * wave + 4 * trp) * 2);
              const u32x4 bw = {bl.x, bl.y, bh.x, bh.y}; a4 = MFMA16(a, __builtin_bit_cast(bf16x8, bw), a4); }
#pragma unroll
          for (int rg = 0; rg < 4; ++rg) OI[(size_t)(16 * mt + 4 * fq + rg) * 512] = a4[rg]; } }
    __syncthreads();
}

constexpr int HS_QE = 0, HS_KD = 17408, HS_VT = 35840, HS_D = 54272, HS_O = 54784, HS_G = 54784 + 33792, HS_DS = HS_G + 512, HS_DC = HS_DS + 4096;
constexpr int NSEG = 8, SEGC = 16;
__device__ __forceinline__ void hg_seq_unit(const Params& P, LAS unsigned char* lds, int layer, int g0, int nch, int h, const float* S0, float* Sout, int mode, int seg, const float* Lb, int tid, int lane, int wave) {
    unsigned char* ws = P.ws; const float* gnp = P.in[10] + layer * 512 + h * 128;
    size_t zo = 0;
    asm volatile("" : "+v"(tid), "+v"(lane), "+s"(zo), "+s"(g0), "+s"(nch), "+s"(h), "+s"(mode), "+s"(seg));
    ws += zo; gnp += zo; S0 += zo; Sout += zo; Lb += zo;
    const int fr = lane & 15, fq = lane >> 4;
    const bf16_t* QE = (const bf16_t*)(ws + WS_QE); const bf16_t* KDT = (const bf16_t*)(ws + WS_KDT); const bf16_t* HI = (const bf16_t*)(ws + WS_VTH);
    const float* DG = (const float*)(ws + WS_DG); float* OI = (float*)(ws + WS_HF); bf16_t* YC = (bf16_t*)(ws + WS_YC);
    f32x4 S[8];
#pragma unroll
    for (int kb = 0; kb < 8; ++kb) S[kb] = (f32x4){0.f, 0.f, 0.f, 0.f};
    if (mode == 0) {
#pragma unroll
        for (int kb = 0; kb < 8; ++kb)
#pragma unroll
            for (int rg = 0; rg < 4; ++rg) S[kb][rg] = S0[(size_t)(16 * kb + 4 * fq + rg) * 128 + 16 * wave + fr];
    }
    if (mode == 2) {
        const float* LG = (const float*)(ws + WS_LG);
        if (tid < 128) {
            const int gb = g0 - seg * SEGC;
            for (int j = 0; j < seg; ++j) { float a = 0.f;
#pragma unroll
                for (int c = 0; c < SEGC; ++c) a += LG[((size_t)(gb + SEGC * j + c) * 4 + h) * 128 + tid];
                *(LAS float*)(lds + HS_DS + (j * 128 + tid) * 4) = __expf(a); }
            float run = 0.f;
#pragma unroll
            for (int c = 0; c < SEGC; ++c) { *(LAS float*)(lds + HS_DC + (c * 128 + tid) * 4) = __expf(run); run += LG[((size_t)(g0 + c) * 4 + h) * 128 + tid]; }
            *(LAS float*)(lds + HS_DS + (seg * 128 + tid) * 4) = __expf(run);
        }
        __syncthreads();
        for (int j = 0; j < seg; ++j) { const float* Lj = Lb + (size_t)j * 16384;
#pragma unroll
            for (int kb = 0; kb < 8; ++kb) { const f32x4 d4 = *(const LAS f32x4*)(lds + HS_DS + (j * 128 + 16 * kb + 4 * fq) * 4);
#pragma unroll
                for (int rg = 0; rg < 4; ++rg) S[kb][rg] = S[kb][rg] * d4[rg] + Lj[(size_t)(16 * kb + 4 * fq + rg) * 128 + 16 * wave + fr]; } }
    }
    const int nt = tid >> 3, nseg = tid & 7;
    if (tid < 128) *(LAS float*)(lds + HS_G + tid * 4) = gnp[tid];
    u32x4 pq[2], pkd[2], pv[2]; f32x4 pd;
#define HS_ISSUE(g) do { _Pragma("unroll") for (int j = 0; j < 2; ++j) { const int idx = tid + 512 * j; \
        pq[j] = *(const u32x4*)(QE + ((size_t)(g) * 64 + (idx >> 4)) * 512 + h * 128 + (idx & 15) * 8); \
        if (mode != 2) { pkd[j] = *(const u32x4*)(KDT + (size_t)((g) * 4 + h) * 8192 + idx * 8); pv[j] = *(const u32x4*)(HI + ((size_t)(g) * 64 + (idx >> 4)) * 512 + h * 128 + (idx & 15) * 8); } } \
        if (mode != 2 && tid < 32) pd = *(const f32x4*)(DG + (size_t)((g) * 4 + h) * 128 + tid * 4); } while (0)
#define HS_COMMIT() do { _Pragma("unroll") for (int j = 0; j < 2; ++j) { const int idx = tid + 512 * j; \
        *(LAS u32x4*)(lds + HS_QE + (idx >> 4) * 272 + (idx & 15) * 16) = pq[j]; \
        if (mode != 2) { *(LAS u32x4*)(lds + HS_KD + (idx >> 3) * 144 + (idx & 7) * 16) = pkd[j]; *(LAS u32x4*)(lds + HS_VT + (idx >> 4) * 272 + (idx & 15) * 16) = pv[j]; } } \
        if (mode != 2 && tid < 32) *(LAS f32x4*)(lds + HS_D + tid * 16) = pd; } while (0)
    HS_ISSUE(g0); HS_COMMIT();
    u32x4 gt0 = {0u, 0u, 0u, 0u}, gt1 = {0u, 0u, 0u, 0u}; f32x4 oi[4];
#define HS_LOAD_OI(g) do { _Pragma("unroll") for (int mt = 0; mt < 4; ++mt) _Pragma("unroll") for (int rg = 0; rg < 4; ++rg) \
        oi[mt][rg] = OI[((size_t)(g) * 64 + 16 * mt + 4 * fq + rg) * 512 + h * 128 + 16 * wave + fr]; } while (0)
#define HS_LOAD_GT(g) do { const size_t yo_ = ((size_t)(g) * 64 + nt) * 1024 + 512 + h * 128 + 16 * nseg; gt0 = *(const u32x4*)(YC + yo_); gt1 = *(const u32x4*)(YC + yo_ + 8); } while (0)
    HS_LOAD_OI(g0); if (mode != 1) HS_LOAD_GT(g0);
    __syncthreads();
    for (int c = 0; c < nch; ++c) {
        const int g = g0 + c;
        if (c + 1 < nch) HS_ISSUE(g + 1);
        const size_t yoff = ((size_t)g * 64 + nt) * 1024 + 512 + h * 128 + 16 * nseg;
        bf16x8 sb[4];
        if (mode == 2) {
#pragma unroll
            for (int ks = 0; ks < 4; ++ks) { const f32x4 da = *(const LAS f32x4*)(lds + HS_DC + (c * 128 + 32 * ks + 4 * fq) * 4), db = *(const LAS f32x4*)(lds + HS_DC + (c * 128 + 32 * ks + 16 + 4 * fq) * 4);
                const f32x4 x = S[2 * ks] * da, y = S[2 * ks + 1] * db; u32x4 w; w.x = pk2(x[0], x[1]); w.y = pk2(x[2], x[3]); w.z = pk2(y[0], y[1]); w.w = pk2(y[2], y[3]); sb[ks] = __builtin_bit_cast(bf16x8, w); }
        } else {
#pragma unroll
            for (int ks = 0; ks < 4; ++ks) { u32x4 w; w.x = pk2(S[2 * ks][0], S[2 * ks][1]); w.y = pk2(S[2 * ks][2], S[2 * ks][3]); w.z = pk2(S[2 * ks + 1][0], S[2 * ks + 1][1]); w.w = pk2(S[2 * ks + 1][2], S[2 * ks + 1][3]);
                sb[ks] = __builtin_bit_cast(bf16x8, w); }
        }
#pragma unroll
        for (int mp = 0; mp < 2; ++mp) { u32x2 alo[2][4], ahi[2][4];
#pragma unroll
          for (int m2 = 0; m2 < 2; ++m2)
#pragma unroll
              for (int ks = 0; ks < 4; ++ks) { const int mt = 2 * mp + m2; alo[m2][ks] = *(const LAS u32x2*)(lds + HS_QE + (16 * mt + fr) * 272 + (32 * ks + 4 * fq) * 2);
                  ahi[m2][ks] = *(const LAS u32x2*)(lds + HS_QE + (16 * mt + fr) * 272 + (32 * ks + 16 + 4 * fq) * 2); }
          __builtin_amdgcn_sched_barrier(0);
#pragma unroll
          for (int m2 = 0; m2 < 2; ++m2) { const int mt = 2 * mp + m2; f32x4 o4 = oi[mt];
#pragma unroll
              for (int ks = 0; ks < 4; ++ks) { const u32x4 aw = {alo[m2][ks].x, alo[m2][ks].y, ahi[m2][ks].x, ahi[m2][ks].y}; o4 = MFMA16(__builtin_bit_cast(bf16x8, aw), sb[ks], o4); }
              if (mode == 1) {
#pragma unroll
                  for (int rg = 0; rg < 4; ++rg) OI[((size_t)g * 64 + 16 * mt + 4 * fq + rg) * 512 + h * 128 + 16 * wave + fr] = o4[rg];
              } else {
#pragma unroll
                  for (int rg = 0; rg < 4; ++rg) *(LAS float*)(lds + HS_O + ((16 * mt + 4 * fq + rg) * 132 + 16 * wave + fr) * 4) = o4[rg];
              } } }
        if (c + 1 < nch) HS_LOAD_OI(g + 1);
        if (mode != 2) {
          const int trq = (lane & 15) >> 2, trp = lane & 3;
          const u32x2 v0 = ldtr(lds + HS_VT + (8 * fq + trq) * 272 + (16 * wave + 4 * trp) * 2), v1 = ldtr(lds + HS_VT + (8 * fq + 4 + trq) * 272 + (16 * wave + 4 * trp) * 2);
          const u32x2 v2 = ldtr(lds + HS_VT + (32 + 8 * fq + trq) * 272 + (16 * wave + 4 * trp) * 2), v3 = ldtr(lds + HS_VT + (32 + 8 * fq + 4 + trq) * 272 + (16 * wave + 4 * trp) * 2);
          const u32x4 bw0 = {v0.x, v0.y, v1.x, v1.y}, bw1 = {v2.x, v2.y, v3.x, v3.y};
          const bf16x8 b0 = __builtin_bit_cast(bf16x8, bw0), b1 = __builtin_bit_cast(bf16x8, bw1);
#pragma unroll
          for (int hf = 0; hf < 2; ++hf) { f32x4 d4[4]; bf16x8 a0[4], a1[4];
#pragma unroll
              for (int q = 0; q < 4; ++q) { const int kb = 4 * hf + q; d4[q] = *(const LAS f32x4*)(lds + HS_D + (16 * kb + 4 * fq) * 4);
                  a0[q] = *(const LAS bf16x8*)(lds + HS_KD + (16 * kb + fr) * 144 + (8 * fq) * 2); a1[q] = *(const LAS bf16x8*)(lds + HS_KD + (16 * kb + fr) * 144 + (32 + 8 * fq) * 2); }
              __builtin_amdgcn_sched_barrier(0);
#pragma unroll
              for (int q = 0; q < 4; ++q) { const int kb = 4 * hf + q; S[kb] = S[kb] * d4[q]; S[kb] = MFMA16(a0[q], b0, S[kb]); S[kb] = MFMA16(a1[q], b1, S[kb]); } } }
        __syncthreads();
        if (mode != 1) { f32x4 v[4]; float ss = 0.f;
#pragma unroll
          for (int j = 0; j < 4; ++j) { v[j] = *(const LAS f32x4*)(lds + HS_O + (nt * 132 + 16 * nseg + 4 * j) * 4); ss += (v[j][0] * v[j][0] + v[j][1] * v[j][1]) + (v[j][2] * v[j][2] + v[j][3] * v[j][3]); }
          ss += __shfl_xor(ss, 1); ss += __shfl_xor(ss, 2); ss += __shfl_xor(ss, 4);
          const float rinv = rsqrtf(ss * (1.0f / 128.0f) + EPS);
          const unsigned gw_[8] = {gt0.x, gt0.y, gt0.z, gt0.w, gt1.x, gt1.y, gt1.z, gt1.w};
          unsigned ow[8];
#pragma unroll
          for (int j = 0; j < 8; ++j) { const f32x4 gq = *(const LAS f32x4*)(lds + HS_G + (16 * nseg + 4 * (j >> 1)) * 4); const float g0_ = gq[(j & 1) * 2], g1_ = gq[(j & 1) * 2 + 1];
              const float a = v[j >> 1][(j & 1) * 2] * rinv * g0_ * bflo(gw_[j]); const float b = v[j >> 1][(j & 1) * 2 + 1] * rinv * g1_ * bfhi(gw_[j]); ow[j] = pk2(a, b); }
          const u32x4 o0 = {ow[0], ow[1], ow[2], ow[3]}, o1 = {ow[4], ow[5], ow[6], ow[7]};
          *(u32x4*)(YC + yoff) = o0; *(u32x4*)(YC + yoff + 8) = o1;
          if (c + 1 < nch) HS_LOAD_GT(g + 1); }
        if (c + 1 < nch) HS_COMMIT();
        __syncthreads();
    }
    if (mode == 2) {
        if (seg == NSEG - 1) {
            const float* Lj = Lb + (size_t)seg * 16384;
#pragma unroll
            for (int kb = 0; kb < 8; ++kb) { const f32x4 d4 = *(const LAS f32x4*)(lds + HS_DS + (seg * 128 + 16 * kb + 4 * fq) * 4);
#pragma unroll
                for (int rg = 0; rg < 4; ++rg) Sout[(size_t)(16 * kb + 4 * fq + rg) * 128 + 16 * wave + fr] = S[kb][rg] * d4[rg] + Lj[(size_t)(16 * kb + 4 * fq + rg) * 128 + 16 * wave + fr]; }
        }
    } else {
#pragma unroll
        for (int kb = 0; kb < 8; ++kb)
#pragma unroll
            for (int rg = 0; rg < 4; ++rg) Sout[(size_t)(16 * kb + 4 * fq + rg) * 128 + 16 * wave + fr] = S[kb][rg];
    }
    __syncthreads();
#undef HS_ISSUE
#undef HS_COMMIT
#undef HS_LOAD_OI
#undef HS_LOAD_GT
}

constexpr int HL_QE = 0, HL_KD = 17408, HL_VT = 35840, HL_D = 53248, HL_QT = 53760, HL_KT = 71168, HL_AM = 88576, HL_TOT = 97792;
__device__ __forceinline__ void hg_local_unit(const Params& P, LAS unsigned char* lds, int layer, int g0, int h, float* Sout, int tid, int lane, int wave) {
    unsigned char* ws = P.ws; const float* hl = P.in[9];
    size_t zo = 0;
    asm volatile("" : "+v"(tid), "+v"(lane), "+s"(zo), "+s"(g0), "+s"(h));
    ws += zo; hl += zo; Sout += zo;
    const int k = tid & 127, tq = tid >> 7, fr = lane & 15, fq = lane >> 4;
    float* HF = (float*)(ws + WS_HF); bf16_t* QE = (bf16_t*)(ws + WS_QE); const bf16_t* HIb = (const bf16_t*)(ws + WS_VTH); float* LG = (float*)(ws + WS_LG);
    float lbv = 0.f;
    if (layer > 0) lbv = __builtin_amdgcn_rcpf(1.f + __expf(hl[h * 128 + k] - hl[512 + h * 128 + k]));
    const float oml = 1.f - lbv;
    f32x4 S[8];
#pragma unroll
    for (int kb = 0; kb < 8; ++kb) S[kb] = (f32x4){0.f, 0.f, 0.f, 0.f};
    float z[16]; unsigned short qv[16]; u32x4 hv[2];
#define HL_E0(gg) (((size_t)(gg) * 64 + tq * 16) * 512 + h * 128 + k)
#define HL_LOADZ(gg) do { const size_t e_ = HL_E0(gg); _Pragma("unroll") for (int i = 0; i < 16; ++i) z[i] = HF[e_ + (size_t)i * 512]; } while (0)
#define HL_LOADQ(gg) do { const size_t e_ = HL_E0(gg); _Pragma("unroll") for (int i = 0; i < 16; ++i) qv[i] = QE[e_ + (size_t)i * 512]; } while (0)
#define HL_LOADH(gg) do { const bf16_t* hi_ = HIb + (size_t)(gg) * 64 * 512 + h * 128; _Pragma("unroll") for (int j = 0; j < 2; ++j) { const int idx = tid + 512 * j; hv[j] = *(const u32x4*)(hi_ + (size_t)(idx >> 4) * 512 + (idx & 15) * 8); } } while (0)
    HL_LOADZ(g0); HL_LOADQ(g0); HL_LOADH(g0);
    for (int c = 0; c < SEGC; ++c) {
        const int g = g0 + c;
        const size_t e0 = HL_E0(g);
        float bc[16], kk[16];
#pragma unroll
        for (int j = 0; j < 2; ++j) { const int idx = tid + 512 * j; *(LAS u32x4*)(lds + HL_VT + (idx >> 4) * 272 + (idx & 15) * 16) = hv[j]; }
        float run = 0.f;
#pragma unroll
        for (int i = 0; i < 16; ++i) { const float zz = z[i]; const float e = __expf(-fabsf(zz)), r = __builtin_amdgcn_rcpf(1.f + e), er = e * r;
            const float lf = (layer == 0) ? (fminf(zz, 0.f) - __logf(1.f + e)) : __logf(lbv + oml * (zz > 0.f ? r : er));
            run += lf; bc[i] = run; kk[i] = oml * (zz > 0.f ? er : r); }
        *(LAS float*)(lds + HL_TOT + (tq * 128 + k) * 4) = run;
        if (c + 1 < SEGC) { HL_LOADZ(g + 1); HL_LOADH(g + 1); }
        __syncthreads();
        const float t0 = *(const LAS float*)(lds + HL_TOT + k * 4), t1 = *(const LAS float*)(lds + HL_TOT + (128 + k) * 4), t2 = *(const LAS float*)(lds + HL_TOT + (256 + k) * 4), t3 = *(const LAS float*)(lds + HL_TOT + (384 + k) * 4);
        const float off = (tq > 0 ? t0 : 0.f) + (tq > 1 ? t1 : 0.f) + (tq > 2 ? t2 : 0.f);
        const float bmid = t0 + t1, blast = (t0 + t1) + (t2 + t3);
        unsigned kdp[8];
        const float cA = __expf(bmid), cB = __expf(blast - bmid);
#pragma unroll
        for (int i = 0; i < 16; i += 2) {
            float kd2[2];
#pragma unroll
            for (int j = 0; j < 2; ++j) { const int ii = i + j; const float b = bc[ii] + off; const float q = bf2f(qv[ii]);
                const float qt = q * __expf(b - bmid), kt = kk[ii] * __expf(bmid - b), qe = qt * cA, kd = kt * cB;
                const unsigned short qeb = f2bf(qe);
                QE[e0 + (size_t)ii * 512] = qeb; kd2[j] = kd;
                const int t = tq * 16 + ii;
                *(LAS bf16_t*)(lds + HL_QE + t * 272 + k * 2) = qeb;
                *(LAS bf16_t*)(lds + HL_QT + t * 272 + k * 2) = f2bf(qt); *(LAS bf16_t*)(lds + HL_KT + t * 272 + k * 2) = f2bf(kt); }
            kdp[i >> 1] = pk2(kd2[0], kd2[1]);
        }
        { const u32x4 w0 = {kdp[0], kdp[1], kdp[2], kdp[3]}, w1 = {kdp[4], kdp[5], kdp[6], kdp[7]};
          *(LAS u32x4*)(lds + HL_KD + k * 144 + tq * 32) = w0; *(LAS u32x4*)(lds + HL_KD + k * 144 + tq * 32 + 16) = w1; }
        if (tq == 0) { *(LAS float*)(lds + HL_D + k * 4) = __expf(blast); LG[(size_t)(g * 4 + h) * 128 + k] = blast; }
        if (c + 1 < SEGC) HL_LOADQ(g + 1);
        __syncthreads();
        { const int mt = wave >> 1;
#pragma unroll
          for (int nn = 0; nn < 2; ++nn) { const int nt = 2 * (wave & 1) + nn; f32x4 a4 = {0.f, 0.f, 0.f, 0.f};
#pragma unroll
              for (int ks = 0; ks < 4; ++ks) { const bf16x8 a = *(const LAS bf16x8*)(lds + HL_QT + (16 * mt + fr) * 272 + (32 * ks + 8 * fq) * 2);
                  const bf16x8 b = *(const LAS bf16x8*)(lds + HL_KT + (16 * nt + fr) * 272 + (32 * ks + 8 * fq) * 2); a4 = MFMA16(a, b, a4); }
#pragma unroll
              for (int rg = 0; rg < 4; ++rg) { const int t = 16 * mt + 4 * fq + rg, s_ = 16 * nt + fr; const float v = (s_ <= t) ? a4[rg] : 0.f;
                  *(LAS bf16_t*)(lds + HL_AM + t * 144 + s_ * 2) = f2bf(v); } } }
        __syncthreads();
        const int trq = (lane & 15) >> 2, trp = lane & 3;
        bf16x8 vb0, vb1;
        { const u32x2 v0 = ldtr(lds + HL_VT + (8 * fq + trq) * 272 + (16 * wave + 4 * trp) * 2), v1 = ldtr(lds + HL_VT + (8 * fq + 4 + trq) * 272 + (16 * wave + 4 * trp) * 2);
          const u32x2 v2 = ldtr(lds + HL_VT + (32 + 8 * fq + trq) * 272 + (16 * wave + 4 * trp) * 2), v3 = ldtr(lds + HL_VT + (32 + 8 * fq + 4 + trq) * 272 + (16 * wave + 4 * trp) * 2);
          const u32x4 bw0 = {v0.x, v0.y, v1.x, v1.y}, bw1 = {v2.x, v2.y, v3.x, v3.y}; vb0 = __builtin_bit_cast(bf16x8, bw0); vb1 = __builtin_bit_cast(bf16x8, bw1); }
        bf16x8 sb[4];
#pragma unroll
        for (int ks = 0; ks < 4; ++ks) { u32x4 w; w.x = pk2(S[2 * ks][0], S[2 * ks][1]); w.y = pk2(S[2 * ks][2], S[2 * ks][3]); w.z = pk2(S[2 * ks + 1][0], S[2 * ks + 1][1]); w.w = pk2(S[2 * ks + 1][2], S[2 * ks + 1][3]);
            sb[ks] = __builtin_bit_cast(bf16x8, w); }
#pragma unroll
        for (int mt = 0; mt < 4; ++mt) {
            const bf16x8 am0 = *(const LAS bf16x8*)(lds + HL_AM + (16 * mt + fr) * 144 + (8 * fq) * 2), am1 = *(const LAS bf16x8*)(lds + HL_AM + (16 * mt + fr) * 144 + (32 + 8 * fq) * 2);
            u32x2 alo[4], ahi[4];
#pragma unroll
            for (int ks = 0; ks < 4; ++ks) { alo[ks] = *(const LAS u32x2*)(lds + HL_QE + (16 * mt + fr) * 272 + (32 * ks + 4 * fq) * 2); ahi[ks] = *(const LAS u32x2*)(lds + HL_QE + (16 * mt + fr) * 272 + (32 * ks + 16 + 4 * fq) * 2); }
            f32x4 o4 = {0.f, 0.f, 0.f, 0.f};
            o4 = MFMA16(am0, vb0, o4); o4 = MFMA16(am1, vb1, o4);
#pragma unroll
            for (int ks = 0; ks < 4; ++ks) { const u32x4 aw = {alo[ks].x, alo[ks].y, ahi[ks].x, ahi[ks].y}; o4 = MFMA16(__builtin_bit_cast(bf16x8, aw), sb[ks], o4); }
#pragma unroll
            for (int rg = 0; rg < 4; ++rg) HF[((size_t)g * 64 + 16 * mt + 4 * fq + rg) * 512 + h * 128 + 16 * wave + fr] = o4[rg];
        }
#pragma unroll
        for (int hf = 0; hf < 2; ++hf) { f32x4 d4[4]; bf16x8 a0[4], a1[4];
#pragma unroll
            for (int q = 0; q < 4; ++q) { const int kb = 4 * hf + q; d4[q] = *(const LAS f32x4*)(lds + HL_D + (16 * kb + 4 * fq) * 4);
                a0[q] = *(const LAS bf16x8*)(lds + HL_KD + (16 * kb + fr) * 144 + (8 * fq) * 2); a1[q] = *(const LAS bf16x8*)(lds + HL_KD + (16 * kb + fr) * 144 + (32 + 8 * fq) * 2); }
#pragma unroll
            for (int q = 0; q < 4; ++q) { const int kb = 4 * hf + q; S[kb] = S[kb] * d4[q]; S[kb] = MFMA16(a0[q], vb0, S[kb]); S[kb] = MFMA16(a1[q], vb1, S[kb]); } }
        __syncthreads();
    }
#pragma unroll
    for (int kb = 0; kb < 8; ++kb)
#pragma unroll
        for (int rg = 0; rg < 4; ++rg) Sout[(size_t)(16 * kb + 4 * fq + rg) * 128 + 16 * wave + fr] = S[kb][rg];
#undef HL_E0
#undef HL_LOADZ
#undef HL_LOADQ
#undef HL_LOADH
}

constexpr int AT_BUF = 9216 + 9216 + 256, AT_PFX = 2 * AT_BUF, AT_PUB = AT_PFX + 528, AT_RED = AT_PUB + 528;
constexpr float AT_THR = -160.f;
__device__ __forceinline__ int crow(int r, int hi) { return (r & 3) + 8 * (r >> 2) + 4 * hi; }
__device__ __forceinline__ void attn_tile(LAS unsigned char* lds, int bo, const bf16x8 (&qr)[4], f32x16& o0, f32x16& o1, float& mrun, float& lrun, int t, int qlo, int r32, int hi) {
    f32x16 p0, p1;
#pragma unroll
    for (int g = 0; g < 4; ++g) { const f32x4 x0 = *(const LAS f32x4*)(lds + bo + 18432 + (8 * g + 4 * hi) * 4), x1 = *(const LAS f32x4*)(lds + bo + 18432 + (32 + 8 * g + 4 * hi) * 4);
#pragma unroll
        for (int i = 0; i < 4; ++i) { p0[4 * g + i] = x0[i]; p1[4 * g + i] = x1[i]; } }
    { bf16x8 k0[4], k1[4];
#pragma unroll
      for (int d0 = 0; d0 < 4; ++d0) { k0[d0] = *(const LAS bf16x8*)(lds + bo + r32 * 144 + (16 * d0 + 8 * hi) * 2); k1[d0] = *(const LAS bf16x8*)(lds + bo + (32 + r32) * 144 + (16 * d0 + 8 * hi) * 2); }
      __builtin_amdgcn_sched_barrier(0);
#pragma unroll
      for (int d0 = 0; d0 < 4; ++d0) { p0 = MFMA32(k0[d0], qr[d0], p0); p1 = MFMA32(k1[d0], qr[d0], p1); } }
    if (64 * t + 63 > qlo) {
        const int qp = qlo + r32, kb = 64 * t + 4 * hi;
#pragma unroll
        for (int r = 0; r < 16; ++r) { const int kv = kb + (r & 3) + 8 * (r >> 2); if (kv > qp) p0[r] = -INFINITY; if (kv + 32 > qp) p1[r] = -INFINITY; }
    }
    float mx = fmaxf(p0[0], p1[0]);
#pragma unroll
    for (int r = 1; r < 16; ++r) mx = fmaxf(mx, fmaxf(p0[r], p1[r]));
    mx = fmaxf(mx, __shfl_xor(mx, 32));
    if (__any(mx > mrun)) {
        const float mnew = fmaxf(mrun, mx);
        const float alpha = __builtin_amdgcn_exp2f(mrun - mnew);
        mrun = mnew; lrun *= alpha;
#pragma unroll
        for (int r = 0; r < 16; ++r) { o0[r] *= alpha; o1[r] *= alpha; }
    }
    float rsum = 0.f;
#pragma unroll
    for (int r = 0; r < 16; ++r) { p0[r] = __builtin_amdgcn_exp2f(p0[r] - mrun); p1[r] = __builtin_amdgcn_exp2f(p1[r] - mrun); rsum += p0[r] + p1[r]; }
    lrun += rsum;
    const int trq = (r32 & 15) >> 2, trp = r32 & 3, blk = r32 >> 4;
    u32x2 va[4][2][2];
#pragma unroll
    for (int st = 0; st < 4; ++st) { const int kvb = 16 * st + 4 * hi;
#pragma unroll
        for (int d0 = 0; d0 < 2; ++d0) { va[st][d0][0] = ldtr(lds + bo + 9216 + (kvb + trq) * 144 + (32 * d0 + 16 * blk + 4 * trp) * 2); va[st][d0][1] = ldtr(lds + bo + 9216 + (kvb + 8 + trq) * 144 + (32 * d0 + 16 * blk + 4 * trp) * 2); } }
    __builtin_amdgcn_sched_barrier(0);
#pragma unroll
    for (int st = 0; st < 4; ++st) {
        u32x4 w;
        if (st < 2) { w.x = pk2(p0[8 * st], p0[8 * st + 1]); w.y = pk2(p0[8 * st + 2], p0[8 * st + 3]); w.z = pk2(p0[8 * st + 4], p0[8 * st + 5]); w.w = pk2(p0[8 * st + 6], p0[8 * st + 7]); }
        else { const int s2 = st - 2; w.x = pk2(p1[8 * s2], p1[8 * s2 + 1]); w.y = pk2(p1[8 * s2 + 2], p1[8 * s2 + 3]); w.z = pk2(p1[8 * s2 + 4], p1[8 * s2 + 5]); w.w = pk2(p1[8 * s2 + 6], p1[8 * s2 + 7]); }
        const bf16x8 pf = __builtin_bit_cast(bf16x8, w);
        { const u32x4 aw = {va[st][0][0].x, va[st][0][0].y, va[st][0][1].x, va[st][0][1].y}; o0 = MFMA32(__builtin_bit_cast(bf16x8, aw), pf, o0); }
        { const u32x4 aw = {va[st][1][0].x, va[st][1][0].y, va[st][1][1].x, va[st][1][1].y}; o1 = MFMA32(__builtin_bit_cast(bf16x8, aw), pf, o1); }
    }
}
__device__ __forceinline__ void attn_unit(LAS unsigned char* lds, const bf16_t* Qp, const bf16_t* Kp, const bf16_t* VTp, int vpitch, const float* CLp, const float* BTp, const float* CMp, const float* KNp,
                                          int NT, int nqw, int qpos0, int cref_tile, bf16_t* Yp, const float* Kc, const float* Vc, int ncache, int tid, int lane, int wave) {
    size_t zo = 0;
    asm volatile("" : "+v"(tid), "+v"(lane), "+s"(zo), "+s"(vpitch), "+s"(NT), "+s"(nqw), "+s"(qpos0), "+s"(cref_tile), "+s"(ncache));
    Qp += zo; Kp += zo; VTp += zo; CLp += zo; BTp += zo; CMp += zo; KNp += zo; Yp += zo; Kc += zo; Vc += zo;
    const int r32 = lane & 31, hi = lane >> 5;
    LAS float* Pfx = (LAS float*)(lds + AT_PFX); LAS float* PUB = (LAS float*)(lds + AT_PUB); LAS float* red = (LAS float*)(lds + AT_RED);
    const int srow = tid >> 3, sch = tid & 7;
    float bt_a = 0.f, bt_b = 0.f, kn_a = 0.f, kn_b = 0.f, cm_a = 0.f, cm_b = 0.f;
    if (wave == 0) {
        if (lane < NT) { bt_a = BTp[(size_t)lane * 8]; kn_a = KNp[(size_t)lane * 8]; cm_a = CMp[(size_t)lane * 8]; }
        if (lane + 64 < NT) { bt_b = BTp[(size_t)(lane + 64) * 8]; kn_b = KNp[(size_t)(lane + 64) * 8]; cm_b = CMp[(size_t)(lane + 64) * 8]; }
    }
    bf16x8 qr[4];
    const bool active = wave < nqw;
    if (active) {
#pragma unroll
        for (int d0 = 0; d0 < 4; ++d0) qr[d0] = *(const bf16x8*)(Qp + (size_t)(32 * wave + r32) * 512 + 16 * d0 + 8 * hi);
    } else {
#pragma unroll
        for (int d0 = 0; d0 < 4; ++d0) qr[d0] = (bf16x8){0, 0, 0, 0, 0, 0, 0, 0};
    }
    u32x4 pkA, pvA, pkB, pvB; float pbA = 0.f, pbB = 0.f;
#define AT_ISSUE(PK, PV, PB, t) { if ((t) < ncache) { const size_t co_ = ((size_t)(64 * (t) + srow)) * 512 + sch * 8;     \
            const f32x4 ka_ = *(const f32x4*)(Kc + co_), kc_ = *(const f32x4*)(Kc + co_ + 4), va_ = *(const f32x4*)(Vc + co_), vc_ = *(const f32x4*)(Vc + co_ + 4); \
            PK = (u32x4){pk2(ka_[0], ka_[1]), pk2(ka_[2], ka_[3]), pk2(kc_[0], kc_[1]), pk2(kc_[2], kc_[3])}; PV = (u32x4){pk2(va_[0], va_[1]), pk2(va_[2], va_[3]), pk2(vc_[0], vc_[1]), pk2(vc_[2], vc_[3])}; } \
        else { PK = *(const u32x4*)(Kp + ((size_t)(64 * (t) + srow)) * 512 + sch * 8); PV = *(const u32x4*)(VTp + ((size_t)(64 * (t) + srow)) * 512 + sch * 8); } \
        if (tid < 64) PB = CLp[(size_t)(64 * (t) + tid) * 8]; }
#define AT_COMMIT(PK, PV, PB, t, bo) { *(LAS u32x4*)(lds + (bo) + srow * 144 + sch * 16) = PK; *(LAS u32x4*)(lds + (bo) + 9216 + srow * 144 + sch * 16) = PV; \
        if (tid < 64) *(LAS float*)(lds + (bo) + 18432 + tid * 4) = (cref - Pfx[(t)] - PB) * LOG2E; }
    AT_ISSUE(pkB, pvB, pbB, NT - 1);
    if (NT >= 2) AT_ISSUE(pkA, pvA, pbA, NT - 2);
    u32x2 gte[4][2];
    { const bf16_t* yrow_ = Yp + (size_t)(32 * (active ? wave : 0) + r32) * 1024;
#pragma unroll
      for (int g = 0; g < 4; ++g) { gte[g][0] = *(const u32x2*)(yrow_ + 8 * g + 4 * hi); gte[g][1] = *(const u32x2*)(yrow_ + 32 + 8 * g + 4 * hi); } }
    float qn2 = 0.f;
#pragma unroll
    for (int d0 = 0; d0 < 4; ++d0) qn2 += sq8(__builtin_bit_cast(u32x4, qr[d0]));
    qn2 += __shfl_xor(qn2, 32);
#pragma unroll
    for (int o = 1; o < 32; o <<= 1) qn2 = fmaxf(qn2, __shfl_xor(qn2, o));
    if (lane == 0) red[wave] = qn2;
    __syncthreads();
    if (wave == 0) {
        float q2 = red[0];
#pragma unroll
        for (int w = 1; w < 8; ++w) q2 = fmaxf(q2, red[w]);
        const float Qmax = sqrtf(q2) * 1.002f;
        const float sa = wave_scan_incl(bt_a, lane), ta = __shfl(sa, 63), sb = wave_scan_incl(bt_b, lane);
        const float ea = sa - bt_a, eb = sb + ta - bt_b;
        Pfx[lane] = ea; Pfx[lane + 64] = eb;
        const float c0 = __shfl(ea, cref_tile & 63), c1 = __shfl(eb, cref_tile & 63);
        const float crf = (cref_tile < 64) ? c0 : c1;
        const float ua = (lane < NT) ? (kn_a * Qmax + (crf - ea - cm_a) * LOG2E) : -INFINITY;
        const float ub = (lane + 64 < NT) ? (kn_b * Qmax + (crf - eb - cm_b) * LOG2E) : -INFINITY;
        const float pa = wave_scan_max(ua, lane), tm = __shfl(pa, 63), pb = fmaxf(wave_scan_max(ub, lane), tm);
        PUB[lane] = pa; PUB[lane + 64] = pb;
    }
    __syncthreads();
    const float cref = Pfx[cref_tile];
    AT_COMMIT(pkB, pvB, pbB, NT - 1, 0);
    __syncthreads();
    float mrun = -INFINITY, lrun = 0.f, LB = 0.f;
    f32x16 o0, o1;
#pragma unroll
    for (int r = 0; r < 16; ++r) { o0[r] = 0.f; o1[r] = 0.f; }
    const int qlo = qpos0 + 32 * wave;
    int t = NT - 1, bo = 0;
#define AT_STEP(RCK, RCV, RCB, RNK, RNV, RNB) { \
        if (t < cref_tile && PUB[t] - LB < AT_THR) break;     \
        if (t >= 2) AT_ISSUE(RNK, RNV, RNB, t - 2); \
        if (active && 64 * t <= qlo + 31) attn_tile(lds, bo, qr, o0, o1, mrun, lrun, t, qlo, r32, hi); \
        if (t >= 1) AT_COMMIT(RCK, RCV, RCB, t - 1, AT_BUF - bo); \
        if (t == cref_tile) { const float mm = wave_min(active ? mrun : INFINITY); if (lane == 0) red[8 + wave] = mm; } \
        __syncthreads(); \
        if (t == cref_tile) { float m = red[8]; _Pragma("unroll") for (int w = 1; w < 8; ++w) m = fminf(m, red[8 + w]); LB = m; } \
        if (t == 0) break; \
        --t; bo = AT_BUF - bo; }
    for (;;) {
        AT_STEP(pkA, pvA, pbA, pkB, pvB, pbB)
        AT_STEP(pkB, pvB, pbB, pkA, pvA, pbA)
    }
    if (active) {
        const float lt = lrun + __shfl_xor(lrun, 32);
        const float inv = 1.0f / lt;
        bf16_t* yrow = Yp + (size_t)(32 * wave + r32) * 1024;
#pragma unroll
        for (int g = 0; g < 4; ++g) {
            { bf16_t* p = yrow + 8 * g + 4 * hi; const u32x2 gt = gte[g][0]; u32x2 w;
              w.x = pk2(o0[4 * g] * inv * bflo(gt.x), o0[4 * g + 1] * inv * bfhi(gt.x)); w.y = pk2(o0[4 * g + 2] * inv * bflo(gt.y), o0[4 * g + 3] * inv * bfhi(gt.y)); *(u32x2*)p = w; }
            { bf16_t* p = yrow + 32 + 8 * g + 4 * hi; const u32x2 gt = gte[g][1]; u32x2 w;
              w.x = pk2(o1[4 * g] * inv * bflo(gt.x), o1[4 * g + 1] * inv * bfhi(gt.x)); w.y = pk2(o1[4 * g + 2] * inv * bflo(gt.y), o1[4 * g + 3] * inv * bfhi(gt.y)); *(u32x2*)p = w; }
        }
    }
    __syncthreads();
#undef AT_ISSUE
#undef AT_COMMIT
#undef AT_STEP
}

__global__ void __launch_bounds__(512, 2) fwd_megakernel(Params P) {
    extern __shared__ __attribute__((aligned(16))) unsigned char lds_raw[];
    LAS unsigned char* lds = (LAS unsigned char*)lds_raw;
    cg::grid_group grid = cg::this_grid();
    const int tid = threadIdx.x, lane = tid & 63, wave = __builtin_amdgcn_readfirstlane(tid >> 6);
    unsigned char* ws = P.ws;
    volatile LAS int* slot = (volatile LAS int*)(lds + LDS_MISC);
    volatile LAS unsigned* bst = (volatile LAS unsigned*)(lds + LDS_MISC + 64);
    if (tid < 2) bst[tid] = 0u;
    if (blockIdx.x == 0) {
#pragma unroll
        for (int i = 0; i < 4; ++i) ((u32x4*)(ws + WS_CTL))[tid * 4 + i] = (u32x4){0u, 0u, 0u, 0u};
    }
    __syncthreads();

#ifndef NO_P0
    p0_prologue(P, lds, tid, lane, wave);
#endif
    grid.sync();
    const XcdBarrier xbar = xcd_barrier_post((unsigned*)(ws + WS_BAR), bst);
#define GSYNC() xcd_barrier(xbar)

#ifndef NREP_L
#define NREP_L 1
#endif
#ifndef NREP_P1
#define NREP_P1 1
#endif
    for (int li = 0; li < DEPTH * NREP_L; ++li) {
      const int layer = li / NREP_L;
      const bool lastrep = (li % NREP_L == NREP_L - 1);
      {
        for (int rep1 = 0; rep1 < NREP_P1; ++rep1) {
            pg8::Gemm g{(const bf16_t*)(ws + WS_XB), (const bf16_t*)(ws + WS_WTIN) + (size_t)layer * NPAD * 1024, MT, NPAD, 1024};
            pg8::StaticOrder S; S.init(MT, NPAD, (int)gridDim.x, (int)blockIdx.x);
            EpiIn E; E.ws = ws; E.out = P.out; E.bfv = P.in[8] + layer * 8; E.layer = layer; E.S = S; E.rsl = lds + LDS_MISC + 1024; E.ui = 0;
#ifndef NO_P1
            pg8::gemm_phase<EpiIn, pg8::StaticOrder, true, true>(lds, g, S, E);
#endif
        }
        GSYNC();
        fox_cumsum(P, lds, layer, tid, lane, wave);
#ifndef NO_PP
        for (int u = (MP / 64) * 4 + blockIdx.x; u < NG * 4; u += gridDim.x) hg_prepass_unit(P, lds, layer, u >> 2, u & 3, tid, lane, wave);
#endif
        unsigned* sdone = (unsigned*)(ws + WS_CTL) + 16 + li;
        asm volatile("s_waitcnt vmcnt(0)" ::: "memory");
        __syncthreads();
        if (tid == 0) { __builtin_amdgcn_fence(__ATOMIC_RELEASE, "agent"); asm volatile("s_waitcnt vmcnt(0)" ::: "memory"); __hip_atomic_fetch_add(sdone, 1u, __ATOMIC_RELAXED, __HIP_MEMORY_SCOPE_AGENT); }
        bool stats_ready = false;
#ifndef PROBE_CUT
#define PROBE_CUT 9
#endif
        if (lastrep || PROBE_CUT >= 2) {
            unsigned* cnt = (unsigned*)(ws + WS_CTL) + li;
            constexpr int T_HP = 32 * NSEG, T_AP = T_HP + 2048, T_AS = T_AP + 128, T_HSM = T_AS + 64, T_SO = T_HSM + 16, T_FX = T_SO + 32 * NSEG;
            unsigned* segdone = (unsigned*)(ws + WS_CTL) + 32 + 32 * li;
            for (;;) {
                if (tid == 0) *slot = (int)atomicAdd(cnt, 1u);
                __syncthreads();
                const int pt = *slot;
                __syncthreads();
                if (pt >= T_FX) break;
                int tk;
                { constexpr int A1 = 1408, P1_ = T_HP + A1, P2_ = P1_ + 32 * NSEG, P3_ = P2_ + 128, P4_ = P3_ + 64, P5_ = P4_ + 16;
                  if (pt < P1_) tk = pt;
                  else if (pt < P2_) tk = T_SO + (pt - P1_);
                  else if (pt < P3_) tk = T_AP + (pt - P2_);
                  else if (pt < P4_) tk = T_AS + (pt - P3_);
                  else if (pt < P5_) tk = T_HSM + (pt - P4_);
                  else tk = T_HP + A1 + (pt - P5_); }
                if (tk >= T_HP && !stats_ready) {
                    if (tid == 0) {
                        for (unsigned spin = 0; spin < (1u << 20); ++spin) { if (__hip_atomic_load(sdone, __ATOMIC_RELAXED, __HIP_MEMORY_SCOPE_AGENT) >= gridDim.x) break; __builtin_amdgcn_s_sleep(4); }
                        __builtin_amdgcn_fence(__ATOMIC_ACQUIRE, "agent"); asm volatile("s_waitcnt vmcnt(0)" ::: "memory"); }
                    __syncthreads();
                    stats_ready = true;
                }
                unsigned* sampdone = (unsigned*)(ws + WS_CTL) + 96 + 4 * li;
                if (tk >= T_HSM && tk < T_SO) {
                    const int j = (tk - T_HSM) >> 2, pn = (tk - T_HSM) & 3;
                    if (tid == 0) {
                        for (unsigned spin = 0; spin < (1u << 20); ++spin) { if (__hip_atomic_load(sampdone + j, __ATOMIC_RELAXED, __HIP_MEMORY_SCOPE_AGENT) >= 48u) break; __builtin_amdgcn_s_sleep(4); }
                        __builtin_amdgcn_fence(__ATOMIC_ACQUIRE, "agent"); asm volatile("s_waitcnt vmcnt(0)" ::: "memory"); }
                    __syncthreads();
                    pg8::Gemm g1{(const bf16_t*)(ws + WS_YC), (const bf16_t*)(ws + WS_WTOUT) + (size_t)layer * 1024 * 1024, MT, 1024, 1024};
                    OneUnit S1; S1.pm = MP / 256 + j; S1.pn = pn;
                    EpiOut E1; E1.XB = (bf16_t*)(ws + WS_XB); E1.SS = (float*)(ws + WS_SS);
                    pg8::gemm_phase<EpiOut, OneUnit, true, true>(lds, g1, S1, E1);
                    __syncthreads();
                    continue;
                }
                if (tk < T_HP || tk >= T_AS) {
                    int g0, nch, h, mode, seg = 0; const float* S0; float* So;
                    if (tk < T_HP) { const int bh = tk >> 3, b = bh >> 2; seg = tk & 7; h = bh & 3; g0 = b * 128 + seg * SEGC; nch = SEGC; S0 = P.in[5]; mode = 1; So = (float*)(ws + WS_LB) + ((size_t)bh * NSEG + seg) * 16384; }
                    else if (tk < T_HSM) { const int bh = tk - T_AS, b = bh >> 2; h = bh & 3; g0 = 1024 + b; nch = 1; mode = 0; S0 = P.in[5] + ((size_t)(layer * DBAT + b) * 4 + h) * 16384; So = P.out + OFF_HS + ((size_t)(layer * DBAT + b) * 4 + h) * 16384; }
                    else { const int idx = tk - T_SO, bh = idx & 31, b = bh >> 2; seg = NSEG - 1 - (idx >> 5); h = bh & 3; g0 = b * 128 + seg * SEGC; nch = SEGC; mode = 2; S0 = P.in[5]; So = P.out + OFF_HP + ((size_t)(layer * NBAT + b) * 4 + h) * 16384;
                        if (tid == 0) {
                            for (unsigned spin = 0; spin < (1u << 20); ++spin) { if (__hip_atomic_load(segdone + bh, __ATOMIC_RELAXED, __HIP_MEMORY_SCOPE_AGENT) >= (unsigned)NSEG) break; __builtin_amdgcn_s_sleep(4); }
                            __builtin_amdgcn_fence(__ATOMIC_ACQUIRE, "agent"); asm volatile("s_waitcnt vmcnt(0)" ::: "memory"); }
                        __syncthreads(); }
#ifndef NO_HS
                    if (mode == 1) {
                        hg_local_unit(P, lds, layer, g0, h, So, tid, lane, wave);
                        asm volatile("s_waitcnt vmcnt(0)" ::: "memory");
                        __syncthreads();
                        if (tid == 0) { __builtin_amdgcn_fence(__ATOMIC_RELEASE, "agent"); asm volatile("s_waitcnt vmcnt(0)" ::: "memory"); __hip_atomic_fetch_add(segdone + (tk >> 3), 1u, __ATOMIC_RELAXED, __HIP_MEMORY_SCOPE_AGENT); }
                    } else { hg_seq_unit(P, lds, layer, g0, nch, h, S0, So, mode, seg, (const float*)(ws + WS_LB) + (size_t)(mode == 2 ? (tk - T_SO) & 31 : 0) * NSEG * 16384, tid, lane, wave);
                        if (mode == 0) {
                            asm volatile("s_waitcnt vmcnt(0)" ::: "memory");
                            __syncthreads();
                            if (tid == 0) { __builtin_amdgcn_fence(__ATOMIC_RELEASE, "agent"); asm volatile("s_waitcnt vmcnt(0)" ::: "memory"); __hip_atomic_fetch_add(sampdone + ((tk - T_AS) >> 4), 1u, __ATOMIC_RELAXED, __HIP_MEMORY_SCOPE_AGENT); }
                        } }
#endif
                } else {
                    const bf16_t *Qp, *Kp, *VTp; const float *CLp, *BTp, *CMp, *KNp, *Kc = P.in[2], *Vc = P.in[3]; bf16_t* Yp; int vpitch, NT, nqw, qpos0, creft, ncache = 0;
                    if (tk < T_AP) {
                        const int idx = tk - T_HP, qb = 31 - (idx >> 6), bh = idx & 63, b = bh >> 3, h = bh & 7;
                        Qp = (const bf16_t*)(ws + WS_QB) + ((size_t)b * SEQ + qb * 256) * 512 + h * 64; Kp = (const bf16_t*)(ws + WS_KBP) + (size_t)b * SEQ * 512 + h * 64;
                        VTp = (const bf16_t*)(ws + WS_VTP) + (size_t)b * SEQ * 512 + h * 64; vpitch = 512; CLp = (const float*)(ws + WS_CL) + ((size_t)layer * KROWS + (size_t)b * SEQ) * 8 + h;
                        BTp = (const float*)(ws + WS_BT) + ((size_t)layer * NKT + b * 128) * 8 + h; CMp = (const float*)(ws + WS_CM) + ((size_t)layer * NKT + b * 128) * 8 + h; KNp = (const float*)(ws + WS_KN) + ((size_t)layer * NKT + b * 128) * 8 + h; NT = 4 * (qb + 1); nqw = 8; qpos0 = qb * 256; creft = qb * 4;
                        Yp = (bf16_t*)(ws + WS_YC) + ((size_t)b * SEQ + qb * 256) * 1024 + h * 64;
                    } else {
                        const int bh = tk - T_AP, b = bh >> 3, h = bh & 7;
                        Qp = (const bf16_t*)(ws + WS_QB) + ((size_t)MP + b * 64) * 512 + h * 64; Kp = (const bf16_t*)(ws + WS_KBS) + ((size_t)layer * KSROWS + (size_t)b * SKV) * 512 + h * 64;
                        VTp = (const bf16_t*)(ws + WS_VTS) + ((size_t)layer * KSROWS + (size_t)b * SKV) * 512 + h * 64; vpitch = 512; CLp = (const float*)(ws + WS_CL) + ((size_t)layer * KROWS + MP + (size_t)b * SKV) * 8 + h;
                        BTp = (const float*)(ws + WS_BT) + ((size_t)layer * NKT + 1024 + b * 33) * 8 + h; CMp = (const float*)(ws + WS_CM) + ((size_t)layer * NKT + 1024 + b * 33) * 8 + h; KNp = (const float*)(ws + WS_KN) + ((size_t)layer * NKT + 1024 + b * 33) * 8 + h; NT = 33; nqw = 2; qpos0 = PAST; creft = 32; ncache = 32; Kc = P.in[2] + ((size_t)(layer * DBAT + b) * PAST) * 512 + h * 64; Vc = P.in[3] + ((size_t)(layer * DBAT + b) * PAST) * 512 + h * 64;
                        Yp = (bf16_t*)(ws + WS_YC) + ((size_t)MP + b * 64) * 1024 + h * 64;
                    }
#ifndef NO_AT
                    attn_unit(lds, Qp, Kp, VTp, vpitch, CLp, BTp, CMp, KNp, NT, nqw, qpos0, creft, Yp, Kc, Vc, ncache, tid, lane, wave);
                    if (tk >= T_AP) {
                        asm volatile("s_waitcnt vmcnt(0)" ::: "memory");
                        __syncthreads();
                        if (tid == 0) { __builtin_amdgcn_fence(__ATOMIC_RELEASE, "agent"); asm volatile("s_waitcnt vmcnt(0)" ::: "memory"); __hip_atomic_fetch_add(sampdone + ((tk - T_AP) >> 5), 1u, __ATOMIC_RELAXED, __HIP_MEMORY_SCOPE_AGENT); }
                    }
#endif
                }
            }
        }
        if (lastrep || PROBE_CUT >= 3) GSYNC();
      }
        if (li % NREP_L == NREP_L - 1) {
            pg8::Gemm g{(const bf16_t*)(ws + WS_YC), (const bf16_t*)(ws + WS_WTOUT) + (size_t)layer * 1024 * 1024, MP, 1024, 1024};
            pg8::StaticOrder S; S.init(MP, 1024, (int)gridDim.x, (int)blockIdx.x);
            EpiOut E; E.XB = (bf16_t*)(ws + WS_XB); E.SS = (float*)(ws + WS_SS);
#ifndef NO_P3
            pg8::gemm_phase<EpiOut, pg8::StaticOrder, true, true>(lds, g, S, E);
#endif
        }
        if (lastrep) GSYNC();
    }
    {
        const float* SS = (const float*)(ws + WS_SS); const float* fg = P.in[12]; float* y = P.out + OFF_Y; const bf16_t* XB = (const bf16_t*)(ws + WS_XB);
        const int gw = blockIdx.x * 8 + wave, NGW = gridDim.x * 8;
        f32x4 g4[4];
#pragma unroll
        for (int j = 0; j < 4; ++j) g4[j] = ((const f32x4*)fg)[4 * lane + j];
        for (int r0 = gw; r0 < MT; r0 += 4 * NGW) {
            float sv[4]; u32x4 v[4][2];
#pragma unroll
            for (int q = 0; q < 4; ++q) { const int r = min(r0 + q * NGW, MT - 1); sv[q] = (lane < 16) ? SS[(size_t)r * 16 + lane] : 0.f;
                v[q][0] = ((const u32x4*)(XB + (size_t)r * 1024))[2 * lane]; v[q][1] = ((const u32x4*)(XB + (size_t)r * 1024))[2 * lane + 1]; }
#pragma unroll
            for (int q = 0; q < 4; ++q) { const int r = r0 + q * NGW; const float rinv = rsqrtf(wave_sum(sv[q]) * (1.0f / 1024.0f) + EPS);
                if (r < MT) {
#pragma unroll
                    for (int j = 0; j < 4; ++j) { const unsigned w0 = v[q][j >> 1][(j & 1) * 2], w1 = v[q][j >> 1][(j & 1) * 2 + 1];
                        f32x4 o; o[0] = bflo(w0) * rinv * g4[j][0]; o[1] = bfhi(w0) * rinv * g4[j][1]; o[2] = bflo(w1) * rinv * g4[j][2]; o[3] = bfhi(w1) * rinv * g4[j][3];
                        ((f32x4*)(y + (size_t)r * 1024))[4 * lane + j] = o; } } }
        }
    }
}

extern "C" void kernel_launch(void* const* d_in, const int* in_sizes, int n_in, void* d_out, int out_size, void* d_ws, size_t ws_size, hipStream_t stream) {
    static int grid = 0;
    if (grid == 0) {
        if (n_in != 13 || (size_t)out_size != OUT_TOTAL || ws_size < WS_END) { fprintf(stderr, "kernel_launch: unexpected sizes n_in=%d out=%d ws=%zu (need %zu)\n", n_in, out_size, ws_size, (size_t)WS_END); grid = -1; return; }
        int dev = 0, cus = 0, per_cu = 0;
        hipGetDevice(&dev); hipDeviceGetAttribute(&cus, hipDeviceAttributeMultiprocessorCount, dev);
        if (hipFuncSetAttribute((const void*)fwd_megakernel, hipFuncAttributeMaxDynamicSharedMemorySize, LDS_BYTES) != hipSuccess) { fprintf(stderr, "kernel_launch: hipFuncSetAttribute failed\n"); grid = -1; return; }
        if (hipOccupancyMaxActiveBlocksPerMultiprocessor(&per_cu, (const void*)fwd_megakernel, 512, LDS_BYTES) != hipSuccess || per_cu < 1) { fprintf(stderr, "kernel_launch: occupancy query says %d\n", per_cu); per_cu = 1; }
        (void)hipGetLastError();
        grid = cus;
    }
    if (grid < 0) return;
    Params p{};
    for (int i = 0; i < 13; ++i) p.in[i] = (const float*)d_in[i];
    p.out = (float*)d_out; p.ws = (unsigned char*)d_ws;
    void* args[] = {&p};
    hipError_t e = hipLaunchCooperativeKernel((const void*)fwd_megakernel, dim3(grid), dim3(512), args, LDS_BYTES, stream);
    if (e != hipSuccess) fprintf(stderr, "cooperative launch failed: %s (grid %d)\n", hipGetErrorString(e), grid);
}
```

```cpp
#include <hip/hip_runtime.h>
#include <hip/hip_cooperative_groups.h>
#include <cstdio>
#include <cstdint>
namespace cg = cooperative_groups;
namespace pg8 {
#define PG8_LAS __attribute__((address_space(3)))
typedef unsigned short bf16_t;
typedef short bf16x8 __attribute__((ext_vector_type(8)));
typedef float f32x4 __attribute__((ext_vector_type(4)));
typedef unsigned u32x4 __attribute__((ext_vector_type(4)));
constexpr int BM = 256, BK = 64, HALF = 128, HTB = HALF * BK * 2  , STAGE_BYTES = 8 * HTB, NXCD = 8, WGM = 8;

__host__ __device__ __forceinline__ int lds_byte(int r, int c) { const int st = (r >> 4) * 2 + (c >> 5), rr = r & 15, cc = c & 31, ob = rr * 64 + cc * 2; return st * 1024 + (ob ^ (((ob >> 9) & 1) << 5)); }
__host__ __device__ __forceinline__ void stage_rc(int b, int& R, int& C) { const int st = b / 1024, sb = b % 1024, swz = sb ^ (((sb >> 9) & 1) << 5); R = (st >> 1) * 16 + swz / 64; C = (st & 1) * 32 + (swz % 64) / 2; }
__host__ __device__ __forceinline__ int perm32(int rho) { const int n = rho >> 4, i = rho & 15; return 8 * (i >> 2) + 4 * n + (i & 3); }

struct Unit { int pm, pn; };
struct Gemm { const bf16_t* A; const bf16_t* Bt; int M, N, K; };

struct StaticOrder {
    int nM, nN, nwg, G, c;
    __host__ __device__ void init(int M, int N, int G_, int c_) { nM = M / BM; nN = N / BM; nwg = nM * nN; G = G_; c = c_; }
    __host__ __device__ bool next(int i, Unit& u) const {
        const long L = (long)i * G + c; if (L >= nwg) return false;
        int wgid = (int)L; { const int q = nwg / NXCD, r = nwg % NXCD, xcd = wgid % NXCD, off = wgid / NXCD; wgid = (xcd < r ? xcd * (q + 1) : r * (q + 1) + (xcd - r) * q) + off; }
        const int nig = WGM * nN, gid = wgid / nig, fm = gid * WGM, gsz = (nM - fm) < WGM ? (nM - fm) : WGM;
        u.pm = fm + ((wgid % nig) % gsz); u.pn = (wgid % nig) / gsz; return true;
    }
    __device__ __forceinline__ void a_ready(const Unit&) const {}
    __device__ __forceinline__ void done(const Unit&) const {}
};

template <class Epi, class Sched, bool ALIGN_EPI = false, bool SP2 = false>
__device__ __forceinline__ void gemm_phase(PG8_LAS unsigned char* lds, const Gemm g, const Sched& S, const Epi& E) {
    int tid_ = threadIdx.x; asm volatile("" : "+v"(tid_));
    const int tid = tid_, wid = __builtin_amdgcn_readfirstlane(tid >> 6), lane = tid & 63, wr = wid >> 2, wc = wid & 3, fr = lane & 15, fq = lane >> 4;
    const int K = g.K, nt = K / BK;
    unsigned voffA[2], voffB[2];
#pragma unroll
    for (int i = 0; i < 2; ++i) { int R, C; stage_rc(tid * 16 + i * 8192, R, C); const int Rb = Epi::PERM ? ((R & ~31) + perm32(R & 31)) : R;
        voffA[i] = (unsigned)(R * K + C) * 2u; voffB[i] = (unsigned)(Rb * K + C) * 2u; }
    const size_t kstep = (size_t)(BK * 2);
    const size_t hstep = (size_t)HALF * K * 2;
    const size_t tstep = 2 * hstep;
    const unsigned ldsw = (unsigned)wid * 1024u;
    const int aoff = lds_byte(wr * 64 + fr, fq * 8), boff = lds_byte(wc * 32 + fr, fq * 8);
#define PG8_SA(b, h) (((b) * 2 + (h)) * HTB)
#define PG8_SB(b, h) ((4 + (b) * 2 + (h)) * HTB)
#define PG8_STAGE(bufoff, gbase, voff) do { _Pragma("unroll") for (int _i = 0; _i < 2; ++_i) \
        __builtin_amdgcn_global_load_lds((const unsigned*)((const char*)(gbase) + (voff)[_i]), (PG8_LAS unsigned*)(lds + (bufoff) + ldsw + _i * 8192), 16, 0, 0); } while (0)
#define PG8_LDA(dst, b, h) do { _Pragma("unroll") for (int m = 0; m < 4; ++m) _Pragma("unroll") for (int k = 0; k < 2; ++k) dst[m][k] = *(const PG8_LAS bf16x8*)(lds + PG8_SA(b, h) + aoff + m * 2048 + k * 1024); } while (0)
#define PG8_LDB(dst, b, h) do { _Pragma("unroll") for (int n = 0; n < 2; ++n) _Pragma("unroll") for (int k = 0; k < 2; ++k) dst[n][k] = *(const PG8_LAS bf16x8*)(lds + PG8_SB(b, h) + boff + n * 2048 + k * 1024); } while (0)
#define PG8_MMA(ai, bj, At, Bt) do { __builtin_amdgcn_s_setprio(1); _Pragma("unroll") for (int m = 0; m < 4; ++m) _Pragma("unroll") for (int n = 0; n < 2; ++n) _Pragma("unroll") for (int k = 0; k < 2; ++k) \
        acc[ai][bj][m][n] = __builtin_amdgcn_mfma_f32_16x16x32_bf16(Bt[n][k], At[m][k], acc[ai][bj][m][n], 0, 0, 0); __builtin_amdgcn_s_setprio(0); } while (0)
#define PG8_WAIT_V(n) asm volatile("s_waitcnt vmcnt(" #n ")" ::: "memory")
#define PG8_WAIT_L(n) asm volatile("s_waitcnt lgkmcnt(" #n ")" ::: "memory")
#define PG8_BAR __builtin_amdgcn_s_barrier()
#define PG8_SCHED __builtin_amdgcn_sched_barrier(0)
    Unit cur, nxt; int ui = 0;
    if (!S.next(0, cur)) return;
    f32x4 acc[2][2][4][2];
#pragma unroll
    for (int a = 0; a < 2; ++a)
#pragma unroll
        for (int b = 0; b < 2; ++b)
#pragma unroll
            for (int m = 0; m < 4; ++m)
#pragma unroll
                for (int n = 0; n < 2; ++n) acc[a][b][m][n] = (f32x4){0.f, 0.f, 0.f, 0.f};
    bf16x8 At[4][2], B0[2][2], B1[2][2];
    const char* cA = (const char*)g.A + (size_t)cur.pm * tstep; const char* cB = (const char*)g.Bt + (size_t)cur.pn * tstep;
    S.a_ready(cur);
    if constexpr (SP2) {
        PG8_STAGE(PG8_SB(0, 0), cB, voffB); PG8_STAGE(PG8_SB(0, 1), cB + hstep, voffB); PG8_STAGE(PG8_SA(0, 0), cA, voffA); PG8_STAGE(PG8_SA(0, 1), cA + hstep, voffA);
        if (wr == 1) PG8_BAR;
        PG8_WAIT_V(2); PG8_BAR;
        PG8_STAGE(PG8_SB(1, 0), cB + kstep, voffB); PG8_STAGE(PG8_SA(1, 0), cA + kstep, voffA); PG8_STAGE(PG8_SB(1, 1), cB + hstep + kstep, voffB);
        PG8_WAIT_V(6); PG8_BAR;
    } else {
        PG8_STAGE(PG8_SB(0, 0), cB, voffB); PG8_STAGE(PG8_SA(0, 0), cA, voffA); PG8_STAGE(PG8_SB(0, 1), cB + hstep, voffB); PG8_STAGE(PG8_SA(0, 1), cA + hstep, voffA);
        if (wr == 1) PG8_BAR;
        PG8_WAIT_V(4); PG8_BAR;
        PG8_STAGE(PG8_SB(1, 0), cB + kstep, voffB); PG8_STAGE(PG8_SA(1, 0), cA + kstep, voffA); PG8_STAGE(PG8_SB(1, 1), cB + hstep + kstep, voffB);
        PG8_WAIT_V(6); PG8_BAR;
    }
    for (;;) {
        const bool has_next = S.next(ui + 1, nxt);
        const char* nA = has_next ? (const char*)g.A + (size_t)nxt.pm * tstep : cA; const char* nB = has_next ? (const char*)g.Bt + (size_t)nxt.pn * tstep : cB;
        for (int t = 0; t < nt; t += 2) {
            const bool last = (t == nt - 2);
            const char* a1 = cA + (size_t)(t + 1) * kstep;
            const char* a2 = last ? nA : cA + (size_t)(t + 2) * kstep; const char* b2 = last ? nB : cB + (size_t)(t + 2) * kstep;
            const char* a3 = a2 + kstep; const char* b3 = b2 + kstep;
            if (last && has_next) S.a_ready(nxt);
            if constexpr (SP2) {
            PG8_LDB(B0, 0, 0); PG8_LDB(B1, 0, 1); PG8_SCHED; PG8_LDA(At, 0, 0); PG8_STAGE(PG8_SA(1, 1), a1 + hstep, voffA);
            PG8_WAIT_V(8); PG8_WAIT_L(0); PG8_BAR; PG8_MMA(0, 0, At, B0); PG8_MMA(0, 1, At, B1); PG8_BAR; PG8_SCHED;
            PG8_LDA(At, 0, 1); PG8_STAGE(PG8_SB(0, 0), b2, voffB); PG8_STAGE(PG8_SB(0, 1), b2 + hstep, voffB); PG8_STAGE(PG8_SA(0, 0), a2, voffA);
            PG8_WAIT_V(8); PG8_WAIT_L(0); PG8_BAR; PG8_MMA(1, 0, At, B0); PG8_MMA(1, 1, At, B1); PG8_BAR; PG8_SCHED;
            PG8_LDB(B0, 1, 0); PG8_LDB(B1, 1, 1); PG8_SCHED; PG8_LDA(At, 1, 0); PG8_STAGE(PG8_SA(0, 1), a2 + hstep, voffA);
            PG8_WAIT_V(8); PG8_WAIT_L(0); PG8_BAR; PG8_MMA(0, 0, At, B0); PG8_MMA(0, 1, At, B1); PG8_BAR; PG8_SCHED;
            PG8_LDA(At, 1, 1); PG8_STAGE(PG8_SB(1, 0), b3, voffB); PG8_STAGE(PG8_SB(1, 1), b3 + hstep, voffB); PG8_STAGE(PG8_SA(1, 0), a3, voffA);
            PG8_WAIT_V(8); PG8_WAIT_L(0); PG8_BAR; PG8_MMA(1, 0, At, B0); PG8_MMA(1, 1, At, B1); PG8_BAR; PG8_SCHED;
            } else {
            PG8_LDB(B0, 0, 0); PG8_SCHED; PG8_LDA(At, 0, 0); PG8_STAGE(PG8_SA(1, 1), a1 + hstep, voffA);
            PG8_WAIT_L(8); PG8_BAR; PG8_WAIT_L(0); PG8_MMA(0, 0, At, B0); PG8_BAR; PG8_SCHED;
            PG8_LDB(B1, 0, 1); PG8_STAGE(PG8_SB(0, 0), b2, voffB);
            PG8_BAR; PG8_WAIT_L(0); PG8_MMA(0, 1, At, B1); PG8_BAR;
            PG8_LDA(At, 0, 1); PG8_STAGE(PG8_SA(0, 0), a2, voffA);
            PG8_BAR; PG8_WAIT_L(0); PG8_MMA(1, 0, At, B0); PG8_BAR; PG8_SCHED;
            PG8_STAGE(PG8_SB(0, 1), b2 + hstep, voffB);
            PG8_WAIT_V(6); PG8_BAR; PG8_MMA(1, 1, At, B1); PG8_BAR;
            PG8_LDB(B0, 1, 0); PG8_SCHED; PG8_LDA(At, 1, 0); PG8_STAGE(PG8_SA(0, 1), a2 + hstep, voffA);
            PG8_WAIT_L(8); PG8_BAR; PG8_WAIT_L(0); PG8_MMA(0, 0, At, B0); PG8_BAR; PG8_SCHED;
            PG8_LDB(B1, 1, 1); PG8_STAGE(PG8_SB(1, 0), b3, voffB);
            PG8_BAR; PG8_WAIT_L(0); PG8_MMA(0, 1, At, B1); PG8_BAR;
            PG8_LDA(At, 1, 1); PG8_STAGE(PG8_SA(1, 0), a3, voffA);
            PG8_BAR; PG8_WAIT_L(0); PG8_MMA(1, 0, At, B0); PG8_BAR; PG8_SCHED;
            PG8_STAGE(PG8_SB(1, 1), b3 + hstep, voffB);
            PG8_WAIT_V(6); PG8_BAR; PG8_MMA(1, 1, At, B1); PG8_BAR;
            }
        }
        if constexpr (ALIGN_EPI) { if (wr == 0) PG8_BAR; }
        if constexpr (!Epi::AFTER_DRAIN) { E(acc, cur, wr, wc, fr, fq); S.done(cur); }
        if (!has_next) break;
#pragma unroll
        for (int a = 0; a < 2; ++a)
#pragma unroll
            for (int b = 0; b < 2; ++b)
#pragma unroll
                for (int m = 0; m < 4; ++m)
#pragma unroll
                    for (int n = 0; n < 2; ++n) acc[a][b][m][n] = (f32x4){0.f, 0.f, 0.f, 0.f};
        cur = nxt; cA = nA; cB = nB; ++ui;
        if constexpr (ALIGN_EPI) { if (wr == 1) PG8_BAR; }
    }
    PG8_WAIT_V(0);
    if constexpr (!ALIGN_EPI) { if (wr == 0) PG8_BAR; }
    PG8_BAR;
    if constexpr (Epi::AFTER_DRAIN) { E.fused(acc, cur, wr, wc, fr, fq, lds, wid, lane); S.done(cur); }
#undef PG8_SA
#undef PG8_SB
#undef PG8_STAGE
#undef PG8_LDA
#undef PG8_LDB
#undef PG8_MMA
#undef PG8_WAIT_V
#undef PG8_WAIT_L
#undef PG8_BAR
#undef PG8_SCHED
}
}

#define LAS __attribute__((address_space(3)))
typedef unsigned short bf16_t;
typedef short bf16x8 __attribute__((ext_vector_type(8)));
typedef float f32x4 __attribute__((ext_vector_type(4)));
typedef float f32x16 __attribute__((ext_vector_type(16)));
typedef unsigned u32x4 __attribute__((ext_vector_type(4)));
typedef unsigned u32x2 __attribute__((ext_vector_type(2)));

constexpr int DMODEL = 1024, SEQ = 8192, NBAT = 8, DEPTH = 2, DBAT = 16, DSEQ = 64, PAST = 2048;
constexpr int MP = NBAT * SEQ;
constexpr int MS = DBAT * DSEQ;
constexpr int MT = MP + MS;
constexpr int DIN = 4104, NPAD = 4352;
constexpr int SKV = PAST + DSEQ;
constexpr int KSROWS = DBAT * SKV;
constexpr int KROWS = MP + KSROWS;
constexpr int NG = MT / 64;
constexpr int NKT = KROWS / 64;
constexpr float EPS = 1e-6f;
constexpr float LOG2E = 1.4426950408889634f;
constexpr float QSCALE = 0.125f * LOG2E;

constexpr size_t OFF_Y = 0;
constexpr size_t OFF_KP = (size_t)MT * 1024;
constexpr size_t OFF_VP = OFF_KP + (size_t)DEPTH * MP * 512;
constexpr size_t OFF_LP = OFF_VP + (size_t)DEPTH * MP * 512;
constexpr size_t OFF_HP = OFF_LP + (size_t)DEPTH * MP * 8;
constexpr size_t OFF_KS = OFF_HP + (size_t)DEPTH * NBAT * 4 * 16384;
constexpr size_t OFF_VS = OFF_KS + (size_t)DEPTH * MS * 512;
constexpr size_t OFF_LS = OFF_VS + (size_t)DEPTH * MS * 512;
constexpr size_t OFF_HS = OFF_LS + (size_t)DEPTH * MS * 8;
constexpr size_t OUT_TOTAL = OFF_HS + (size_t)DEPTH * DBAT * 4 * 16384;

constexpr size_t al256(size_t x) { return (x + 255) & ~(size_t)255; }
constexpr size_t WS_CTL = 0;
constexpr size_t WS_BAR = 8192;
constexpr size_t WS_WTIN = 32768;
constexpr size_t WS_WTOUT = WS_WTIN + al256((size_t)DEPTH * NPAD * 1024 * 2);
constexpr size_t WS_XB = WS_WTOUT + al256((size_t)DEPTH * 1024 * 1024 * 2);
constexpr size_t WS_YC = WS_XB + al256((size_t)MT * 1024 * 2);
constexpr size_t WS_QB = WS_YC + al256((size_t)MT * 1024 * 2);
constexpr size_t WS_KBP = WS_QB + al256((size_t)MT * 512 * 2);
constexpr size_t WS_KBS = WS_KBP + al256((size_t)MP * 512 * 2);
constexpr size_t WS_VTP = WS_KBS + al256((size_t)DEPTH * KSROWS * 512 * 2);
constexpr size_t WS_VTS = WS_VTP + al256((size_t)MP * 512 * 2);
constexpr size_t WS_QE = WS_VTS + al256((size_t)DEPTH * KSROWS * 512 * 2);
constexpr size_t WS_HF = WS_QE + al256((size_t)MT * 512 * 2);
constexpr size_t WS_KDT = WS_HF + al256((size_t)MT * 512 * 4);
constexpr size_t WS_VTH = WS_KDT + al256((size_t)NG * 4 * 8192 * 2);
constexpr size_t WS_DG = WS_VTH + al256((size_t)NG * 4 * 8192 * 2);
constexpr size_t WS_CL = WS_DG + al256((size_t)NG * 4 * 128 * 4);
constexpr size_t WS_BT = WS_CL + al256((size_t)DEPTH * KROWS * 8 * 4);
constexpr size_t WS_SS = WS_BT + al256((size_t)DEPTH * NKT * 8 * 4);
constexpr size_t WS_CM = WS_SS + al256((size_t)16 * MT * 4);
constexpr size_t WS_KN = WS_CM + al256((size_t)DEPTH * NKT * 8 * 4);
constexpr size_t WS_LG = WS_KN + al256((size_t)DEPTH * NKT * 8 * 4);
constexpr size_t WS_LB = WS_LG + al256((size_t)NG * 4 * 128 * 4);
constexpr size_t WS_END = WS_LB + al256((size_t)256 * 16384 * 4);

static_assert(WS_END <= (size_t)1073741824, "d_ws map must fit 1 GiB");
constexpr int LDS_BYTES = 147456;
constexpr int LDS_MISC = 131072;

struct Params {
    const float* in[13];
    float* out;
    unsigned char* ws;
};

__device__ __forceinline__ unsigned pk2(float lo, float hi) {
    typedef float f2_t __attribute__((ext_vector_type(2))); typedef __bf16 b2_t __attribute__((ext_vector_type(2)));
    f2_t v = {lo, hi}; b2_t b = __builtin_convertvector(v, b2_t); return __builtin_bit_cast(unsigned, b);
}
__device__ __forceinline__ float bf2f(unsigned short b) { return __uint_as_float((unsigned)b << 16); }
__device__ __forceinline__ float bflo(unsigned w) { return __uint_as_float(w << 16); }
__device__ __forceinline__ float bfhi(unsigned w) { return __uint_as_float(w & 0xffff0000u); }
__device__ __forceinline__ unsigned short f2bf(float f) { return (unsigned short)(pk2(f, 0.f) & 0xffffu); }
__device__ __forceinline__ float fsilu(float x) { return x * __builtin_amdgcn_rcpf(1.f + __expf(-x)); }
__device__ __forceinline__ float logsig(float z) { return fminf(z, 0.f) - __logf(1.f + __expf(-fabsf(z))); }
__device__ __forceinline__ float wave_sum(float v) {
#pragma unroll
    for (int o = 1; o < 64; o <<= 1) v += __shfl_xor(v, o);
    return v;
}
__device__ __forceinline__ float wave_scan_incl(float v, int lane) {
#pragma unroll
    for (int o = 1; o < 64; o <<= 1) { float t = __shfl_up(v, o); if (lane >= o) v += t; }
    return v;
}
__device__ __forceinline__ float wave_scan_max(float v, int lane) {
#pragma unroll
    for (int o = 1; o < 64; o <<= 1) { float t = __shfl_up(v, o); if (lane >= o) v = fmaxf(v, t); }
    return v;
}
__device__ __forceinline__ float wave_min(float v) {
#pragma unroll
    for (int o = 1; o < 64; o <<= 1) v = fminf(v, __shfl_xor(v, o));
    return v;
}
__device__ __forceinline__ float sq8(u32x4 w) {
    float s = 0.f;
#pragma unroll
    for (int i = 0; i < 4; ++i) { const float a = bflo(w[i]), b = bfhi(w[i]); s += a * a + b * b; }
    return s;
}
#define XB_TMO      128
#define XB_XCNT(j)  (256  + 64 * (j))
#define XB_XSUB(j)  (1280 + 64 * (j))
#define XB_XGEN(j)  (2304 + 64 * (j))
#define XB_TOP      3328
#define XB_TOPGEN   3392
#define XCD_BAR_WORDS 3456
#define XB_SPIN_CAP (1u << 18)

__device__ __forceinline__ unsigned xb_ld(unsigned* p)              { return __hip_atomic_load(p, __ATOMIC_RELAXED, __HIP_MEMORY_SCOPE_AGENT); }
__device__ __forceinline__ unsigned xb_add(unsigned* p, unsigned v) { return __hip_atomic_fetch_add(p, v, __ATOMIC_RELAXED, __HIP_MEMORY_SCOPE_AGENT); }
__device__ __forceinline__ unsigned xb_xcc_id() { return (unsigned)__builtin_amdgcn_s_getreg((3 << 11) | 20) & 0xFu; }
#define XB_SPIN(cond, bar) do { unsigned _sp = 0; while (cond) { __builtin_amdgcn_s_sleep(1); \
    if ((++_sp & 255u) == 0u) { if (xb_ld(&(bar)[XB_TMO])) break; if (_sp > XB_SPIN_CAP) { atomicAdd(&(bar)[XB_TMO], 1u); break; } } } } while (0)

struct XcdBarrier {
    unsigned* bar; unsigned x;
    volatile LAS unsigned* st;
};

__device__ __forceinline__ XcdBarrier xcd_barrier_post(unsigned* bar, volatile LAS unsigned* st) {
    XcdBarrier b; b.bar = bar; b.x = xb_xcc_id(); b.st = st;
    if (threadIdx.x == 0) (void)xb_add(&bar[XB_XCNT(b.x)], 1u);
    return b;
}
__device__ __forceinline__ void xcd_barrier_complete(unsigned* bar, unsigned x, unsigned& nloc, unsigned& nx) {
    const unsigned G = gridDim.x * gridDim.y * gridDim.z;
    unsigned sum, cnt, mine, sp = 0u;
    for (;;) {
        sum = 0u; cnt = 0u; mine = 0u;
#pragma unroll
        for (unsigned j = 0; j < 16; ++j) { const unsigned c = xb_ld(&bar[XB_XCNT(j)]); sum += c; cnt += (c > 0u) ? 1u : 0u; mine = (j == x) ? c : mine; }
        if (sum == G) break;
        __builtin_amdgcn_s_sleep(1);
        if ((++sp & 255u) == 0u) { if (xb_ld(&bar[XB_TMO])) break; if (sp > XB_SPIN_CAP) { atomicAdd(&bar[XB_TMO], 1u); break; } }
    }
    nloc = mine > 0u ? mine : 1u; nx = cnt > 0u ? cnt : 1u;
}

__device__ __forceinline__ void xcd_barrier(const XcdBarrier& b) {
    asm volatile("s_waitcnt vmcnt(0)" ::: "memory");
    __syncthreads();
    if (threadIdx.x == 0) {
        unsigned* bar = b.bar;
        __builtin_amdgcn_s_waitcnt(0);
        unsigned nloc = b.st[0], nx = b.st[1];
        if (nloc == 0u) { xcd_barrier_complete(bar, b.x, nloc, nx); b.st[0] = nloc; b.st[1] = nx; }
        const unsigned old = xb_add(&bar[XB_XSUB(b.x)], 1u);
        const unsigned gen = old / nloc;
        if (old + 1u == (gen + 1u) * nloc) {
            __builtin_amdgcn_fence(__ATOMIC_RELEASE, "agent");
            asm volatile("s_waitcnt vmcnt(0)" ::: "memory");
            const unsigned og = xb_add(&bar[XB_TOP], 1u);
            const unsigned tg = og / nx;
            if (og + 1u == (tg + 1u) * nx) xb_add(&bar[XB_TOPGEN], 1u);
            else XB_SPIN(xb_ld(&bar[XB_TOPGEN]) == tg, bar);
            __builtin_amdgcn_fence(__ATOMIC_ACQUIRE, "agent");
            xb_add(&bar[XB_XGEN(b.x)], 1u);
            asm volatile("s_waitcnt vmcnt(0)" ::: "memory");
        } else {
            XB_SPIN(xb_ld(&bar[XB_XGEN(b.x)]) == gen, bar);
            __builtin_amdgcn_fence(__ATOMIC_ACQUIRE, "agent");
            asm volatile("s_waitcnt vmcnt(0)" ::: "memory");
        }
    }
    __syncthreads();
}

typedef short v4i16_t __attribute__((ext_vector_type(4)));
__device__ __forceinline__ u32x2 ldtr(LAS unsigned char* p) { const v4i16_t v = __builtin_amdgcn_ds_read_tr16_b64_v4i16((LAS v4i16_t*)p); return __builtin_bit_cast(u32x2, v); }
#define LDSW() asm volatile("s_waitcnt lgkmcnt(0)" ::: "memory")

__device__ __forceinline__ float row_rs(const float* SS, int r, int fq) {
    const f32x4 p4 = *(const f32x4*)(SS + (size_t)r * 16 + 4 * fq);
    float s = (p4[0] + p4[1]) + (p4[2] + p4[3]);
    s += __shfl_xor(s, 16); s += __shfl_xor(s, 32);
    return rsqrtf(s * (1.0f / 1024.0f) + EPS);
}
struct EpiIn {
    static constexpr bool PERM = true, AFTER_DRAIN = false;
    unsigned char* ws; float* out; const float* bfv; int layer;
    pg8::StaticOrder S; LAS unsigned char* rsl; mutable int ui;
    __device__ __forceinline__ void operator()(const f32x4 (&acc)[2][2][4][2], const pg8::Unit& u, int wr, int wc, int fr, int fq) const {
        unsigned char* ws = this->ws; float* out = this->out; const float* bfv = this->bfv;
        size_t zo = 0;
        asm volatile("" : "+v"(fr), "+v"(fq), "+s"(wr), "+s"(wc), "+s"(zo));
        ws += zo; out += zo; bfv += zo;
        const int cat = u.pn >> 1;
        const int rowb = u.pm * 256 + wr * 64 + fr;
        const bool samp = (u.pm >= MP / 256);
        const float* SS = (const float*)(ws + WS_SS);
        const int cb = (u.pn & 1) * 256 + wc * 32 + 8 * fq;
        LAS float* slot = (LAS float*)(rsl + (wr * 4 + wc) * 512);
        float rs[2][4];
        if (ui == 0) {
#pragma unroll
            for (int ai = 0; ai < 2; ++ai)
#pragma unroll
                for (int m = 0; m < 4; ++m) rs[ai][m] = row_rs(SS, rowb + ai * 128 + m * 16, fq);
        } else {
#pragma unroll
            for (int ai = 0; ai < 2; ++ai)
#pragma unroll
                for (int m = 0; m < 4; ++m) rs[ai][m] = slot[(ai * 4 + m) * 16 + fr];
        }
        pg8::Unit nx; const bool hasn = S.next(ui + 1, nx);
        f32x4 np[8];
        if (hasn) { const int nrowb = nx.pm * 256 + wr * 64 + fr;
#pragma unroll
            for (int q = 0; q < 8; ++q) np[q] = *(const f32x4*)(SS + (size_t)(nrowb + (q >> 2) * 128 + (q & 3) * 16) * 16 + 4 * fq); }
        if (cat == 0 || cat == 3 || cat == 4 || cat == 6 || cat == 7) {
            bf16_t* base; int pitch;
            if (cat == 0) { base = (bf16_t*)(ws + WS_QB); pitch = 512; } else if (cat == 3) { base = (bf16_t*)(ws + WS_YC); pitch = 1024; }
            else if (cat == 4) { base = (bf16_t*)(ws + WS_QE); pitch = 512; } else if (cat == 6) { base = (bf16_t*)(ws + WS_VTH); pitch = 512; } else { base = (bf16_t*)(ws + WS_YC) + 512; pitch = 1024; }
#pragma unroll
            for (int ai = 0; ai < 2; ++ai)
#pragma unroll
                for (int m = 0; m < 4; ++m) { const int r = rowb + ai * 128 + m * 16; const float sc = rs[ai][m];
#pragma unroll
                    for (int bj = 0; bj < 2; ++bj) { u32x4 w;
#pragma unroll
                        for (int n = 0; n < 2; ++n) { f32x4 v = acc[ai][bj][m][n] * sc;
                            if (cat == 0) v = v * QSCALE; else if (cat != 6) { v[0] = fsilu(v[0]); v[1] = fsilu(v[1]); v[2] = fsilu(v[2]); v[3] = fsilu(v[3]); }
                            w[2 * n] = pk2(v[0], v[1]); w[2 * n + 1] = pk2(v[2], v[3]); }
                        *(u32x4*)(base + (size_t)r * pitch + cb + bj * 128) = w; } }
        } else if (cat == 1 || cat == 2) {
#pragma unroll
            for (int ai = 0; ai < 2; ++ai)
#pragma unroll
                for (int m = 0; m < 4; ++m) { const int r = rowb + ai * 128 + m * 16; const float sc = rs[ai][m];
                    float* fo; bf16_t* bo;
                    if (!samp) { fo = out + (cat == 1 ? OFF_KP : OFF_VP) + ((size_t)layer * MP + r) * 512; bo = (bf16_t*)(ws + (cat == 1 ? WS_KBP : WS_VTP)) + (size_t)r * 512; }
                    else { const int q = r - MP; fo = out + (cat == 1 ? OFF_KS : OFF_VS) + ((size_t)layer * MS + q) * 512; bo = (bf16_t*)(ws + (cat == 1 ? WS_KBS : WS_VTS)) + ((size_t)layer * KSROWS + (size_t)((q >> 6) * SKV + PAST + (q & 63))) * 512; }
#pragma unroll
                    for (int bj = 0; bj < 2; ++bj) { u32x4 w;
#pragma unroll
                        for (int n = 0; n < 2; ++n) { const f32x4 v = acc[ai][bj][m][n] * sc; *(f32x4*)(fo + cb + bj * 128 + 4 * n) = v; w[2 * n] = pk2(v[0], v[1]); w[2 * n + 1] = pk2(v[2], v[3]); }
                        *(u32x4*)(bo + cb + bj * 128) = w; } }
        } else if (cat == 5) {
            float* HF = (float*)(ws + WS_HF);
#pragma unroll
            for (int ai = 0; ai < 2; ++ai)
#pragma unroll
                for (int m = 0; m < 4; ++m) { const int r = rowb + ai * 128 + m * 16; const float sc = rs[ai][m];
#pragma unroll
                    for (int bj = 0; bj < 2; ++bj)
#pragma unroll
                        for (int n = 0; n < 2; ++n) *(f32x4*)(HF + (size_t)r * 512 + cb + bj * 128 + n * 4) = acc[ai][bj][m][n] * sc; }
        } else {
            const f32x4 b0 = *(const f32x4*)(bfv), b1 = *(const f32x4*)(bfv + 4);
#pragma unroll
            for (int ai = 0; ai < 2; ++ai)
#pragma unroll
                for (int m = 0; m < 4; ++m) { const int r = rowb + ai * 128 + m * 16; const float sc = rs[ai][m];
                    if (wc == 0 && fq == 0) {
                        const f32x4 v0 = acc[ai][0][m][0] * sc + b0, v1 = acc[ai][0][m][1] * sc + b1; f32x4 o0, o1;
#pragma unroll
                        for (int i = 0; i < 4; ++i) { o0[i] = logsig(v0[i]); o1[i] = logsig(v1[i]); }
                        float* dst = samp ? (out + OFF_LS + ((size_t)layer * MS + (r - MP)) * 8) : (out + OFF_LP + ((size_t)layer * MP + r) * 8);
                        *(f32x4*)(dst) = o0; *(f32x4*)(dst + 4) = o1; } }
        }
        if (hasn) {
#pragma unroll
            for (int q = 0; q < 8; ++q) { float s_ = (np[q][0] + np[q][1]) + (np[q][2] + np[q][3]); s_ += __shfl_xor(s_, 16); s_ += __shfl_xor(s_, 32);
                if (fq == 0) slot[q * 16 + fr] = rsqrtf(s_ * (1.0f / 1024.0f) + EPS); }
        }
        ++ui;
    }
};

struct OneUnit {
    int pm, pn;
    __device__ __forceinline__ bool next(int i, pg8::Unit& u) const { if (i != 0) return false; u.pm = pm; u.pn = pn; return true; }
    __device__ __forceinline__ void a_ready(const pg8::Unit&) const {}
    __device__ __forceinline__ void done(const pg8::Unit&) const {}
};
struct EpiOut {
    static constexpr bool PERM = true, AFTER_DRAIN = false;
    bf16_t* XB;
    float* SS;
    __device__ __forceinline__ void operator()(const f32x4 (&acc)[2][2][4][2], const pg8::Unit& u, int wr, int wc, int fr, int fq) const {
        bf16_t* XB = this->XB; float* SS = this->SS;
        size_t zo = 0;
        asm volatile("" : "+v"(fr), "+v"(fq), "+s"(wr), "+s"(wc), "+s"(zo));
        XB += zo; SS += zo;
        const int rowb = u.pm * 256 + wr * 64 + fr;
        const int cb = u.pn * 256 + wc * 32 + 8 * fq;
#pragma unroll
        for (int ai = 0; ai < 2; ++ai)
#pragma unroll
            for (int m = 0; m < 4; ++m) { const int r = rowb + ai * 128 + m * 16;
                u32x4 rw[2];
#pragma unroll
                for (int bj = 0; bj < 2; ++bj) rw[bj] = *(const u32x4*)(XB + (size_t)r * 1024 + cb + bj * 128);
                float ss = 0.f;
#pragma unroll
                for (int bj = 0; bj < 2; ++bj) { u32x4 w;
#pragma unroll
                    for (int n = 0; n < 2; ++n) { f32x4 v = acc[ai][bj][m][n];
                        v[0] += bflo(rw[bj][2 * n]); v[1] += bfhi(rw[bj][2 * n]); v[2] += bflo(rw[bj][2 * n + 1]); v[3] += bfhi(rw[bj][2 * n + 1]);
                        ss += (v[0] * v[0] + v[1] * v[1]) + (v[2] * v[2] + v[3] * v[3]);
                        w[2 * n] = pk2(v[0], v[1]); w[2 * n + 1] = pk2(v[2], v[3]); }
                    *(u32x4*)(XB + (size_t)r * 1024 + cb + bj * 128) = w; }
                ss += __shfl_xor(ss, 16); ss += __shfl_xor(ss, 32);
                if (fq == 0) SS[(size_t)r * 16 + (u.pn * 4 + wc)] = ss; }
    }
};

__device__ __forceinline__ void tr_item(const float* src, size_t spitch, int nvalid, const float* scale, bf16_t* dst, size_t dpitch, LAS float* scr, int lane) {
    const int n = lane & 31;
#pragma unroll 16
    for (int i = 0; i < 32; ++i) { const int kk = 2 * i + (lane >> 5); float v = (n < nvalid) ? src[(size_t)kk * spitch + n] : 0.f; if (scale) v *= scale[kk]; scr[kk * 33 + n] = v; }
    LDSW();
    const int c = lane & 7;
#pragma unroll
    for (int j = 0; j < 4; ++j) { const int nn = (lane >> 3) + 8 * j; const LAS float* s = scr + (8 * c) * 33 + nn;
        u32x4 o; o.x = pk2(s[0 * 33], s[1 * 33]); o.y = pk2(s[2 * 33], s[3 * 33]); o.z = pk2(s[4 * 33], s[5 * 33]); o.w = pk2(s[6 * 33], s[7 * 33]);
        *(u32x4*)(dst + (size_t)nn * dpitch + 8 * c) = o; }
    LDSW();
}

__device__ __forceinline__ void p0_prologue(const Params& P, LAS unsigned char* lds, int tid, int lane, int wave) {
    unsigned char* ws = P.ws;
    LAS float* scr = (LAS float*)(lds + wave * 16384);
    const bool roleA = wave < 4;
    const int gw = roleA ? (blockIdx.x * 4 + wave) : (blockIdx.x * 4 + (wave - 4)), NGW = gridDim.x * 4;
    const float* w_in = P.in[7]; const float* w_out = P.in[11]; const float* norm_g = P.in[6];
    bf16_t* WTIN = (bf16_t*)(ws + WS_WTIN); bf16_t* WTOUT = (bf16_t*)(ws + WS_WTOUT);
    constexpr int I_IN = 16 * (NPAD / 32), I_OUT = 16 * 32;
    constexpr int NIT = DEPTH * I_IN + DEPTH * I_OUT;
    if (roleA)
    for (int it = gw; it < NIT; it += NGW) {
        int r = it;
        if (r < DEPTH * I_IN) { const int l = r / I_IN; r -= l * I_IN; const int kb = r / (NPAD / 32), nb = r % (NPAD / 32), n0 = nb * 32;
            int sc = n0, nv = 32; if (n0 >= 4104) { sc = 0; nv = 0; } else if (n0 >= 4096) { sc = 1536; nv = 8; } else if (n0 >= 1536) sc = n0 + 8;
            tr_item(w_in + (size_t)l * 1024 * DIN + (size_t)(64 * kb) * DIN + sc, DIN, nv, norm_g + l * 1024 + 64 * kb, WTIN + ((size_t)l * NPAD + n0) * 1024 + 64 * kb, 1024, scr, lane);
            continue; }
        r -= DEPTH * I_IN;
        if (r < DEPTH * I_OUT) { const int l = r / I_OUT; r -= l * I_OUT; const int kb = r / 32, nb = r % 32;
            tr_item(w_out + (size_t)l * 1024 * 1024 + (size_t)(64 * kb) * 1024 + nb * 32, 1024, 32, nullptr, WTOUT + ((size_t)l * 1024 + nb * 32) * 1024 + 64 * kb, 1024, scr, lane);
            continue; }
    }
    bf16_t* XB = (bf16_t*)(ws + WS_XB); float* SS = (float*)(ws + WS_SS);
    if (!roleA)
    for (int r0 = gw; r0 < MT; r0 += 4 * NGW) {
        f32x4 v[4][4];
#pragma unroll
        for (int q = 0; q < 4; ++q) { const int r = min(r0 + q * NGW, MT - 1);
            const float* src = (r < MP) ? (P.in[0] + (size_t)r * 1024) : (P.in[1] + (size_t)(r - MP) * 1024);
#pragma unroll
            for (int j = 0; j < 4; ++j) v[q][j] = ((const f32x4*)src)[lane + 64 * j]; }
#pragma unroll
        for (int q = 0; q < 4; ++q) { const int r = r0 + q * NGW;
            float s = 0.f;
#pragma unroll
            for (int j = 0; j < 4; ++j) s += (v[q][j][0] * v[q][j][0] + v[q][j][1] * v[q][j][1]) + (v[q][j][2] * v[q][j][2] + v[q][j][3] * v[q][j][3]);
            s = wave_sum(s);
            if (r < MT) {
#pragma unroll
                for (int j = 0; j < 4; ++j) { u32x2 w; w.x = pk2(v[q][j][0], v[q][j][1]); w.y = pk2(v[q][j][2], v[q][j][3]); ((u32x2*)(XB + (size_t)r * 1024))[lane + 64 * j] = w; }
                if (lane < 16) SS[(size_t)r * 16 + lane] = (lane == 0) ? s : 0.f;
            } }
    }
    if (roleA)
    for (int tl = gw; tl < DEPTH * DBAT * 32; tl += NGW) {
        const int l = tl / (DBAT * 32), q = tl % (DBAT * 32), b = q / 32, t = q % 32;
        const float* src = P.in[2] + ((size_t)(l * DBAT + b) * PAST + t * 64) * 512;
        float nmax = 0.f;
#pragma unroll 16
        for (int r = 0; r < 64; ++r) {
            const f32x4 a = ((const f32x4*)(src + (size_t)r * 512))[2 * lane], c = ((const f32x4*)(src + (size_t)r * 512))[2 * lane + 1];
            u32x4 w; w.x = pk2(a[0], a[1]); w.y = pk2(a[2], a[3]); w.z = pk2(c[0], c[1]); w.w = pk2(c[2], c[3]);
            float n2 = sq8(w); n2 += __shfl_xor(n2, 1); n2 += __shfl_xor(n2, 2); n2 += __shfl_xor(n2, 4); nmax = fmaxf(nmax, n2);
        }
        if ((lane & 7) == 0) ((float*)(ws + WS_KN))[((size_t)l * NKT + 1024 + b * 33 + t) * 8 + (lane >> 3)] = sqrtf(nmax);
    }
    float* CL = (float*)(ws + WS_CL); float* BT = (float*)(ws + WS_BT);
    if (roleA)
    for (int r = gw; r < DEPTH * DBAT * 32; r += NGW) {
        const int l = r / (DBAT * 32), q = r % (DBAT * 32), b = q / 32, t = q % 32;
        const float* src = P.in[4] + ((size_t)(l * DBAT + b) * PAST + t * 64 + lane) * 8;
        const size_t krow = (size_t)MP + (size_t)b * SKV + t * 64 + lane;
#pragma unroll
        for (int h = 0; h < 8; ++h) { const float c = wave_scan_incl(src[h], lane); CL[((size_t)l * KROWS + krow) * 8 + h] = c; const float cm = wave_min(c);
            if (lane == 63) { BT[((size_t)l * NKT + (krow >> 6)) * 8 + h] = c; ((float*)(ws + WS_CM))[((size_t)l * NKT + (krow >> 6)) * 8 + h] = cm; } }
    }
}

__device__ __forceinline__ void fox_cumsum(const Params& P, LAS unsigned char* lds, int layer, int tid, int lane, int wave) {
    asm volatile("" : "+v"(lane));
    float* CL = (float*)(P.ws + WS_CL) + (size_t)layer * KROWS * 8; float* BT = (float*)(P.ws + WS_BT) + (size_t)layer * NKT * 8;
    float* CM = (float*)(P.ws + WS_CM) + (size_t)layer * NKT * 8; float* KN = (float*)(P.ws + WS_KN) + (size_t)layer * NKT * 8;
    const float* lfP = P.out + OFF_LP + (size_t)layer * MP * 8; const float* lfS = P.out + OFF_LS + (size_t)layer * MS * 8;
    LAS float* part = (LAS float*)lds;
    for (int g = blockIdx.x; g < NG; g += gridDim.x) {
        const float* src; size_t krow0;
        if (g < MP / 64) { src = lfP + (size_t)g * 64 * 8; krow0 = (size_t)g * 64; }
        else { const int b = g - MP / 64; src = lfS + (size_t)b * 64 * 8; krow0 = (size_t)MP + (size_t)b * SKV + PAST; }
        const bf16_t* kb = (g < MP / 64) ? ((const bf16_t*)(P.ws + WS_KBP) + krow0 * 512) : ((const bf16_t*)(P.ws + WS_KBS) + ((size_t)layer * KSROWS + (krow0 - MP)) * 512);
        u32x4 kw[8];
#pragma unroll
        for (int r = 0; r < 8; ++r) kw[r] = ((const u32x4*)(kb + (size_t)(8 * wave + r) * 512))[lane];
        float hv[8];
        if (wave == 0) {
#pragma unroll
            for (int h = 0; h < 8; ++h) hv[h] = src[(size_t)lane * 8 + h];
        }
        float nmax = 0.f;
#pragma unroll
        for (int r = 0; r < 8; ++r) { float n2 = sq8(kw[r]); n2 += __shfl_xor(n2, 1); n2 += __shfl_xor(n2, 2); n2 += __shfl_xor(n2, 4); nmax = fmaxf(nmax, n2); }
        if ((lane & 7) == 0) part[wave * 8 + (lane >> 3)] = nmax;
        if (wave == 0) {
#pragma unroll
            for (int h = 0; h < 8; ++h) { const float c = wave_scan_incl(hv[h], lane); CL[(krow0 + lane) * 8 + h] = c; const float cm = wave_min(c);
                if (lane == 63) { BT[(krow0 >> 6) * 8 + h] = c; CM[(krow0 >> 6) * 8 + h] = cm; } }
        }
        __syncthreads();
        if (tid < 8) { float m = part[tid];
#pragma unroll
            for (int w = 1; w < 8; ++w) m = fmaxf(m, part[w * 8 + tid]);
            KN[(krow0 >> 6) * 8 + tid] = sqrtf(m); }
        __syncthreads();
    }
}

#define MFMA16(a, b, c) __builtin_amdgcn_mfma_f32_16x16x32_bf16((a), (b), (c), 0, 0, 0)
#define MFMA32(a, b, c) __builtin_amdgcn_mfma_f32_32x32x16_bf16((a), (b), (c), 0, 0, 0)

constexpr int PP_QT = 0, PP_KT = 17408, PP_VT = 34816, PP_AM = 53248, PP_TOT = 62464;
__device__ __forceinline__ void hg_prepass_unit(const Params& P, LAS unsigned char* lds, int layer, int g, int h, int tid, int lane, int wave) {
    unsigned char* ws = P.ws; const float* hl = P.in[9];
    size_t zo = 0;
    asm volatile("" : "+v"(tid), "+v"(lane), "+s"(zo), "+s"(g), "+s"(h));
    ws += zo; hl += zo;
    const int k = tid & 127, tq = tid >> 7, fr = lane & 15, fq = lane >> 4;
    float* HF = (float*)(ws + WS_HF); bf16_t* QE = (bf16_t*)(ws + WS_QE); bf16_t* KDT = (bf16_t*)(ws + WS_KDT) + (size_t)(g * 4 + h) * 8192;
    const bf16_t* HI = (const bf16_t*)(ws + WS_VTH) + (size_t)g * 64 * 512 + h * 128; float* DG = (float*)(ws + WS_DG) + (size_t)(g * 4 + h) * 128;
    float lbv = 0.f;
    if (layer > 0) { lbv = __builtin_amdgcn_rcpf(1.f + __expf(hl[h * 128 + k] - hl[512 + h * 128 + k])); }
    const float oml = 1.f - lbv;
    const size_t e0 = ((size_t)g * 64 + tq * 16) * 512 + h * 128 + k;
    float bc[16], kk[16]; unsigned short qv[16];
    float run = 0.f;
#pragma unroll
    for (int i = 0; i < 16; ++i) qv[i] = QE[e0 + (size_t)i * 512];
#pragma unroll
    for (int i = 0; i < 16; ++i) { const float z = HF[e0 + (size_t)i * 512]; const float ls = logsig(z);
        const float lf = (layer == 0) ? ls : __logf(lbv + oml * __expf(ls)); run += lf; bc[i] = run; kk[i] = oml * __builtin_amdgcn_rcpf(1.f + __expf(z)); }
    LAS float* tot = (LAS float*)(lds + PP_TOT);
    tot[tq * 128 + k] = run;
#pragma unroll
    for (int j = 0; j < 2; ++j) { const int idx = tid + 512 * j, rc = idx >> 4, ch = idx & 15; const u32x4 v = *(const u32x4*)(HI + (size_t)rc * 512 + ch * 8); *(LAS u32x4*)(lds + PP_VT + rc * 272 + ch * 16) = v; }
    __syncthreads();
    const float t0 = tot[k], t1 = tot[128 + k], t2 = tot[256 + k], t3 = tot[384 + k];
    const float off = (tq > 0 ? t0 : 0.f) + (tq > 1 ? t1 : 0.f) + (tq > 2 ? t2 : 0.f);
    const float bmid = t0 + t1, blast = (t0 + t1) + (t2 + t3);
    unsigned kdp[8];
#pragma unroll
    for (int i = 0; i < 16; i += 2) {
        float kd2[2];
#pragma unroll
        for (int j = 0; j < 2; ++j) { const int ii = i + j; const float b = bc[ii] + off; const float q = bf2f(qv[ii]);
            const float qe = q * __expf(b), kd = kk[ii] * __expf(blast - b), qt = q * __expf(b - bmid), kt = kk[ii] * __expf(bmid - b);
            QE[e0 + (size_t)ii * 512] = f2bf(qe); kd2[j] = kd;
            const int t = tq * 16 + ii;
            *(LAS bf16_t*)(lds + PP_QT + t * 272 + k * 2) = f2bf(qt); *(LAS bf16_t*)(lds + PP_KT + t * 272 + k * 2) = f2bf(kt); }
        kdp[i >> 1] = pk2(kd2[0], kd2[1]);
    }
    { u32x4 w0 = {kdp[0], kdp[1], kdp[2], kdp[3]}, w1 = {kdp[4], kdp[5], kdp[6], kdp[7]};
      *(u32x4*)(KDT + k * 64 + tq * 16) = w0; *(u32x4*)(KDT + k * 64 + tq * 16 + 8) = w1; }
    if (tq == 0) { DG[k] = __expf(blast); ((float*)(ws + WS_LG))[(size_t)(g * 4 + h) * 128 + k] = blast; }
    __syncthreads();
    { const int mt = wave >> 1;
#pragma unroll
      for (int nn = 0; nn < 2; ++nn) { const int nt = 2 * (wave & 1) + nn; f32x4 a4 = {0.f, 0.f, 0.f, 0.f};
#pragma unroll
          for (int ks = 0; ks < 4; ++ks) { const bf16x8 a = *(const LAS bf16x8*)(lds + PP_QT + (16 * mt + fr) * 272 + (32 * ks + 8 * fq) * 2);
              const bf16x8 b = *(const LAS bf16x8*)(lds + PP_KT + (16 * nt + fr) * 272 + (32 * ks + 8 * fq) * 2); a4 = MFMA16(a, b, a4); }
#pragma unroll
          for (int rg = 0; rg < 4; ++rg) { const int t = 16 * mt + 4 * fq + rg, s = 16 * nt + fr; const float v = (s <= t) ? a4[rg] : 0.f;
              *(LAS bf16_t*)(lds + PP_AM + t * 144 + s * 2) = f2bf(v); } } }
    __syncthreads();
    { float* OI = HF + (size_t)g * 64 * 512 + h * 128 + 16 * wave + fr;
#pragma unroll
      for (int mt = 0; mt < 4; ++mt) { f32x4 a4 = {0.f, 0.f, 0.f, 0.f};
#pragma unroll
          for (int ks = 0; ks < 2; ++ks) { const bf16x8 a = *(const LAS bf16x8*)(lds + PP_AM + (16 * mt + fr) * 144 + (32 * ks + 8 * fq) * 2);
              const int trq = (lane & 15) >> 2, trp = lane & 3;
              const u32x2 bl = ldtr(lds + PP_VT + (32 * ks + 8 * fq + trq) * 272 + (16 * wave + 4 * trp) * 2), bh = ldtr(lds + PP_VT + (32 * ks + 8 * fq + 4 + trq) * 272 + (16 * wave + 4 * trp) * 2);
              const u32x4 bw = {bl.x, bl.y, bh.x, bh.y}; a4 = MFMA16(a, __builtin_bit_cast(bf16x8, bw), a4); }
#pragma unroll
          for (int rg = 0; rg < 4; ++rg) OI[(size_t)(16 * mt + 4 * fq + rg) * 512] = a4[rg]; } }
    __syncthreads();
}

constexpr int HS_QE = 0, HS_KD = 17408, HS_VT = 35840, HS_D = 54272, HS_O = 54784, HS_G = 54784 + 33792, HS_DS = HS_G + 512, HS_DC = HS_DS + 4096;
constexpr int NSEG = 8, SEGC = 16;
__device__ __forceinline__ void hg_seq_unit(const Params& P, LAS unsigned char* lds, int layer, int g0, int nch, int h, const float* S0, float* Sout, int mode, int seg, const float* Lb, int tid, int lane, int wave) {
    unsigned char* ws = P.ws; const float* gnp = P.in[10] + layer * 512 + h * 128;
    size_t zo = 0;
    asm volatile("" : "+v"(tid), "+v"(lane), "+s"(zo), "+s"(g0), "+s"(nch), "+s"(h), "+s"(mode), "+s"(seg));
    ws += zo; gnp += zo; S0 += zo; Sout += zo; Lb += zo;
    const int fr = lane & 15, fq = lane >> 4;
    const bf16_t* QE = (const bf16_t*)(ws + WS_QE); const bf16_t* KDT = (const bf16_t*)(ws + WS_KDT); const bf16_t* HI = (const bf16_t*)(ws + WS_VTH);
    const float* DG = (const float*)(ws + WS_DG); float* OI = (float*)(ws + WS_HF); bf16_t* YC = (bf16_t*)(ws + WS_YC);
    f32x4 S[8];
#pragma unroll
    for (int kb = 0; kb < 8; ++kb) S[kb] = (f32x4){0.f, 0.f, 0.f, 0.f};
    if (mode == 0) {
#pragma unroll
        for (int kb = 0; kb < 8; ++kb)
#pragma unroll
            for (int rg = 0; rg < 4; ++rg) S[kb][rg] = S0[(size_t)(16 * kb + 4 * fq + rg) * 128 + 16 * wave + fr];
    }
    if (mode == 2) {
        const float* LG = (const float*)(ws + WS_LG);
        if (tid < 128) {
            const int gb = g0 - seg * SEGC;
            for (int j = 0; j < seg; ++j) { float a = 0.f;
#pragma unroll
                for (int c = 0; c < SEGC; ++c) a += LG[((size_t)(gb + SEGC * j + c) * 4 + h) * 128 + tid];
                *(LAS float*)(lds + HS_DS + (j * 128 + tid) * 4) = __expf(a); }
            float run = 0.f;
#pragma unroll
            for (int c = 0; c < SEGC; ++c) { *(LAS float*)(lds + HS_DC + (c * 128 + tid) * 4) = __expf(run); run += LG[((size_t)(g0 + c) * 4 + h) * 128 + tid]; }
            *(LAS float*)(lds + HS_DS + (seg * 128 + tid) * 4) = __expf(run);
        }
        __syncthreads();
        for (int j = 0; j < seg; ++j) { const float* Lj = Lb + (size_t)j * 16384;
#pragma unroll
            for (int kb = 0; kb < 8; ++kb) { const f32x4 d4 = *(const LAS f32x4*)(lds + HS_DS + (j * 128 + 16 * kb + 4 * fq) * 4);
#pragma unroll
                for (int rg = 0; rg < 4; ++rg) S[kb][rg] = S[kb][rg] * d4[rg] + Lj[(size_t)(16 * kb + 4 * fq + rg) * 128 + 16 * wave + fr]; } }
    }
    const int nt = tid >> 3, nseg = tid & 7;
    if (tid < 128) *(LAS float*)(lds + HS_G + tid * 4) = gnp[tid];
    u32x4 pq[2], pkd[2], pv[2]; f32x4 pd;
#define HS_ISSUE(g) do { _Pragma("unroll") for (int j = 0; j < 2; ++j) { const int idx = tid + 512 * j; \
        pq[j] = *(const u32x4*)(QE + ((size_t)(g) * 64 + (idx >> 4)) * 512 + h * 128 + (idx & 15) * 8); \
        if (mode != 2) { pkd[j] = *(const u32x4*)(KDT + (size_t)((g) * 4 + h) * 8192 + idx * 8); pv[j] = *(const u32x4*)(HI + ((size_t)(g) * 64 + (idx >> 4)) * 512 + h * 128 + (idx & 15) * 8); } } \
        if (mode != 2 && tid < 32) pd = *(const f32x4*)(DG + (size_t)((g) * 4 + h) * 128 + tid * 4); } while (0)
#define HS_COMMIT() do { _Pragma("unroll") for (int j = 0; j < 2; ++j) { const int idx = tid + 512 * j; \
        *(LAS u32x4*)(lds + HS_QE + (idx >> 4) * 272 + (idx & 15) * 16) = pq[j]; \
        if (mode != 2) { *(LAS u32x4*)(lds + HS_KD + (idx >> 3) * 144 + (idx & 7) * 16) = pkd[j]; *(LAS u32x4*)(lds + HS_VT + (idx >> 4) * 272 + (idx & 15) * 16) = pv[j]; } } \
        if (mode != 2 && tid < 32) *(LAS f32x4*)(lds + HS_D + tid * 16) = pd; } while (0)
    HS_ISSUE(g0); HS_COMMIT();
    u32x4 gt0 = {0u, 0u, 0u, 0u}, gt1 = {0u, 0u, 0u, 0u}; f32x4 oi[4];
#define HS_LOAD_OI(g) do { _Pragma("unroll") for (int mt = 0; mt < 4; ++mt) _Pragma("unroll") for (int rg = 0; rg < 4; ++rg) \
        oi[mt][rg] = OI[((size_t)(g) * 64 + 16 * mt + 4 * fq + rg) * 512 + h * 128 + 16 * wave + fr]; } while (0)
#define HS_LOAD_GT(g) do { const size_t yo_ = ((size_t)(g) * 64 + nt) * 1024 + 512 + h * 128 + 16 * nseg; gt0 = *(const u32x4*)(YC + yo_); gt1 = *(const u32x4*)(YC + yo_ + 8); } while (0)
    HS_LOAD_OI(g0); if (mode != 1) HS_LOAD_GT(g0);
    __syncthreads();
    for (int c = 0; c < nch; ++c) {
        const int g = g0 + c;
        if (c + 1 < nch) HS_ISSUE(g + 1);
        const size_t yoff = ((size_t)g * 64 + nt) * 1024 + 512 + h * 128 + 16 * nseg;
        bf16x8 sb[4];
        if (mode == 2) {
#pragma unroll
            for (int ks = 0; ks < 4; ++ks) { const f32x4 da = *(const LAS f32x4*)(lds + HS_DC + (c * 128 + 32 * ks + 4 * fq) * 4), db = *(const LAS f32x4*)(lds + HS_DC + (c * 128 + 32 * ks + 16 + 4 * fq) * 4);
                const f32x4 x = S[2 * ks] * da, y = S[2 * ks + 1] * db; u32x4 w; w.x = pk2(x[0], x[1]); w.y = pk2(x[2], x[3]); w.z = pk2(y[0], y[1]); w.w = pk2(y[2], y[3]); sb[ks] = __builtin_bit_cast(bf16x8, w); }
        } else {
#pragma unroll
            for (int ks = 0; ks < 4; ++ks) { u32x4 w; w.x = pk2(S[2 * ks][0], S[2 * ks][1]); w.y = pk2(S[2 * ks][2], S[2 * ks][3]); w.z = pk2(S[2 * ks + 1][0], S[2 * ks + 1][1]); w.w = pk2(S[2 * ks + 1][2], S[2 * ks + 1][3]);
                sb[ks] = __builtin_bit_cast(bf16x8, w); }
        }
#pragma unroll
        for (int mp = 0; mp < 2; ++mp) { u32x2 alo[2][4], ahi[2][4];
#pragma unroll
          for (int m2 = 0; m2 < 2; ++m2)
#pragma unroll
              for (int ks = 0; ks < 4; ++ks) { const int mt = 2 * mp + m2; alo[m2][ks] = *(const LAS u32x2*)(lds + HS_QE + (16 * mt + fr) * 272 + (32 * ks + 4 * fq) * 2);
                  ahi[m2][ks] = *(const LAS u32x2*)(lds + HS_QE + (16 * mt + fr) * 272 + (32 * ks + 16 + 4 * fq) * 2); }
          __builtin_amdgcn_sched_barrier(0);
#pragma unroll
          for (int m2 = 0; m2 < 2; ++m2) { const int mt = 2 * mp + m2; f32x4 o4 = oi[mt];
#pragma unroll
              for (int ks = 0; ks < 4; ++ks) { const u32x4 aw = {alo[m2][ks].x, alo[m2][ks].y, ahi[m2][ks].x, ahi[m2][ks].y}; o4 = MFMA16(__builtin_bit_cast(bf16x8, aw), sb[ks], o4); }
              if (mode == 1) {
#pragma unroll
                  for (int rg = 0; rg < 4; ++rg) OI[((size_t)g * 64 + 16 * mt + 4 * fq + rg) * 512 + h * 128 + 16 * wave + fr] = o4[rg];
              } else {
#pragma unroll
                  for (int rg = 0; rg < 4; ++rg) *(LAS float*)(lds + HS_O + ((16 * mt + 4 * fq + rg) * 132 + 16 * wave + fr) * 4) = o4[rg];
              } } }
        if (c + 1 < nch) HS_LOAD_OI(g + 1);
        if (mode != 2) {
          const int trq = (lane & 15) >> 2, trp = lane & 3;
          const u32x2 v0 = ldtr(lds + HS_VT + (8 * fq + trq) * 272 + (16 * wave + 4 * trp) * 2), v1 = ldtr(lds + HS_VT + (8 * fq + 4 + trq) * 272 + (16 * wave + 4 * trp) * 2);
          const u32x2 v2 = ldtr(lds + HS_VT + (32 + 8 * fq + trq) * 272 + (16 * wave + 4 * trp) * 2), v3 = ldtr(lds + HS_VT + (32 + 8 * fq + 4 + trq) * 272 + (16 * wave + 4 * trp) * 2);
          const u32x4 bw0 = {v0.x, v0.y, v1.x, v1.y}, bw1 = {v2.x, v2.y, v3.x, v3.y};
          const bf16x8 b0 = __builtin_bit_cast(bf16x8, bw0), b1 = __builtin_bit_cast(bf16x8, bw1);
#pragma unroll
          for (int hf = 0; hf < 2; ++hf) { f32x4 d4[4]; bf16x8 a0[4], a1[4];
#pragma unroll
              for (int q = 0; q < 4; ++q) { const int kb = 4 * hf + q; d4[q] = *(const LAS f32x4*)(lds + HS_D + (16 * kb + 4 * fq) * 4);
                  a0[q] = *(const LAS bf16x8*)(lds + HS_KD + (16 * kb + fr) * 144 + (8 * fq) * 2); a1[q] = *(const LAS bf16x8*)(lds + HS_KD + (16 * kb + fr) * 144 + (32 + 8 * fq) * 2); }
              __builtin_amdgcn_sched_barrier(0);
#pragma unroll
              for (int q = 0; q < 4; ++q) { const int kb = 4 * hf + q; S[kb] = S[kb] * d4[q]; S[kb] = MFMA16(a0[q], b0, S[kb]); S[kb] = MFMA16(a1[q], b1, S[kb]); } } }
        __syncthreads();
        if (mode != 1) { f32x4 v[4]; float ss = 0.f;
#pragma unroll
          for (int j = 0; j < 4; ++j) { v[j] = *(const LAS f32x4*)(lds + HS_O + (nt * 132 + 16 * nseg + 4 * j) * 4); ss += (v[j][0] * v[j][0] + v[j][1] * v[j][1]) + (v[j][2] * v[j][2] + v[j][3] * v[j][3]); }
          ss += __shfl_xor(ss, 1); ss += __shfl_xor(ss, 2); ss += __shfl_xor(ss, 4);
          const float rinv = rsqrtf(ss * (1.0f / 128.0f) + EPS);
          const unsigned gw_[8] = {gt0.x, gt0.y, gt0.z, gt0.w, gt1.x, gt1.y, gt1.z, gt1.w};
          unsigned ow[8];
#pragma unroll
          for (int j = 0; j < 8; ++j) { const f32x4 gq = *(const LAS f32x4*)(lds + HS_G + (16 * nseg + 4 * (j >> 1)) * 4); const float g0_ = gq[(j & 1) * 2], g1_ = gq[(j & 1) * 2 + 1];
              const float a = v[j >> 1][(j & 1) * 2] * rinv * g0_ * bflo(gw_[j]); const float b = v[j >> 1][(j & 1) * 2 + 1] * rinv * g1_ * bfhi(gw_[j]); ow[j] = pk2(a, b); }
          const u32x4 o0 = {ow[0], ow[1], ow[2], ow[3]}, o1 = {ow[4], ow[5], ow[6], ow[7]};
          *(u32x4*)(YC + yoff) = o0; *(u32x4*)(YC + yoff + 8) = o1;
          if (c + 1 < nch) HS_LOAD_GT(g + 1); }
        if (c + 1 < nch) HS_COMMIT();
        __syncthreads();
    }
    if (mode == 2) {
        if (seg == NSEG - 1) {
            const float* Lj = Lb + (size_t)seg * 16384;
#pragma unroll
            for (int kb = 0; kb < 8; ++kb) { const f32x4 d4 = *(const LAS f32x4*)(lds + HS_DS + (seg * 128 + 16 * kb + 4 * fq) * 4);
#pragma unroll
                for (int rg = 0; rg < 4; ++rg) Sout[(size_t)(16 * kb + 4 * fq + rg) * 128 + 16 * wave + fr] = S[kb][rg] * d4[rg] + Lj[(size_t)(16 * kb + 4 * fq + rg) * 128 + 16 * wave + fr]; }
        }
    } else {
#pragma unroll
        for (int kb = 0; kb < 8; ++kb)
#pragma unroll
            for (int rg = 0; rg < 4; ++rg) Sout[(size_t)(16 * kb + 4 * fq + rg) * 128 + 16 * wave + fr] = S[kb][rg];
    }
    __syncthreads();
#undef HS_ISSUE
#undef HS_COMMIT
#undef HS_LOAD_OI
#undef HS_LOAD_GT
}

constexpr int HL_QE = 0, HL_KD = 17408, HL_VT = 35840, HL_D = 53248, HL_QT = 53760, HL_KT = 71168, HL_AM = 88576, HL_TOT = 97792;
__device__ __forceinline__ void hg_local_unit(const Params& P, LAS unsigned char* lds, int layer, int g0, int h, float* Sout, int tid, int lane, int wave) {
    unsigned char* ws = P.ws; const float* hl = P.in[9];
    size_t zo = 0;
    asm volatile("" : "+v"(tid), "+v"(lane), "+s"(zo), "+s"(g0), "+s"(h));
    ws += zo; hl += zo; Sout += zo;
    const int k = tid & 127, tq = tid >> 7, fr = lane & 15, fq = lane >> 4;
    float* HF = (float*)(ws + WS_HF); bf16_t* QE = (bf16_t*)(ws + WS_QE); const bf16_t* HIb = (const bf16_t*)(ws + WS_VTH); float* LG = (float*)(ws + WS_LG);
    float lbv = 0.f;
    if (layer > 0) lbv = __builtin_amdgcn_rcpf(1.f + __expf(hl[h * 128 + k] - hl[512 + h * 128 + k]));
    const float oml = 1.f - lbv;
    f32x4 S[8];
#pragma unroll
    for (int kb = 0; kb < 8; ++kb) S[kb] = (f32x4){0.f, 0.f, 0.f, 0.f};
    float z[16]; unsigned short qv[16]; u32x4 hv[2];
#define HL_E0(gg) (((size_t)(gg) * 64 + tq * 16) * 512 + h * 128 + k)
#define HL_LOADZ(gg) do { const size_t e_ = HL_E0(gg); _Pragma("unroll") for (int i = 0; i < 16; ++i) z[i] = HF[e_ + (size_t)i * 512]; } while (0)
#define HL_LOADQ(gg) do { const size_t e_ = HL_E0(gg); _Pragma("unroll") for (int i = 0; i < 16; ++i) qv[i] = QE[e_ + (size_t)i * 512]; } while (0)
#define HL_LOADH(gg) do { const bf16_t* hi_ = HIb + (size_t)(gg) * 64 * 512 + h * 128; _Pragma("unroll") for (int j = 0; j < 2; ++j) { const int idx = tid + 512 * j; hv[j] = *(const u32x4*)(hi_ + (size_t)(idx >> 4) * 512 + (idx & 15) * 8); } } while (0)
    HL_LOADZ(g0); HL_LOADQ(g0); HL_LOADH(g0);
    for (int c = 0; c < SEGC; ++c) {
        const int g = g0 + c;
        const size_t e0 = HL_E0(g);
        float bc[16], kk[16];
#pragma unroll
        for (int j = 0; j < 2; ++j) { const int idx = tid + 512 * j; *(LAS u32x4*)(lds + HL_VT + (idx >> 4) * 272 + (idx & 15) * 16) = hv[j]; }
        float run = 0.f;
#pragma unroll
        for (int i = 0; i < 16; ++i) { const float zz = z[i]; const float e = __expf(-fabsf(zz)), r = __builtin_amdgcn_rcpf(1.f + e), er = e * r;
            const float lf = (layer == 0) ? (fminf(zz, 0.f) - __logf(1.f + e)) : __logf(lbv + oml * (zz > 0.f ? r : er));
            run += lf; bc[i] = run; kk[i] = oml * (zz > 0.f ? er : r); }
        *(LAS float*)(lds + HL_TOT + (tq * 128 + k) * 4) = run;
        if (c + 1 < SEGC) { HL_LOADZ(g + 1); HL_LOADH(g + 1); }
        __syncthreads();
        const float t0 = *(const LAS float*)(lds + HL_TOT + k * 4), t1 = *(const LAS float*)(lds + HL_TOT + (128 + k) * 4), t2 = *(const LAS float*)(lds + HL_TOT + (256 + k) * 4), t3 = *(const LAS float*)(lds + HL_TOT + (384 + k) * 4);
        const float off = (tq > 0 ? t0 : 0.f) + (tq > 1 ? t1 : 0.f) + (tq > 2 ? t2 : 0.f);
        const float bmid = t0 + t1, blast = (t0 + t1) + (t2 + t3);
        unsigned kdp[8];
        const float cA = __expf(bmid), cB = __expf(blast - bmid);
#pragma unroll
        for (int i = 0; i < 16; i += 2) {
            float kd2[2];
#pragma unroll
            for (int j = 0; j < 2; ++j) { const int ii = i + j; const float b = bc[ii] + off; const float q = bf2f(qv[ii]);
                const float qt = q * __expf(b - bmid), kt = kk[ii] * __expf(bmid - b), qe = qt * cA, kd = kt * cB;
                const unsigned short qeb = f2bf(qe);
                QE[e0 + (size_t)ii * 512] = qeb; kd2[j] = kd;
                const int t = tq * 16 + ii;
                *(LAS bf16_t*)(lds + HL_QE + t * 272 + k * 2) = qeb;
                *(LAS bf16_t*)(lds + HL_QT + t * 272 + k * 2) = f2bf(qt); *(LAS bf16_t*)(lds + HL_KT + t * 272 + k * 2) = f2bf(kt); }
            kdp[i >> 1] = pk2(kd2[0], kd2[1]);
        }
        { const u32x4 w0 = {kdp[0], kdp[1], kdp[2], kdp[3]}, w1 = {kdp[4], kdp[5], kdp[6], kdp[7]};
          *(LAS u32x4*)(lds + HL_KD + k * 144 + tq * 32) = w0; *(LAS u32x4*)(lds + HL_KD + k * 144 + tq * 32 + 16) = w1; }
        if (tq == 0) { *(LAS float*)(lds + HL_D + k * 4) = __expf(blast); LG[(size_t)(g * 4 + h) * 128 + k] = blast; }
        if (c + 1 < SEGC) HL_LOADQ(g + 1);
        __syncthreads();
        { const int mt = wave >> 1;
#pragma unroll
          for (int nn = 0; nn < 2; ++nn) { const int nt = 2 * (wave & 1) + nn; f32x4 a4 = {0.f, 0.f, 0.f, 0.f};
#pragma unroll
              for (int ks = 0; ks < 4; ++ks) { const bf16x8 a = *(const LAS bf16x8*)(lds + HL_QT + (16 * mt + fr) * 272 + (32 * ks + 8 * fq) * 2);
                  const bf16x8 b = *(const LAS bf16x8*)(lds + HL_KT + (16 * nt + fr) * 272 + (32 * ks + 8 * fq) * 2); a4 = MFMA16(a, b, a4); }
#pragma unroll
              for (int rg = 0; rg < 4; ++rg) { const int t = 16 * mt + 4 * fq + rg, s_ = 16 * nt + fr; const float v = (s_ <= t) ? a4[rg] : 0.f;
                  *(LAS bf16_t*)(lds + HL_AM + t * 144 + s_ * 2) = f2bf(v); } } }
        __syncthreads();
        const int trq = (lane & 15) >> 2, trp = lane & 3;
        bf16x8 vb0, vb1;
        { const u32x2 v0 = ldtr(lds + HL_VT + (8 * fq + trq) * 272 + (16 * wave + 4 * trp) * 2), v1 = ldtr(lds + HL_VT + (8 * fq + 4 + trq) * 272 + (16 * wave + 4 * trp) * 2);
          const u32x2 v2 = ldtr(lds + HL_VT + (32 + 8 * fq + trq) * 272 + (16 * wave + 4 * trp) * 2), v3 = ldtr(lds + HL_VT + (32 + 8 * fq + 4 + trq) * 272 + (16 * wave + 4 * trp) * 2);
          const u32x4 bw0 = {v0.x, v0.y, v1.x, v1.y}, bw1 = {v2.x, v2.y, v3.x, v3.y}; vb0 = __builtin_bit_cast(bf16x8, bw0); vb1 = __builtin_bit_cast(bf16x8, bw1); }
        bf16x8 sb[4];
#pragma unroll
        for (int ks = 0; ks < 4; ++ks) { u32x4 w; w.x = pk2(S[2 * ks][0], S[2 * ks][1]); w.y = pk2(S[2 * ks][2], S[2 * ks][3]); w.z = pk2(S[2 * ks + 1][0], S[2 * ks + 1][1]); w.w = pk2(S[2 * ks + 1][2], S[2 * ks + 1][3]);
            sb[ks] = __builtin_bit_cast(bf16x8, w); }
#pragma unroll
        for (int mt = 0; mt < 4; ++mt) {
            const bf16x8 am0 = *(const LAS bf16x8*)(lds + HL_AM + (16 * mt + fr) * 144 + (8 * fq) * 2), am1 = *(const LAS bf16x8*)(lds + HL_AM + (16 * mt + fr) * 144 + (32 + 8 * fq) * 2);
            u32x2 alo[4], ahi[4];
#pragma unroll
            for (int ks = 0; ks < 4; ++ks) { alo[ks] = *(const LAS u32x2*)(lds + HL_QE + (16 * mt + fr) * 272 + (32 * ks + 4 * fq) * 2); ahi[ks] = *(const LAS u32x2*)(lds + HL_QE + (16 * mt + fr) * 272 + (32 * ks + 16 + 4 * fq) * 2); }
            f32x4 o4 = {0.f, 0.f, 0.f, 0.f};
            o4 = MFMA16(am0, vb0, o4); o4 = MFMA16(am1, vb1, o4);
#pragma unroll
            for (int ks = 0; ks < 4; ++ks) { const u32x4 aw = {alo[ks].x, alo[ks].y, ahi[ks].x, ahi[ks].y}; o4 = MFMA16(__builtin_bit_cast(bf16x8, aw), sb[ks], o4); }
#pragma unroll
            for (int rg = 0; rg < 4; ++rg) HF[((size_t)g * 64 + 16 * mt + 4 * fq + rg) * 512 + h * 128 + 16 * wave + fr] = o4[rg];
        }
#pragma unroll
        for (int hf = 0; hf < 2; ++hf) { f32x4 d4[4]; bf16x8 a0[4], a1[4];
#pragma unroll
            for (int q = 0; q < 4; ++q) { const int kb = 4 * hf + q; d4[q] = *(const LAS f32x4*)(lds + HL_D + (16 * kb + 4 * fq) * 4);
                a0[q] = *(const LAS bf16x8*)(lds + HL_KD + (16 * kb + fr) * 144 + (8 * fq) * 2); a1[q] = *(const LAS bf16x8*)(lds + HL_KD + (16 * kb + fr) * 144 + (32 + 8 * fq) * 2); }
#pragma unroll
            for (int q = 0; q < 4; ++q) { const int kb = 4 * hf + q; S[kb] = S[kb] * d4[q]; S[kb] = MFMA16(a0[q], vb0, S[kb]); S[kb] = MFMA16(a1[q], vb1, S[kb]); } }
        __syncthreads();
    }
#pragma unroll
    for (int kb = 0; kb < 8; ++kb)
#pragma unroll
        for (int rg = 0; rg < 4; ++rg) Sout[(size_t)(16 * kb + 4 * fq + rg) * 128 + 16 * wave + fr] = S[kb][rg];
#undef HL_E0
#undef HL_LOADZ
#undef HL_LOADQ
#undef HL_LOADH
}

constexpr int AT_BUF = 9216 + 9216 + 256, AT_PFX = 2 * AT_BUF, AT_PUB = AT_PFX + 528, AT_RED = AT_PUB + 528;
constexpr float AT_THR = -160.f;
__device__ __forceinline__ int crow(int r, int hi) { return (r & 3) + 8 * (r >> 2) + 4 * hi; }
__device__ __forceinline__ void attn_tile(LAS unsigned char* lds, int bo, const bf16x8 (&qr)[4], f32x16& o0, f32x16& o1, float& mrun, float& lrun, int t, int qlo, int r32, int hi) {
    f32x16 p0, p1;
#pragma unroll
    for (int g = 0; g < 4; ++g) { const f32x4 x0 = *(const LAS f32x4*)(lds + bo + 18432 + (8 * g + 4 * hi) * 4), x1 = *(const LAS f32x4*)(lds + bo + 18432 + (32 + 8 * g + 4 * hi) * 4);
#pragma unroll
        for (int i = 0; i < 4; ++i) { p0[4 * g + i] = x0[i]; p1[4 * g + i] = x1[i]; } }
    { bf16x8 k0[4], k1[4];
#pragma unroll
      for (int d0 = 0; d0 < 4; ++d0) { k0[d0] = *(const LAS bf16x8*)(lds + bo + r32 * 144 + (16 * d0 + 8 * hi) * 2); k1[d0] = *(const LAS bf16x8*)(lds + bo + (32 + r32) * 144 + (16 * d0 + 8 * hi) * 2); }
      __builtin_amdgcn_sched_barrier(0);
#pragma unroll
      for (int d0 = 0; d0 < 4; ++d0) { p0 = MFMA32(k0[d0], qr[d0], p0); p1 = MFMA32(k1[d0], qr[d0], p1); } }
    if (64 * t + 63 > qlo) {
        const int qp = qlo + r32, kb = 64 * t + 4 * hi;
#pragma unroll
        for (int r = 0; r < 16; ++r) { const int kv = kb + (r & 3) + 8 * (r >> 2); if (kv > qp) p0[r] = -INFINITY; if (kv + 32 > qp) p1[r] = -INFINITY; }
    }
    float mx = fmaxf(p0[0], p1[0]);
#pragma unroll
    for (int r = 1; r < 16; ++r) mx = fmaxf(mx, fmaxf(p0[r], p1[r]));
    mx = fmaxf(mx, __shfl_xor(mx, 32));
    if (__any(mx > mrun)) {
        const float mnew = fmaxf(mrun, mx);
        const float alpha = __builtin_amdgcn_exp2f(mrun - mnew);
        mrun = mnew; lrun *= alpha;
#pragma unroll
        for (int r = 0; r < 16; ++r) { o0[r] *= alpha; o1[r] *= alpha; }
    }
    float rsum = 0.f;
#pragma unroll
    for (int r = 0; r < 16; ++r) { p0[r] = __builtin_amdgcn_exp2f(p0[r] - mrun); p1[r] = __builtin_amdgcn_exp2f(p1[r] - mrun); rsum += p0[r] + p1[r]; }
    lrun += rsum;
    const int trq = (r32 & 15) >> 2, trp = r32 & 3, blk = r32 >> 4;
    u32x2 va[4][2][2];
#pragma unroll
    for (int st = 0; st < 4; ++st) { const int kvb = 16 * st + 4 * hi;
#pragma unroll
        for (int d0 = 0; d0 < 2; ++d0) { va[st][d0][0] = ldtr(lds + bo + 9216 + (kvb + trq) * 144 + (32 * d0 + 16 * blk + 4 * trp) * 2); va[st][d0][1] = ldtr(lds + bo + 9216 + (kvb + 8 + trq) * 144 + (32 * d0 + 16 * blk + 4 * trp) * 2); } }
    __builtin_amdgcn_sched_barrier(0);
#pragma unroll
    for (int st = 0; st < 4; ++st) {
        u32x4 w;
        if (st < 2) { w.x = pk2(p0[8 * st], p0[8 * st + 1]); w.y = pk2(p0[8 * st + 2], p0[8 * st + 3]); w.z = pk2(p0[8 * st + 4], p0[8 * st + 5]); w.w = pk2(p0[8 * st + 6], p0[8 * st + 7]); }
        else { const int s2 = st - 2; w.x = pk2(p1[8 * s2], p1[8 * s2 + 1]); w.y = pk2(p1[8 * s2 + 2], p1[8 * s2 + 3]); w.z = pk2(p1[8 * s2 + 4], p1[8 * s2 + 5]); w.w = pk2(p1[8 * s2 + 6], p1[8 * s2 + 7]); }
        const bf16x8 pf = __builtin_bit_cast(bf16x8, w);
        { const u32x4 aw = {va[st][0][0].x, va[st][0][0].y, va[st][0][1].x, va[st][0][1].y}; o0 = MFMA32(__builtin_bit_cast(bf16x8, aw), pf, o0); }
        { const u32x4 aw = {va[st][1][0].x, va[st][1][0].y, va[st][1][1].x, va[st][1][1].y}; o1 = MFMA32(__builtin_bit_cast(bf16x8, aw), pf, o1); }
    }
}
__device__ __forceinline__ void attn_unit(LAS unsigned char* lds, const bf16_t* Qp, const bf16_t* Kp, const bf16_t* VTp, int vpitch, const float* CLp, const float* BTp, const float* CMp, const float* KNp,
                                          int NT, int nqw, int qpos0, int cref_tile, bf16_t* Yp, const float* Kc, const float* Vc, int ncache, int tid, int lane, int wave) {
    size_t zo = 0;
    asm volatile("" : "+v"(tid), "+v"(lane), "+s"(zo), "+s"(vpitch), "+s"(NT), "+s"(nqw), "+s"(qpos0), "+s"(cref_tile), "+s"(ncache));
    Qp += zo; Kp += zo; VTp += zo; CLp += zo; BTp += zo; CMp += zo; KNp += zo; Yp += zo; Kc += zo; Vc += zo;
    const int r32 = lane & 31, hi = lane >> 5;
    LAS float* Pfx = (LAS float*)(lds + AT_PFX); LAS float* PUB = (LAS float*)(lds + AT_PUB); LAS float* red = (LAS float*)(lds + AT_RED);
    const int srow = tid >> 3, sch = tid & 7;
    float bt_a = 0.f, bt_b = 0.f, kn_a = 0.f, kn_b = 0.f, cm_a = 0.f, cm_b = 0.f;
    if (wave == 0) {
        if (lane < NT) { bt_a = BTp[(size_t)lane * 8]; kn_a = KNp[(size_t)lane * 8]; cm_a = CMp[(size_t)lane * 8]; }
        if (lane + 64 < NT) { bt_b = BTp[(size_t)(lane + 64) * 8]; kn_b = KNp[(size_t)(lane + 64) * 8]; cm_b = CMp[(size_t)(lane + 64) * 8]; }
    }
    bf16x8 qr[4];
    const bool active = wave < nqw;
    if (active) {
#pragma unroll
        for (int d0 = 0; d0 < 4; ++d0) qr[d0] = *(const bf16x8*)(Qp + (size_t)(32 * wave + r32) * 512 + 16 * d0 + 8 * hi);
    } else {
#pragma unroll
        for (int d0 = 0; d0 < 4; ++d0) qr[d0] = (bf16x8){0, 0, 0, 0, 0, 0, 0, 0};
    }
    u32x4 pkA, pvA, pkB, pvB; float pbA = 0.f, pbB = 0.f;
#define AT_ISSUE(PK, PV, PB, t) { if ((t) < ncache) { const size_t co_ = ((size_t)(64 * (t) + srow)) * 512 + sch * 8;     \
            const f32x4 ka_ = *(const f32x4*)(Kc + co_), kc_ = *(const f32x4*)(Kc + co_ + 4), va_ = *(const f32x4*)(Vc + co_), vc_ = *(const f32x4*)(Vc + co_ + 4); \
            PK = (u32x4){pk2(ka_[0], ka_[1]), pk2(ka_[2], ka_[3]), pk2(kc_[0], kc_[1]), pk2(kc_[2], kc_[3])}; PV = (u32x4){pk2(va_[0], va_[1]), pk2(va_[2], va_[3]), pk2(vc_[0], vc_[1]), pk2(vc_[2], vc_[3])}; } \
        else { PK = *(const u32x4*)(Kp + ((size_t)(64 * (t) + srow)) * 512 + sch * 8); PV = *(const u32x4*)(VTp + ((size_t)(64 * (t) + srow)) * 512 + sch * 8); } \
        if (tid < 64) PB = CLp[(size_t)(64 * (t) + tid) * 8]; }
#define AT_COMMIT(PK, PV, PB, t, bo) { *(LAS u32x4*)(lds + (bo) + srow * 144 + sch * 16) = PK; *(LAS u32x4*)(lds + (bo) + 9216 + srow * 144 + sch * 16) = PV; \
        if (tid < 64) *(LAS float*)(lds + (bo) + 18432 + tid * 4) = (cref - Pfx[(t)] - PB) * LOG2E; }
    AT_ISSUE(pkB, pvB, pbB, NT - 1);
    if (NT >= 2) AT_ISSUE(pkA, pvA, pbA, NT - 2);
    u32x2 gte[4][2];
    { const bf16_t* yrow_ = Yp + (size_t)(32 * (active ? wave : 0) + r32) * 1024;
#pragma unroll
      for (int g = 0; g < 4; ++g) { gte[g][0] = *(const u32x2*)(yrow_ + 8 * g + 4 * hi); gte[g][1] = *(const u32x2*)(yrow_ + 32 + 8 * g + 4 * hi); } }
    float qn2 = 0.f;
#pragma unroll
    for (int d0 = 0; d0 < 4; ++d0) qn2 += sq8(__builtin_bit_cast(u32x4, qr[d0]));
    qn2 += __shfl_xor(qn2, 32);
#pragma unroll
    for (int o = 1; o < 32; o <<= 1) qn2 = fmaxf(qn2, __shfl_xor(qn2, o));
    if (lane == 0) red[wave] = qn2;
    __syncthreads();
    if (wave == 0) {
        float q2 = red[0];
#pragma unroll
        for (int w = 1; w < 8; ++w) q2 = fmaxf(q2, red[w]);
        const float Qmax = sqrtf(q2) * 1.002f;
        const float sa = wave_scan_incl(bt_a, lane), ta = __shfl(sa, 63), sb = wave_scan_incl(bt_b, lane);
        const float ea = sa - bt_a, eb = sb + ta - bt_b;
        Pfx[lane] = ea; Pfx[lane + 64] = eb;
        const float c0 = __shfl(ea, cref_tile & 63), c1 = __shfl(eb, cref_tile & 63);
        const float crf = (cref_tile < 64) ? c0 : c1;
        const float ua = (lane < NT) ? (kn_a * Qmax + (crf - ea - cm_a) * LOG2E) : -INFINITY;
        const float ub = (lane + 64 < NT) ? (kn_b * Qmax + (crf - eb - cm_b) * LOG2E) : -INFINITY;
        const float pa = wave_scan_max(ua, lane), tm = __shfl(pa, 63), pb = fmaxf(wave_scan_max(ub, lane), tm);
        PUB[lane] = pa; PUB[lane + 64] = pb;
    }
    __syncthreads();
    const float cref = Pfx[cref_tile];
    AT_COMMIT(pkB, pvB, pbB, NT - 1, 0);
    __syncthreads();
    float mrun = -INFINITY, lrun = 0.f, LB = 0.f;
    f32x16 o0, o1;
#pragma unroll
    for (int r = 0; r < 16; ++r) { o0[r] = 0.f; o1[r] = 0.f; }
    const int qlo = qpos0 + 32 * wave;
    int t = NT - 1, bo = 0;
#define AT_STEP(RCK, RCV, RCB, RNK, RNV, RNB) { \
        if (t < cref_tile && PUB[t] - LB < AT_THR) break;     \
        if (t >= 2) AT_ISSUE(RNK, RNV, RNB, t - 2); \
        if (active && 64 * t <= qlo + 31) attn_tile(lds, bo, qr, o0, o1, mrun, lrun, t, qlo, r32, hi); \
        if (t >= 1) AT_COMMIT(RCK, RCV, RCB, t - 1, AT_BUF - bo); \
        if (t == cref_tile) { const float mm = wave_min(active ? mrun : INFINITY); if (lane == 0) red[8 + wave] = mm; } \
        __syncthreads(); \
        if (t == cref_tile) { float m = red[8]; _Pragma("unroll") for (int w = 1; w < 8; ++w) m = fminf(m, red[8 + w]); LB = m; } \
        if (t == 0) break; \
        --t; bo = AT_BUF - bo; }
    for (;;) {
        AT_STEP(pkA, pvA, pbA, pkB, pvB, pbB)
        AT_STEP(pkB, pvB, pbB, pkA, pvA, pbA)
    }
    if (active) {
        const float lt = lrun + __shfl_xor(lrun, 32);
        const float inv = 1.0f / lt;
        bf16_t* yrow = Yp + (size_t)(32 * wave + r32) * 1024;
#pragma unroll
        for (int g = 0; g < 4; ++g) {
            { bf16_t* p = yrow + 8 * g + 4 * hi; const u32x2 gt = gte[g][0]; u32x2 w;
              w.x = pk2(o0[4 * g] * inv * bflo(gt.x), o0[4 * g + 1] * inv * bfhi(gt.x)); w.y = pk2(o0[4 * g + 2] * inv * bflo(gt.y), o0[4 * g + 3] * inv * bfhi(gt.y)); *(u32x2*)p = w; }
            { bf16_t* p = yrow + 32 + 8 * g + 4 * hi; const u32x2 gt = gte[g][1]; u32x2 w;
              w.x = pk2(o1[4 * g] * inv * bflo(gt.x), o1[4 * g + 1] * inv * bfhi(gt.x)); w.y = pk2(o1[4 * g + 2] * inv * bflo(gt.y), o1[4 * g + 3] * inv * bfhi(gt.y)); *(u32x2*)p = w; }
        }
    }
    __syncthreads();
#undef AT_ISSUE
#undef AT_COMMIT
#undef AT_STEP
}

__global__ void __launch_bounds__(512, 2) fwd_megakernel(Params P) {
    extern __shared__ __attribute__((aligned(16))) unsigned char lds_raw[];
    LAS unsigned char* lds = (LAS unsigned char*)lds_raw;
    cg::grid_group grid = cg::this_grid();
    const int tid = threadIdx.x, lane = tid & 63, wave = __builtin_amdgcn_readfirstlane(tid >> 6);
    unsigned char* ws = P.ws;
    volatile LAS int* slot = (volatile LAS int*)(lds + LDS_MISC);
    volatile LAS unsigned* bst = (volatile LAS unsigned*)(lds + LDS_MISC + 64);
    if (tid < 2) bst[tid] = 0u;
    if (blockIdx.x == 0) {
#pragma unroll
        for (int i = 0; i < 4; ++i) ((u32x4*)(ws + WS_CTL))[tid * 4 + i] = (u32x4){0u, 0u, 0u, 0u};
    }
    __syncthreads();

#ifndef NO_P0
    p0_prologue(P, lds, tid, lane, wave);
#endif
    grid.sync();
    const XcdBarrier xbar = xcd_barrier_post((unsigned*)(ws + WS_BAR), bst);
#define GSYNC() xcd_barrier(xbar)

#ifndef NREP_L
#define NREP_L 1
#endif
#ifndef NREP_P1
#define NREP_P1 1
#endif
    for (int li = 0; li < DEPTH * NREP_L; ++li) {
      const int layer = li / NREP_L;
      const bool lastrep = (li % NREP_L == NREP_L - 1);
      {
        for (int rep1 = 0; rep1 < NREP_P1; ++rep1) {
            pg8::Gemm g{(const bf16_t*)(ws + WS_XB), (const bf16_t*)(ws + WS_WTIN) + (size_t)layer * NPAD * 1024, MT, NPAD, 1024};
            pg8::StaticOrder S; S.init(MT, NPAD, (int)gridDim.x, (int)blockIdx.x);
            EpiIn E; E.ws = ws; E.out = P.out; E.bfv = P.in[8] + layer * 8; E.layer = layer; E.S = S; E.rsl = lds + LDS_MISC + 1024; E.ui = 0;
#ifndef NO_P1
            pg8::gemm_phase<EpiIn, pg8::StaticOrder, true, true>(lds, g, S, E);
#endif
        }
        GSYNC();
        fox_cumsum(P, lds, layer, tid, lane, wave);
#ifndef NO_PP
        for (int u = (MP / 64) * 4 + blockIdx.x; u < NG * 4; u += gridDim.x) hg_prepass_unit(P, lds, layer, u >> 2, u & 3, tid, lane, wave);
#endif
        unsigned* sdone = (unsigned*)(ws + WS_CTL) + 16 + li;
        asm volatile("s_waitcnt vmcnt(0)" ::: "memory");
        __syncthreads();
        if (tid == 0) { __builtin_amdgcn_fence(__ATOMIC_RELEASE, "agent"); asm volatile("s_waitcnt vmcnt(0)" ::: "memory"); __hip_atomic_fetch_add(sdone, 1u, __ATOMIC_RELAXED, __HIP_MEMORY_SCOPE_AGENT); }
        bool stats_ready = false;
#ifndef PROBE_CUT
#define PROBE_CUT 9
#endif
        if (lastrep || PROBE_CUT >= 2) {
            unsigned* cnt = (unsigned*)(ws + WS_CTL) + li;
            constexpr int T_HP = 32 * NSEG, T_AP = T_HP + 2048, T_AS = T_AP + 128, T_HSM = T_AS + 64, T_SO = T_HSM + 16, T_FX = T_SO + 32 * NSEG;
            unsigned* segdone = (unsigned*)(ws + WS_CTL) + 32 + 32 * li;
            for (;;) {
                if (tid == 0) *slot = (int)atomicAdd(cnt, 1u);
                __syncthreads();
                const int pt = *slot;
                __syncthreads();
                if (pt >= T_FX) break;
                int tk;
                { constexpr int A1 = 1152, P1_ = T_HP + A1, P2_ = P1_ + 32 * NSEG, P3_ = P2_ + 128, P4_ = P3_ + 64, P5_ = P4_ + 16;
                  if (pt < P1_) tk = pt;
                  else if (pt < P2_) tk = T_SO + (pt - P1_);
                  else if (pt < P3_) tk = T_AP + (pt - P2_);
                  else if (pt < P4_) tk = T_AS + (pt - P3_);
                  else if (pt < P5_) tk = T_HSM + (pt - P4_);
                  else tk = T_HP + A1 + (pt - P5_); }
                if (tk >= T_HP && !stats_ready) {
                    if (tid == 0) {
                        for (unsigned spin = 0; spin < (1u << 20); ++spin) { if (__hip_atomic_load(sdone, __ATOMIC_RELAXED, __HIP_MEMORY_SCOPE_AGENT) >= gridDim.x) break; __builtin_amdgcn_s_sleep(4); }
                        __builtin_amdgcn_fence(__ATOMIC_ACQUIRE, "agent"); asm volatile("s_waitcnt vmcnt(0)" ::: "memory"); }
                    __syncthreads();
                    stats_ready = true;
                }
                unsigned* sampdone = (unsigned*)(ws + WS_CTL) + 96 + 4 * li;
                if (tk >= T_HSM && tk < T_SO) {
                    const int j = (tk - T_HSM) >> 2, pn = (tk - T_HSM) & 3;
                    if (tid == 0) {
                        for (unsigned spin = 0; spin < (1u << 20); ++spin) { if (__hip_atomic_load(sampdone + j, __ATOMIC_RELAXED, __HIP_MEMORY_SCOPE_AGENT) >= 48u) break; __builtin_amdgcn_s_sleep(4); }
                        __builtin_amdgcn_fence(__ATOMIC_ACQUIRE, "agent"); asm volatile("s_waitcnt vmcnt(0)" ::: "memory"); }
                    __syncthreads();
                    pg8::Gemm g1{(const bf16_t*)(ws + WS_YC), (const bf16_t*)(ws + WS_WTOUT) + (size_t)layer * 1024 * 1024, MT, 1024, 1024};
                    OneUnit S1; S1.pm = MP / 256 + j; S1.pn = pn;
                    EpiOut E1; E1.XB = (bf16_t*)(ws + WS_XB); E1.SS = (float*)(ws + WS_SS);
                    pg8::gemm_phase<EpiOut, OneUnit, true, true>(lds, g1, S1, E1);
                    __syncthreads();
                    continue;
                }
                if (tk < T_HP || tk >= T_AS) {
                    int g0, nch, h, mode, seg = 0; const float* S0; float* So;
                    if (tk < T_HP) { const int bh = tk >> 3, b = bh >> 2; seg = tk & 7; h = bh & 3; g0 = b * 128 + seg * SEGC; nch = SEGC; S0 = P.in[5]; mode = 1; So = (float*)(ws + WS_LB) + ((size_t)bh * NSEG + seg) * 16384; }
                    else if (tk < T_HSM) { const int bh = tk - T_AS, b = bh >> 2; h = bh & 3; g0 = 1024 + b; nch = 1; mode = 0; S0 = P.in[5] + ((size_t)(layer * DBAT + b) * 4 + h) * 16384; So = P.out + OFF_HS + ((size_t)(layer * DBAT + b) * 4 + h) * 16384; }
                    else { const int idx = tk - T_SO, bh = idx & 31, b = bh >> 2; seg = NSEG - 1 - (idx >> 5); h = bh & 3; g0 = b * 128 + seg * SEGC; nch = SEGC; mode = 2; S0 = P.in[5]; So = P.out + OFF_HP + ((size_t)(layer * NBAT + b) * 4 + h) * 16384;
                        if (tid == 0) {
                            for (unsigned spin = 0; spin < (1u << 20); ++spin) { if (__hip_atomic_load(segdone + bh, __ATOMIC_RELAXED, __HIP_MEMORY_SCOPE_AGENT) >= (unsigned)NSEG) break; __builtin_amdgcn_s_sleep(4); }
                            __builtin_amdgcn_fence(__ATOMIC_ACQUIRE, "agent"); asm volatile("s_waitcnt vmcnt(0)" ::: "memory"); }
                        __syncthreads(); }
#ifndef NO_HS
                    if (mode == 1) {
                        hg_local_unit(P, lds, layer, g0, h, So, tid, lane, wave);
                        asm volatile("s_waitcnt vmcnt(0)" ::: "memory");
                        __syncthreads();
                        if (tid == 0) { __builtin_amdgcn_fence(__ATOMIC_RELEASE, "agent"); asm volatile("s_waitcnt vmcnt(0)" ::: "memory"); __hip_atomic_fetch_add(segdone + (tk >> 3), 1u, __ATOMIC_RELAXED, __HIP_MEMORY_SCOPE_AGENT); }
                    } else { hg_seq_unit(P, lds, layer, g0, nch, h, S0, So, mode, seg, (const float*)(ws + WS_LB) + (size_t)(mode == 2 ? (tk - T_SO) & 31 : 0) * NSEG * 16384, tid, lane, wave);
                        if (mode == 0) {
                            asm volatile("s_waitcnt vmcnt(0)" ::: "memory");
                            __syncthreads();
                            if (tid == 0) { __builtin_amdgcn_fence(__ATOMIC_RELEASE, "agent"); asm volatile("s_waitcnt vmcnt(0)" ::: "memory"); __hip_atomic_fetch_add(sampdone + ((tk - T_AS) >> 4), 1u, __ATOMIC_RELAXED, __HIP_MEMORY_SCOPE_AGENT); }
                        } }
#endif
                } else {
                    const bf16_t *Qp, *Kp, *VTp; const float *CLp, *BTp, *CMp, *KNp, *Kc = P.in[2], *Vc = P.in[3]; bf16_t* Yp; int vpitch, NT, nqw, qpos0, creft, ncache = 0;
                    if (tk < T_AP) {
                        const int idx = tk - T_HP, qb = 31 - (idx >> 6), bh = idx & 63, b = bh >> 3, h = bh & 7;
                        Qp = (const bf16_t*)(ws + WS_QB) + ((size_t)b * SEQ + qb * 256) * 512 + h * 64; Kp = (const bf16_t*)(ws + WS_KBP) + (size_t)b * SEQ * 512 + h * 64;
                        VTp = (const bf16_t*)(ws + WS_VTP) + (size_t)b * SEQ * 512 + h * 64; vpitch = 512; CLp = (const float*)(ws + WS_CL) + ((size_t)layer * KROWS + (size_t)b * SEQ) * 8 + h;
                        BTp = (const float*)(ws + WS_BT) + ((size_t)layer * NKT + b * 128) * 8 + h; CMp = (const float*)(ws + WS_CM) + ((size_t)layer * NKT + b * 128) * 8 + h; KNp = (const float*)(ws + WS_KN) + ((size_t)layer * NKT + b * 128) * 8 + h; NT = 4 * (qb + 1); nqw = 8; qpos0 = qb * 256; creft = qb * 4;
                        Yp = (bf16_t*)(ws + WS_YC) + ((size_t)b * SEQ + qb * 256) * 1024 + h * 64;
                    } else {
                        const int bh = tk - T_AP, b = bh >> 3, h = bh & 7;
                        Qp = (const bf16_t*)(ws + WS_QB) + ((size_t)MP + b * 64) * 512 + h * 64; Kp = (const bf16_t*)(ws + WS_KBS) + ((size_t)layer * KSROWS + (size_t)b * SKV) * 512 + h * 64;
                        VTp = (const bf16_t*)(ws + WS_VTS) + ((size_t)layer * KSROWS + (size_t)b * SKV) * 512 + h * 64; vpitch = 512; CLp = (const float*)(ws + WS_CL) + ((size_t)layer * KROWS + MP + (size_t)b * SKV) * 8 + h;
                        BTp = (const float*)(ws + WS_BT) + ((size_t)layer * NKT + 1024 + b * 33) * 8 + h; CMp = (const float*)(ws + WS_CM) + ((size_t)layer * NKT + 1024 + b * 33) * 8 + h; KNp = (const float*)(ws + WS_KN) + ((size_t)layer * NKT + 1024 + b * 33) * 8 + h; NT = 33; nqw = 2; qpos0 = PAST; creft = 32; ncache = 32; Kc = P.in[2] + ((size_t)(layer * DBAT + b) * PAST) * 512 + h * 64; Vc = P.in[3] + ((size_t)(layer * DBAT + b) * PAST) * 512 + h * 64;
                        Yp = (bf16_t*)(ws + WS_YC) + ((size_t)MP + b * 64) * 1024 + h * 64;
                    }
#ifndef NO_AT
                    attn_unit(lds, Qp, Kp, VTp, vpitch, CLp, BTp, CMp, KNp, NT, nqw, qpos0, creft, Yp, Kc, Vc, ncache, tid, lane, wave);
                    if (tk >= T_AP) {
                        asm volatile("s_waitcnt vmcnt(0)" ::: "memory");
                        __syncthreads();
                        if (tid == 0) { __builtin_amdgcn_fence(__ATOMIC_RELEASE, "agent"); asm volatile("s_waitcnt vmcnt(0)" ::: "memory"); __hip_atomic_fetch_add(sampdone + ((tk - T_AP) >> 5), 1u, __ATOMIC_RELAXED, __HIP_MEMORY_SCOPE_AGENT); }
                    }
#endif
                }
            }
        }
        if (lastrep || PROBE_CUT >= 3) GSYNC();
      }
        if (li % NREP_L == NREP_L - 1) {
            pg8::Gemm g{(const bf16_t*)(ws + WS_YC), (const bf16_t*)(ws + WS_WTOUT) + (size_t)layer * 1024 * 1024, MP, 1024, 1024};
            pg8::StaticOrder S; S.init(MP, 1024, (int)gridDim.x, (int)blockIdx.x);
            EpiOut E; E.XB = (bf16_t*)(ws + WS_XB); E.SS = (float*)(ws + WS_SS);
#ifndef NO_P3
            pg8::gemm_phase<EpiOut, pg8::StaticOrder, true, true>(lds, g, S, E);
#endif
        }
        if (lastrep) GSYNC();
    }
    {
        const float* SS = (const float*)(ws + WS_SS); const float* fg = P.in[12]; float* y = P.out + OFF_Y; const bf16_t* XB = (const bf16_t*)(ws + WS_XB);
        const int gw = blockIdx.x * 8 + wave, NGW = gridDim.x * 8;
        f32x4 g4[4];
#pragma unroll
        for (int j = 0; j < 4; ++j) g4[j] = ((const f32x4*)fg)[4 * lane + j];
        for (int r0 = gw; r0 < MT; r0 += 4 * NGW) {
            float sv[4]; u32x4 v[4][2];
#pragma unroll
            for (int q = 0; q < 4; ++q) { const int r = min(r0 + q * NGW, MT - 1); sv[q] = (lane < 16) ? SS[(size_t)r * 16 + lane] : 0.f;
                v[q][0] = ((const u32x4*)(XB + (size_t)r * 1024))[2 * lane]; v[q][1] = ((const u32x4*)(XB + (size_t)r * 1024))[2 * lane + 1]; }
#pragma unroll
            for (int q = 0; q < 4; ++q) { const int r = r0 + q * NGW; const float rinv = rsqrtf(wave_sum(sv[q]) * (1.0f / 1024.0f) + EPS);
                if (r < MT) {
#pragma unroll
                    for (int j = 0; j < 4; ++j) { const unsigned w0 = v[q][j >> 1][(j & 1) * 2], w1 = v[q][j >> 1][(j & 1) * 2 + 1];
                        f32x4 o; o[0] = bflo(w0) * rinv * g4[j][0]; o[1] = bfhi(w0) * rinv * g4[j][1]; o[2] = bflo(w1) * rinv * g4[j][2]; o[3] = bfhi(w1) * rinv * g4[j][3];
                        ((f32x4*)(y + (size_t)r * 1024))[4 * lane + j] = o; } } }
        }
    }
}

extern "C" void kernel_launch(void* const* d_in, const int* in_sizes, int n_in, void* d_out, int out_size, void* d_ws, size_t ws_size, hipStream_t stream) {
    static int grid = 0;
    if (grid == 0) {
        if (n_in != 13 || (size_t)out_size != OUT_TOTAL || ws_size < WS_END) { fprintf(stderr, "kernel_launch: unexpected sizes n_in=%d out=%d ws=%zu (need %zu)\n", n_in, out_size, ws_size, (size_t)WS_END); grid = -1; return; }
        int dev = 0, cus = 0, per_cu = 0;
        hipGetDevice(&dev); hipDeviceGetAttribute(&cus, hipDeviceAttributeMultiprocessorCount, dev);
        if (hipFuncSetAttribute((const void*)fwd_megakernel, hipFuncAttributeMaxDynamicSharedMemorySize, LDS_BYTES) != hipSuccess) { fprintf(stderr, "kernel_launch: hipFuncSetAttribute failed\n"); grid = -1; return; }
        if (hipOccupancyMaxActiveBlocksPerMultiprocessor(&per_cu, (const void*)fwd_megakernel, 512, LDS_BYTES) != hipSuccess || per_cu < 1) { fprintf(stderr, "kernel_launch: occupancy query says %d\n", per_cu); per_cu = 1; }
        (void)hipGetLastError();
        grid = cus;
    }
    if (grid < 0) return;
    Params p{};
    for (int i = 0; i < 13; ++i) p.in[i] = (const float*)d_in[i];
    p.out = (float*)d_out; p.ws = (unsigned char*)d_ws;
    void* args[] = {&p};
    hipError_t e = hipLaunchCooperativeKernel((const void*)fwd_megakernel, dim3(grid), dim3(512), args, LDS_BYTES, stream);
    if (e != hipSuccess) fprintf(stderr, "cooperative launch failed: %s (grid %d)\n", hipGetErrorString(e), grid);
}
```
